# Optimizing an MI355X kernel written in HIP

```python
import jax, jax.numpy as jnp
from jax import lax
import numpy as np

D_MODEL = 1024
BATCH = 16
SEQ = 2048
DEPTH = 1

HEAD_DIM = 64
GQA_HEADS = 8
GQA_KV_HEADS = 2
GQA_GROUP = GQA_HEADS // GQA_KV_HEADS
MLA_HEADS = 8
MLA_NOPE_DIM = 64
MLA_ROPE_DIM = 32
MLA_V_DIM = 64
MLA_Q_RANK = 256
MLA_KV_RANK = 256
MIX_WIDTH = GQA_HEADS * HEAD_DIM + MLA_HEADS * MLA_V_DIM
SZ_GQA_Q = GQA_HEADS * HEAD_DIM
SZ_GQA_K = GQA_KV_HEADS * HEAD_DIM
SZ_GQA_V = GQA_KV_HEADS * HEAD_DIM
SZ_MLA_CQ = MLA_Q_RANK
SZ_MLA_CKV = MLA_KV_RANK
SZ_MLA_KR = MLA_ROPE_DIM
IN_WIDTH = SZ_GQA_Q + SZ_GQA_K + SZ_GQA_V + SZ_MLA_CQ + SZ_MLA_CKV + SZ_MLA_KR
SPLIT_1 = SZ_GQA_Q
SPLIT_2 = SPLIT_1 + SZ_GQA_K
SPLIT_3 = SPLIT_2 + SZ_GQA_V
SPLIT_4 = SPLIT_3 + SZ_MLA_CQ
SPLIT_5 = SPLIT_4 + SZ_MLA_CKV
N_EXPERTS = 16
CAPACITY_FACTOR = 2
EXPERT_FF = 2816
PLE_DIM = 256
GRID_W = 64
Q_BLOCK = 128
ROPE_BASE = 10000.0
LN_EPS = 1e-5
RMS_EPS = 1e-6
DN_ALPHA = (2 * DEPTH) ** 0.25
DN_BETA = (8 * DEPTH) ** -0.25

kernel_name = 'hybrid_gqa_mla_ec_moe_encoder'


def layer_norm(x, g, b):
    xf = x.astype(jnp.float32)
    mu = jnp.mean(xf, axis=-1, keepdims=True)
    xc = xf - mu
    var = jnp.mean(xc * xc, axis=-1, keepdims=True)
    return (xc * lax.rsqrt(var + LN_EPS) * g.astype(jnp.float32) + b.astype(jnp.float32)).astype(x.dtype)


def rms_norm(x, g):
    xf = x.astype(jnp.float32)
    ms = jnp.mean(xf * xf, axis=-1, keepdims=True)
    return (xf * lax.rsqrt(ms + RMS_EPS) * g.astype(jnp.float32)).astype(x.dtype)


def rope_1d(x, pos):
    d = x.shape[-1]
    half = d // 2
    inv_freq = ROPE_BASE ** (-jnp.arange(half, dtype=jnp.float32) * 2.0 / d)
    ang = pos[:, None] * inv_freq[None, :]
    cos = jnp.cos(ang)[:, None, :]
    sin = jnp.sin(ang)[:, None, :]
    xf = x.astype(jnp.float32)
    x1, x2 = xf[..., :half], xf[..., half:]
    return jnp.concatenate([x1 * cos - x2 * sin, x2 * cos + x1 * sin], axis=-1).astype(x.dtype)


def axial_rope(x, row, col):
    h = x.shape[-1] // 2
    return jnp.concatenate([rope_1d(x[..., :h], row), rope_1d(x[..., h:], col)], axis=-1)


def block_attention(q, k, v, scale):
    B, S, KH, G, Dk = q.shape
    nb = S // Q_BLOCK
    qb = q.reshape(B, nb, Q_BLOCK, KH, G, Dk).transpose(1, 0, 2, 3, 4, 5)

    def one_block(qblk):
        s = jnp.einsum('bqhgd,bkhd->bhgqk', qblk, k, preferred_element_type=jnp.float32) * scale
        w = jax.nn.softmax(s, axis=-1).astype(v.dtype)
        return jnp.einsum('bhgqk,bkhd->bqhgd', w, v)

    o = lax.map(one_block, qb)
    return o.transpose(1, 0, 2, 3, 4, 5).reshape(B, S, KH, G, v.shape[-1])


def setup_inputs(seed: int = 0) -> dict:
    key = jax.random.key(seed)
    ks = jax.random.split(key, 24)
    f32 = jnp.float32

    def nrm(k, shape, scale):
        return jax.random.normal(k, shape, f32) * scale

    def gain(k, shape):
        return 1.0 + 0.02 * jax.random.normal(k, shape, f32)

    L = DEPTH
    return {
        'x': jax.random.normal(ks[0], (BATCH, SEQ, D_MODEL), f32),
        'p': jax.random.normal(ks[1], (DEPTH, BATCH, SEQ, PLE_DIM), f32),
        'w_in': nrm(ks[2], (L, D_MODEL, IN_WIDTH), D_MODEL ** -0.5),
        'q_norm': gain(ks[3], (L, HEAD_DIM)),
        'k_norm': gain(ks[4], (L, HEAD_DIM)),
        'cq_norm': gain(ks[5], (L, MLA_Q_RANK)),
        'ckv_norm': gain(ks[6], (L, MLA_KV_RANK)),
        'w_uq': nrm(ks[7], (L, MLA_Q_RANK, MLA_HEADS * (MLA_NOPE_DIM + MLA_ROPE_DIM)), MLA_Q_RANK ** -0.5),
        'w_ukv': nrm(ks[8], (L, MLA_KV_RANK, MLA_HEADS * (MLA_NOPE_DIM + MLA_V_DIM)), MLA_KV_RANK ** -0.5),
        'w_out': nrm(ks[9], (L, MIX_WIDTH, D_MODEL), DN_BETA * MIX_WIDTH ** -0.5),
        'ln_attn_g': gain(ks[10], (L, D_MODEL)),
        'ln_attn_b': nrm(ks[11], (L, D_MODEL), 0.02),
        'w_router': nrm(ks[12], (L, D_MODEL, N_EXPERTS), D_MODEL ** -0.5),
        'w_gate': nrm(ks[13], (L, N_EXPERTS, D_MODEL, EXPERT_FF), D_MODEL ** -0.5),
        'w_up': nrm(ks[14], (L, N_EXPERTS, D_MODEL, EXPERT_FF), D_MODEL ** -0.5),
        'w_down': nrm(ks[15], (L, N_EXPERTS, EXPERT_FF, D_MODEL), DN_BETA * EXPERT_FF ** -0.5),
        'ln_ffn_g': gain(ks[16], (L, D_MODEL)),
        'ln_ffn_b': nrm(ks[17], (L, D_MODEL), 0.02),
        'w_ple_proj': nrm(ks[18], (L, PLE_DIM, D_MODEL), DN_BETA * PLE_DIM ** -0.5),
        'w_ple_gate': nrm(ks[19], (L, D_MODEL, D_MODEL), D_MODEL ** -0.5),
        'ln_ple_g': gain(ks[20], (L, D_MODEL)),
        'ln_ple_b': nrm(ks[21], (L, D_MODEL), 0.02),
    }


def reference(x, p, w_in, q_norm, k_norm, cq_norm, ckv_norm, w_uq, w_ukv, w_out,
              ln_attn_g, ln_attn_b, w_router, w_gate, w_up, w_down, ln_ffn_g, ln_ffn_b,
              w_ple_proj, w_ple_gate, ln_ple_g, ln_ple_b):
    B, S, _ = x.shape
    rows = S // GRID_W
    row = jnp.repeat(jnp.arange(rows, dtype=jnp.float32), GRID_W)
    col = jnp.tile(jnp.arange(GRID_W, dtype=jnp.float32), rows)
    cap = CAPACITY_FACTOR * S // N_EXPERTS
    bidx = jnp.arange(B)[:, None, None]

    for i in range(DEPTH):
        proj = jnp.einsum('bsd,dn->bsn', x, w_in[i])
        q_g, k_g, v_g, c_q, c_kv, k_r = jnp.split(
            proj, [SPLIT_1, SPLIT_2, SPLIT_3, SPLIT_4, SPLIT_5], axis=-1)

        q = axial_rope(rms_norm(q_g.reshape(B, S, GQA_HEADS, HEAD_DIM), q_norm[i]), row, col)
        k = axial_rope(rms_norm(k_g.reshape(B, S, GQA_KV_HEADS, HEAD_DIM), k_norm[i]), row, col)
        v = v_g.reshape(B, S, GQA_KV_HEADS, HEAD_DIM)
        q = q.reshape(B, S, GQA_KV_HEADS, GQA_GROUP, HEAD_DIM)
        o_gqa = block_attention(q, k, v, HEAD_DIM ** -0.5).reshape(B, S, GQA_HEADS * HEAD_DIM)

        qm = jnp.einsum('bsr,rn->bsn', rms_norm(c_q, cq_norm[i]), w_uq[i])
        qm = qm.reshape(B, S, MLA_HEADS, MLA_NOPE_DIM + MLA_ROPE_DIM)
        q_pe = axial_rope(qm[..., MLA_NOPE_DIM:], row, col)
        q_m = jnp.concatenate([qm[..., :MLA_NOPE_DIM], q_pe], axis=-1)[:, :, :, None, :]
        kv = jnp.einsum('bsr,rn->bsn', rms_norm(c_kv, ckv_norm[i]), w_ukv[i])
        kv = kv.reshape(B, S, MLA_HEADS, MLA_NOPE_DIM + MLA_V_DIM)
        k_pe = axial_rope(k_r[:, :, None, :], row, col)
        k_m = jnp.concatenate(
            [kv[..., :MLA_NOPE_DIM], jnp.broadcast_to(k_pe, (B, S, MLA_HEADS, MLA_ROPE_DIM))], axis=-1)
        v_m = kv[..., MLA_NOPE_DIM:]
        o_mla = block_attention(q_m, k_m, v_m, (MLA_NOPE_DIM + MLA_ROPE_DIM) ** -0.5)
        o_mla = o_mla.reshape(B, S, MLA_HEADS * MLA_V_DIM)

        mix = jnp.einsum('bsm,md->bsd', jnp.concatenate([o_gqa, o_mla], axis=-1), w_out[i])
        x = layer_norm(DN_ALPHA * x + mix, ln_attn_g[i], ln_attn_b[i])

        logits = jnp.einsum('bsd,de->bse', x, w_router[i], preferred_element_type=jnp.float32)
        aff = jax.nn.softmax(logits, axis=-1).transpose(0, 2, 1)
        g_val, t_idx = lax.top_k(aff, cap)
        xg = x[bidx, t_idx]
        h = jax.nn.silu(jnp.einsum('becd,edf->becf', xg, w_gate[i])) * \
            jnp.einsum('becd,edf->becf', xg, w_up[i])
        y = jnp.einsum('becf,efd->becd', h, w_down[i]) * g_val[..., None].astype(x.dtype)
        moe = jnp.zeros_like(x).at[bidx, t_idx].add(y)
        x = layer_norm(DN_ALPHA * x + moe, ln_ffn_g[i], ln_ffn_b[i])

        e = jnp.einsum('bsp,pd->bsd', p[i], w_ple_proj[i])
        gate = jax.nn.sigmoid(jnp.einsum('bsd,de->bse', x, w_ple_gate[i]))
        x = layer_norm(DN_ALPHA * x + gate * e, ln_ple_g[i], ln_ple_b[i])

    return x
```

```cpp
#include <hip/hip_runtime.h>
#include <cstdio>
#include <cstdint>

#ifndef MK_ONE_LAUNCH
#define MK_ONE_LAUNCH 0
#endif

namespace pg8 {
#define PG8_LAS __attribute__((address_space(3)))
typedef unsigned short bf16_t;
typedef short bf16x8 __attribute__((ext_vector_type(8)));
typedef float f32x4 __attribute__((ext_vector_type(4)));
typedef unsigned u32x4 __attribute__((ext_vector_type(4)));
typedef unsigned u32x2 __attribute__((ext_vector_type(2)));
constexpr int BM = 256, BK = 64, HALF = 128, HTB = HALF * BK * 2  , STAGE_BYTES = 8 * HTB, NXCD = 8, WGM = 8;

__host__ __device__ __forceinline__ int lds_byte(int r, int c) { const int st = (r >> 4) * 2 + (c >> 5), rr = r & 15, cc = c & 31, ob = rr * 64 + cc * 2; return st * 1024 + (ob ^ (((ob >> 9) & 1) << 5)); }
__host__ __device__ __forceinline__ void stage_rc(int b, int& R, int& C) { const int st = b / 1024, sb = b % 1024, swz = sb ^ (((sb >> 9) & 1) << 5); R = (st >> 1) * 16 + swz / 64; C = (st & 1) * 32 + (swz % 64) / 2; }
__host__ __device__ __forceinline__ int perm32(int rho) { const int n = rho >> 4, i = rho & 15; return 8 * (i >> 2) + 4 * n + (i & 3); }

struct Unit { int pm, pn; };
struct Gemm { const bf16_t* A; const bf16_t* Bt; int M, N, K; };

struct StaticOrder {
    static constexpr bool GATHER = false;
    int nM, nN, nwg, G, c, mpe;
    __host__ __device__ void init(int M, int N, int G_, int c_, int mpe_ = 0) { nM = M / BM; nN = N / BM; nwg = nM * nN; G = G_; c = c_; mpe = mpe_; }
    __host__ __device__ bool next(int i, Unit& u) const {
        const long L = (long)i * G + c; if (L >= nwg) return false;
        int wgid = (int)L; { const int q = nwg / NXCD, r = nwg % NXCD, xcd = wgid % NXCD, off = wgid / NXCD; wgid = (xcd < r ? xcd * (q + 1) : r * (q + 1) + (xcd - r) * q) + off; }
        const int nig = WGM * nN, gid = wgid / nig, fm = gid * WGM, gsz = (nM - fm) < WGM ? (nM - fm) : WGM;
        u.pm = fm + ((wgid % nig) % gsz); u.pn = (wgid % nig) / gsz; return true;
    }
    __host__ __device__ __forceinline__ int btile(const Unit& u) const { return mpe ? (u.pm / mpe) * nN + u.pn : u.pn; }
    __device__ __forceinline__ unsigned arow(const Unit&, int) const { return 0u; }
};
struct GatherOrder : StaticOrder {
    static constexpr bool GATHER = true;
    const int* rowmap;
    __device__ __forceinline__ unsigned arow(const Unit& u, int r) const { return (unsigned)rowmap[u.pm * BM + r]; }
};

__device__ __forceinline__ unsigned cvt_pk_bf16(float lo, float hi) { unsigned r; asm volatile("v_cvt_pk_bf16_f32 %0, %1, %2" : "=v"(r) : "v"(lo), "v"(hi)); return r; }

struct EpiF32 {
    static constexpr bool PERM = false;
    float* O; int ldc;
    __device__ __forceinline__ void operator()(const f32x4 (&acc)[2][2][4][2], const Unit& u, int wr, int wc, int fr, int fq) const {
        const int row0 = u.pm * BM + wr * 64 + fr, col0 = u.pn * BM + wc * 32 + 4 * fq;
#pragma unroll
        for (int ai = 0; ai < 2; ++ai)
#pragma unroll
            for (int m = 0; m < 4; ++m) { float* rowp = O + (size_t)(row0 + ai * HALF + m * 16) * ldc + col0;
#pragma unroll
                for (int bj = 0; bj < 2; ++bj)
#pragma unroll
                    for (int n = 0; n < 2; ++n) *(f32x4*)(rowp + bj * HALF + n * 16) = acc[ai][bj][m][n]; }
    }
};
struct EpiSwiGLU {
    static constexpr bool PERM = false;
    bf16_t* H; int ldh;
    __device__ __forceinline__ void operator()(const f32x4 (&acc)[2][2][4][2], const Unit& u, int wr, int wc, int fr, int fq) const {
        const int row0 = u.pm * BM + wr * 64 + fr, col0 = u.pn * HALF + wc * 32 + 4 * fq;
#pragma unroll
        for (int ai = 0; ai < 2; ++ai)
#pragma unroll
            for (int m = 0; m < 4; ++m) { bf16_t* rowp = H + (size_t)(row0 + ai * HALF + m * 16) * ldh + col0;
#pragma unroll
                for (int n = 0; n < 2; ++n) { const f32x4 g = acc[ai][0][m][n], up = acc[ai][1][m][n]; float h[4];
#pragma unroll
                    for (int j = 0; j < 4; ++j) { const float s = __builtin_amdgcn_rcpf(1.0f + __builtin_amdgcn_exp2f(-1.4426950408889634f * g[j])); h[j] = g[j] * s * up[j]; }
                    u32x2 w; w.x = cvt_pk_bf16(h[0], h[1]); w.y = cvt_pk_bf16(h[2], h[3]); *(u32x2*)(rowp + n * 16) = w; } }
    }
};
struct EpiRowScaleBf16 {
    static constexpr bool PERM = false;
    bf16_t* O; int ldc; const float* rs;
    __device__ __forceinline__ void operator()(const f32x4 (&acc)[2][2][4][2], const Unit& u, int wr, int wc, int fr, int fq) const {
        const int row0 = u.pm * BM + wr * 64 + fr, col0 = u.pn * BM + wc * 32 + 4 * fq;
#pragma unroll
        for (int ai = 0; ai < 2; ++ai)
#pragma unroll
            for (int m = 0; m < 4; ++m) { const int row = row0 + ai * HALF + m * 16; const float s = rs[row]; bf16_t* rowp = O + (size_t)row * ldc + col0;
#pragma unroll
                for (int bj = 0; bj < 2; ++bj)
#pragma unroll
                    for (int n = 0; n < 2; ++n) { const f32x4 v = acc[ai][bj][m][n] * s; u32x2 w; w.x = cvt_pk_bf16(v[0], v[1]); w.y = cvt_pk_bf16(v[2], v[3]); *(u32x2*)(rowp + bj * HALF + n * 16) = w; } }
    }
};

template <class Epi, class Sched, bool ALIGN_EPI>
__device__ __forceinline__ void gemm_phase(PG8_LAS unsigned char* lds, const Gemm g, const Sched& S, const Epi& E) {
    constexpr bool GATHER = Sched::GATHER;
    const int tid = threadIdx.x, wid = __builtin_amdgcn_readfirstlane(tid >> 6), lane = tid & 63, wr = wid >> 2, wc = wid & 3, fr = lane & 15, fq = lane >> 4;
    const int K = g.K, nt = K / BK;
    unsigned voffB[2], vC0[2], vC1[2], vN0[2], vN1[2]; int RA[2]; unsigned cofA[2];
#pragma unroll
    for (int i = 0; i < 2; ++i) { int R, C; stage_rc(tid * 16 + i * 8192, R, C); const int Rb = Epi::PERM ? ((R & ~31) + perm32(R & 31)) : R;
        vC0[i] = (unsigned)(R * K + C) * 2u; vC1[i] = vC0[i]; vN0[i] = vC0[i]; vN1[i] = vC0[i]; voffB[i] = (unsigned)(Rb * K + C) * 2u; RA[i] = R; cofA[i] = (unsigned)C * 2u; }
    const size_t kstep = (size_t)(BK * 2);
    const size_t hstep = (size_t)HALF * K * 2;
    const size_t hstepA = GATHER ? (size_t)0 : hstep;
    const size_t tstep = 2 * hstep;
    const unsigned ldsw = (unsigned)wid * 1024u;
    const int aoff = lds_byte(wr * 64 + fr, fq * 8), boff = lds_byte(wc * 32 + fr, fq * 8);
#define PG8_SA(b, h) (((b) * 2 + (h)) * HTB)
#define PG8_SB(b, h) ((4 + (b) * 2 + (h)) * HTB)
#define PG8_STAGE(bufoff, gbase, voff) do { _Pragma("unroll") for (int _i = 0; _i < 2; ++_i) \
        __builtin_amdgcn_global_load_lds((const unsigned*)((const char*)(gbase) + (voff)[_i]), (PG8_LAS unsigned*)(lds + (bufoff) + ldsw + _i * 8192), 16, 0, 0); } while (0)
#define PG8_LDA(dst, b, h) do { _Pragma("unroll") for (int m = 0; m < 4; ++m) _Pragma("unroll") for (int k = 0; k < 2; ++k) dst[m][k] = *(const PG8_LAS bf16x8*)(lds + PG8_SA(b, h) + aoff + m * 2048 + k * 1024); } while (0)
#define PG8_LDB(dst, b, h) do { _Pragma("unroll") for (int n = 0; n < 2; ++n) _Pragma("unroll") for (int k = 0; k < 2; ++k) dst[n][k] = *(const PG8_LAS bf16x8*)(lds + PG8_SB(b, h) + boff + n * 2048 + k * 1024); } while (0)
#define PG8_MMA(ai, bj, At, Bt) do { __builtin_amdgcn_s_setprio(1); _Pragma("unroll") for (int m = 0; m < 4; ++m) _Pragma("unroll") for (int n = 0; n < 2; ++n) _Pragma("unroll") for (int k = 0; k < 2; ++k) \
        acc[ai][bj][m][n] = __builtin_amdgcn_mfma_f32_16x16x32_bf16(Bt[n][k], At[m][k], acc[ai][bj][m][n], 0, 0, 0); __builtin_amdgcn_s_setprio(0); } while (0)
#define PG8_WAIT_V(n) asm volatile("s_waitcnt vmcnt(" #n ")" ::: "memory")
#define PG8_WAIT_L(n) asm volatile("s_waitcnt lgkmcnt(" #n ")" ::: "memory")
#define PG8_BAR __builtin_amdgcn_s_barrier()
#define PG8_SCHED __builtin_amdgcn_sched_barrier(0)
#define PG8_AROWS(u, d0, d1) do { if constexpr (GATHER) { _Pragma("unroll") for (int _i = 0; _i < 2; ++_i) { \
        d0[_i] = S.arow(u, RA[_i]) * (unsigned)(K * 2) + cofA[_i]; d1[_i] = S.arow(u, HALF + RA[_i]) * (unsigned)(K * 2) + cofA[_i]; } } } while (0)
    Unit cur, nxt; int ui = 0;
    if (!S.next(0, cur)) return;
    f32x4 acc[2][2][4][2];
#pragma unroll
    for (int a = 0; a < 2; ++a)
#pragma unroll
        for (int b = 0; b < 2; ++b)
#pragma unroll
            for (int m = 0; m < 4; ++m)
#pragma unroll
                for (int n = 0; n < 2; ++n) acc[a][b][m][n] = (f32x4){0.f, 0.f, 0.f, 0.f};
    bf16x8 At[4][2], B0[2][2], B1[2][2];
    const char* cA = GATHER ? (const char*)g.A : (const char*)g.A + (size_t)cur.pm * tstep; const char* cB = (const char*)g.Bt + (size_t)S.btile(cur) * tstep;
    PG8_AROWS(cur, vC0, vC1);
    PG8_STAGE(PG8_SB(0, 0), cB, voffB); PG8_STAGE(PG8_SB(0, 1), cB + hstep, voffB); PG8_STAGE(PG8_SA(0, 0), cA, vC0); PG8_STAGE(PG8_SA(0, 1), cA + hstepA, vC1);
    if (wr == 1) PG8_BAR;
    PG8_WAIT_V(2); PG8_BAR;
    PG8_STAGE(PG8_SB(1, 0), cB + kstep, voffB); PG8_STAGE(PG8_SA(1, 0), cA + kstep, vC0); PG8_STAGE(PG8_SB(1, 1), cB + hstep + kstep, voffB);
    PG8_WAIT_V(6); PG8_BAR;
    for (;;) {
        const bool has_next = S.next(ui + 1, nxt);
        const char* nA = GATHER ? (const char*)g.A : (has_next ? (const char*)g.A + (size_t)nxt.pm * tstep : cA); const char* nB = has_next ? (const char*)g.Bt + (size_t)S.btile(nxt) * tstep : cB;
        if constexpr (GATHER) { if (has_next) { PG8_AROWS(nxt, vN0, vN1); } else { vN0[0] = vC0[0]; vN0[1] = vC0[1]; vN1[0] = vC1[0]; vN1[1] = vC1[1]; } }
        for (int t = 0; t < nt; t += 2) {
            const bool last = (t == nt - 2);
            const char* a1 = cA + (size_t)(t + 1) * kstep;
            const char* a2 = last ? nA : cA + (size_t)(t + 2) * kstep; const char* b2 = last ? nB : cB + (size_t)(t + 2) * kstep;
            const char* a3 = a2 + kstep; const char* b3 = b2 + kstep;
            PG8_LDB(B0, 0, 0); PG8_LDB(B1, 0, 1); PG8_SCHED; PG8_LDA(At, 0, 0); PG8_STAGE(PG8_SA(1, 1), a1 + hstepA, vC1);
            if constexpr (GATHER) { if (last) { vC0[0] = vN0[0]; vC0[1] = vN0[1]; vC1[0] = vN1[0]; vC1[1] = vN1[1]; } }
            PG8_WAIT_V(8); PG8_WAIT_L(0); PG8_BAR; PG8_MMA(0, 0, At, B0); PG8_MMA(0, 1, At, B1); PG8_BAR; PG8_SCHED;
            PG8_LDA(At, 0, 1); PG8_STAGE(PG8_SB(0, 0), b2, voffB); PG8_STAGE(PG8_SB(0, 1), b2 + hstep, voffB); PG8_STAGE(PG8_SA(0, 0), a2, vC0);
            PG8_WAIT_V(8); PG8_WAIT_L(0); PG8_BAR; PG8_MMA(1, 0, At, B0); PG8_MMA(1, 1, At, B1); PG8_BAR; PG8_SCHED;
            PG8_LDB(B0, 1, 0); PG8_LDB(B1, 1, 1); PG8_SCHED; PG8_LDA(At, 1, 0); PG8_STAGE(PG8_SA(0, 1), a2 + hstepA, vC1);
            PG8_WAIT_V(8); PG8_WAIT_L(0); PG8_BAR; PG8_MMA(0, 0, At, B0); PG8_MMA(0, 1, At, B1); PG8_BAR; PG8_SCHED;
            PG8_LDA(At, 1, 1); PG8_STAGE(PG8_SB(1, 0), b3, voffB); PG8_STAGE(PG8_SB(1, 1), b3 + hstep, voffB); PG8_STAGE(PG8_SA(1, 0), a3, vC0);
            PG8_WAIT_V(8); PG8_WAIT_L(0); PG8_BAR; PG8_MMA(1, 0, At, B0); PG8_MMA(1, 1, At, B1); PG8_BAR; PG8_SCHED;
        }
        if constexpr (ALIGN_EPI) { if (wr == 0) PG8_BAR; }
        E(acc, cur, wr, wc, fr, fq);
        if (!has_next) break;
#pragma unroll
        for (int a = 0; a < 2; ++a)
#pragma unroll
            for (int b = 0; b < 2; ++b)
#pragma unroll
                for (int m = 0; m < 4; ++m)
#pragma unroll
                    for (int n = 0; n < 2; ++n) acc[a][b][m][n] = (f32x4){0.f, 0.f, 0.f, 0.f};
        cur = nxt; cA = nA; cB = nB; ++ui;
        if constexpr (ALIGN_EPI) { if (wr == 1) PG8_BAR; }
    }
    PG8_WAIT_V(0);
    if constexpr (!ALIGN_EPI) { if (wr == 0) PG8_BAR; }
    PG8_BAR;
#undef PG8_SA
#undef PG8_SB
#undef PG8_STAGE
#undef PG8_LDA
#undef PG8_LDB
#undef PG8_MMA
#undef PG8_WAIT_V
#undef PG8_WAIT_L
#undef PG8_BAR
#undef PG8_SCHED
#undef PG8_AROWS
}
}

namespace att {
using bf16_t = unsigned short;
using bf16x8 = __attribute__((ext_vector_type(8))) short;
using s16x4  = __attribute__((ext_vector_type(4))) short;
using f32x16 = __attribute__((ext_vector_type(16))) float;
using u32x4  = __attribute__((ext_vector_type(4))) unsigned;
#define SBAR() __builtin_amdgcn_sched_barrier(0)
constexpr float THR = 8.f;
__device__ __forceinline__ int crow(int r, int hi) { return (r & 3) + 8 * (r >> 2) + 4 * hi; }
__device__ __forceinline__ unsigned cvtpk(float lo, float hi) { unsigned r; asm volatile("v_cvt_pk_bf16_f32 %0, %1, %2" : "=v"(r) : "v"(lo), "v"(hi)); return r; }
template <int DK> struct KCfg;
template <> struct KCfg<64> { static constexpr float SCALE = 0.125f;
    static __device__ __forceinline__ int swz(int row, int cb) { return row * 128 + (cb ^ (((row >> 1) & 7) << 4)); } };
template <> struct KCfg<96> { static constexpr float SCALE = 0.10206207261596577f;
    static __device__ __forceinline__ int swz(int row, int cb) { return row * 192 + (cb ^ (((row >> 2) & 3) << 4)); } };

template <int DK> __device__ __forceinline__ void partialSM(f32x16& p0, f32x16& p1, float& m_reg, float& mn, float& alpha) {
  constexpr float SCALE = KCfg<DK>::SCALE, C = SCALE * 1.4426950408889634f;
  float pmax = p0[0];
#pragma unroll
  for (int r = 1; r < 16; ++r) pmax = fmaxf(pmax, p0[r]);
#pragma unroll
  for (int r = 0; r < 16; ++r) pmax = fmaxf(pmax, p1[r]);
  { auto rr = __builtin_amdgcn_permlane32_swap(__float_as_uint(pmax), __float_as_uint(pmax), false, false);
    pmax = fmaxf(__uint_as_float(rr[0]), __uint_as_float(rr[1])); }
  if (__builtin_expect(__all(pmax - m_reg <= THR / SCALE), 1)) { mn = m_reg; alpha = 1.f; }
  else { mn = fmaxf(m_reg, pmax); alpha = __builtin_amdgcn_exp2f((m_reg - mn) * C); m_reg = mn; }
  float mnC = -mn * C;
#pragma unroll
  for (int r = 0; r < 16; ++r) p0[r] = fmaf(p0[r], C, mnC);
#pragma unroll
  for (int r = 0; r < 16; ++r) p1[r] = fmaf(p1[r], C, mnC);
#pragma unroll
  for (int r = 0; r < 16; ++r) p0[r] = __builtin_amdgcn_exp2f(p0[r]);
}
__device__ __forceinline__ void finishSM(f32x16& p0, f32x16& p1, float alpha, float& l_reg, bf16x8& pa0, bf16x8& pa1, bf16x8& pa2, bf16x8& pa3) {
#pragma unroll
  for (int r = 0; r < 16; ++r) p1[r] = __builtin_amdgcn_exp2f(p1[r]);
  float ps = 0;
#pragma unroll
  for (int r = 0; r < 16; ++r) ps += p0[r];
#pragma unroll
  for (int r = 0; r < 16; ++r) ps += p1[r];
  { auto rr = __builtin_amdgcn_permlane32_swap(__float_as_uint(ps), __float_as_uint(ps), false, false);
    ps = __uint_as_float(rr[0]) + __uint_as_float(rr[1]); }
  l_reg = l_reg * alpha + ps;
#define PK4(P, BASE, OUT) do { unsigned a0 = cvtpk(P[BASE + 0], P[BASE + 1]), a1 = cvtpk(P[BASE + 2], P[BASE + 3]);   \
    unsigned b0 = cvtpk(P[BASE + 4], P[BASE + 5]), b1 = cvtpk(P[BASE + 6], P[BASE + 7]);                              \
    auto r0 = __builtin_amdgcn_permlane32_swap(a0, b0, false, false); auto r1 = __builtin_amdgcn_permlane32_swap(a1, b1, false, false); \
    u32x4 w = {r0[0], r1[0], r0[1], r1[1]}; OUT = *reinterpret_cast<bf16x8*>(&w); } while (0)
  PK4(p0, 0, pa0); PK4(p0, 8, pa1); PK4(p1, 0, pa2); PK4(p1, 8, pa3);
#undef PK4
}
template <int DK> __device__ __forceinline__ void qkt(f32x16& p0, f32x16& p1, const char* Ks, const bf16x8* qr, int r32, int hi) {
  p0 = f32x16{}; p1 = f32x16{};
#pragma unroll
  for (int d0 = 0; d0 < DK / 16; ++d0) { const int cb = (d0 * 16 + hi * 8) * 2;
    bf16x8 b0 = *reinterpret_cast<const bf16x8*>(Ks + KCfg<DK>::swz(r32, cb));
    bf16x8 b1 = *reinterpret_cast<const bf16x8*>(Ks + KCfg<DK>::swz(32 + r32, cb));
    p0 = __builtin_amdgcn_mfma_f32_32x32x16_bf16(b0, qr[d0], p0, 0, 0, 0);
    p1 = __builtin_amdgcn_mfma_f32_32x32x16_bf16(b1, qr[d0], p1, 0, 0, 0); }
}
__device__ __forceinline__ int v_st(int k, int c) { const int kk = (k & ~0xC) | ((k & 4) << 1) | ((k & 8) >> 1); return ((kk >> 3) * 2 + (c >> 5)) * 512 + ((kk & 7) * 32 + (c & 31)) * 2; }
__device__ __forceinline__ int v_rd_base(int lane) { return ((lane & 3) << 3) | (((lane >> 2) & 3) << 6) | (((lane >> 4) & 1) << 5) | (((lane >> 5) & 1) << 8); }
constexpr int v_rd_off(int d0, int ks, int half) { return d0 * 512 + ks * 2048 + half * 1024; }
template <int OFF> __device__ __forceinline__ s16x4 tr_read(int vb) {
  s16x4 r; asm volatile("ds_read_b64_tr_b16 %0, %1 offset:%2" : "=&v"(r) : "v"(vb), "i"(OFF) : "memory"); return r;
}
template <int D0> __device__ __forceinline__ void pv_one(f32x16& od, int vb, bf16x8 pa0, bf16x8 pa1, bf16x8 pa2, bf16x8 pa3) {
  const s16x4 l0 = tr_read<v_rd_off(D0, 0, 0)>(vb), h0 = tr_read<v_rd_off(D0, 0, 1)>(vb), l1 = tr_read<v_rd_off(D0, 1, 0)>(vb), h1 = tr_read<v_rd_off(D0, 1, 1)>(vb);
  const s16x4 l2 = tr_read<v_rd_off(D0, 2, 0)>(vb), h2 = tr_read<v_rd_off(D0, 2, 1)>(vb), l3 = tr_read<v_rd_off(D0, 3, 0)>(vb), h3 = tr_read<v_rd_off(D0, 3, 1)>(vb);
  asm volatile("s_waitcnt lgkmcnt(0)" ::: "memory"); SBAR();
#define PK(L, H) (bf16x8){L[0], L[1], L[2], L[3], H[0], H[1], H[2], H[3]}
  od = __builtin_amdgcn_mfma_f32_32x32x16_bf16(pa0, PK(l0, h0), od, 0, 0, 0);
  od = __builtin_amdgcn_mfma_f32_32x32x16_bf16(pa1, PK(l1, h1), od, 0, 0, 0);
  od = __builtin_amdgcn_mfma_f32_32x32x16_bf16(pa2, PK(l2, h2), od, 0, 0, 0);
  od = __builtin_amdgcn_mfma_f32_32x32x16_bf16(pa3, PK(l3, h3), od, 0, 0, 0);
#undef PK
}
__device__ __forceinline__ void pv_d0(f32x16* o, int vb, bf16x8 pa0, bf16x8 pa1, bf16x8 pa2, bf16x8 pa3) {
  pv_one<0>(o[0], vb, pa0, pa1, pa2, pa3); pv_one<1>(o[1], vb, pa0, pa1, pa2, pa3);
}
constexpr int SEQK = 2048, KVBLK = 64, NT = SEQK / KVBLK, SHM_V = 64 * 64 * 2;
constexpr int LDS_BYTES = 2 * SHM_V + 2 * (64 * 96 * 2) + 2048 + 8 * 4096;
template <int DK>
__device__ __forceinline__ void attn_unit(const bf16_t* __restrict__ Qb, int ldq, const bf16_t* __restrict__ Kh, int ldk, const bf16_t* __restrict__ Vh, int ldv, bf16_t* __restrict__ Ob, int ldo, char* lds) {
  constexpr int KCH = DK / 8, SHM_K = 64 * DK * 2; constexpr bool K2 = (64 * KCH > 512);
  const int tid = threadIdx.x, wid = tid >> 6, lane = tid & 63, r32 = lane & 31, hi = lane >> 5;
  char* V_lds = lds; char* K_lds = lds + 2 * SHM_V;
  float* ws = (float*)(lds + 2 * SHM_V + 2 * SHM_K) + wid * 64; float* li_l = ws; float* al_l = ws + 32;
  bf16_t* stg = (bf16_t*)(lds + 2 * SHM_V + 2 * SHM_K + 2048) + wid * 2048;
  float m_reg = -1e30f, l_reg = 0; f32x16 o[2] = {}; bf16x8 qr[DK / 16];
  const bf16_t* Qw = Qb + (long)(wid * 32 + r32) * ldq + hi * 8;
#pragma unroll
  for (int d0 = 0; d0 < DK / 16; ++d0) qr[d0] = *reinterpret_cast<const bf16x8*>(Qw + d0 * 16);
  const int kr0 = tid / KCH, kc0 = (tid % KCH) * 8, kr1 = (tid + 512) / KCH, kc1 = ((tid + 512) % KCH) * 8; const bool has2 = K2 && (tid < 64 * KCH - 512);
  const int vr = tid >> 3, vc = (tid & 7) * 8, vst0 = v_st(vr, vc);
  const int vb0 = (int)(uintptr_t)V_lds + v_rd_base(lane);
  bf16x8 sk0, sk1, sv0;
#define SLOAD(k0) do { sk0 = *reinterpret_cast<const bf16x8*>(&Kh[(long)((k0) + kr0) * ldk + kc0]); if (has2) sk1 = *reinterpret_cast<const bf16x8*>(&Kh[(long)((k0) + kr1) * ldk + kc1]); \
    sv0 = *reinterpret_cast<const bf16x8*>(&Vh[(long)((k0) + vr) * ldv + vc]); } while (0)
#define SWRITE(b) do { *(bf16x8*)(K_lds + (b) * SHM_K + KCfg<DK>::swz(kr0, kc0 * 2)) = sk0; if (has2) *(bf16x8*)(K_lds + (b) * SHM_K + KCfg<DK>::swz(kr1, kc1 * 2)) = sk1; \
    *(bf16x8*)(V_lds + (b) * SHM_V + vst0) = sv0; } while (0)
#define SWAIT() asm volatile("s_waitcnt vmcnt(0)" ::: "memory")
#define RESC(a) do { if (__any((a) < 1.f)) { if (hi == 0) al_l[r32] = (a); asm volatile("s_waitcnt lgkmcnt(0)" ::: "memory"); \
    _Pragma("unroll") for (int d = 0; d < 2; ++d) _Pragma("unroll") for (int r = 0; r < 16; ++r) o[d][r] *= al_l[crow(r, hi)]; } } while (0)
  f32x16 pA0, pA1, pB0, pB1; float mnA, mnB, alA, alB; bf16x8 pa0, pa1, pa2, pa3;
  SLOAD(0); SWAIT(); SWRITE(0); __syncthreads();
  qkt<DK>(pA0, pA1, K_lds, qr, r32, hi); partialSM<DK>(pA0, pA1, m_reg, mnA, alA);
  SLOAD(KVBLK);
  SWAIT(); SWRITE(1); __syncthreads();
  for (int j = 1; j + 1 < NT; j += 2) {
    SBAR(); qkt<DK>(pB0, pB1, K_lds + SHM_K, qr, r32, hi);
    finishSM(pA0, pA1, alA, l_reg, pa0, pa1, pa2, pa3); SBAR();
    SLOAD((j + 1) * KVBLK); SBAR();
    pv_d0(o, vb0, pa0, pa1, pa2, pa3); partialSM<DK>(pB0, pB1, m_reg, mnB, alB);
    __syncthreads(); SWAIT(); SWRITE(0);
    RESC(alB); __syncthreads();
    SBAR(); qkt<DK>(pA0, pA1, K_lds, qr, r32, hi);
    finishSM(pB0, pB1, alB, l_reg, pa0, pa1, pa2, pa3); SBAR();
    SLOAD((j + 2) * KVBLK); SBAR();
    pv_d0(o, vb0 + SHM_V, pa0, pa1, pa2, pa3); partialSM<DK>(pA0, pA1, m_reg, mnA, alA);
    __syncthreads(); SWAIT(); SWRITE(1);
    RESC(alA); __syncthreads();
  }
  SBAR(); qkt<DK>(pB0, pB1, K_lds + SHM_K, qr, r32, hi);
  finishSM(pA0, pA1, alA, l_reg, pa0, pa1, pa2, pa3); SBAR();
  pv_d0(o, vb0, pa0, pa1, pa2, pa3); partialSM<DK>(pB0, pB1, m_reg, mnB, alB);
  __syncthreads(); RESC(alB);
  finishSM(pB0, pB1, alB, l_reg, pa0, pa1, pa2, pa3); SBAR();
  pv_d0(o, vb0 + SHM_V, pa0, pa1, pa2, pa3);
  if (hi == 0) li_l[r32] = l_reg; asm volatile("s_waitcnt lgkmcnt(0)" ::: "memory");
  float rli[16];
#pragma unroll
  for (int r = 0; r < 16; ++r) rli[r] = __builtin_amdgcn_rcpf(li_l[crow(r, hi)]);
#pragma unroll
  for (int r = 0; r < 16; ++r) { const int orow = crow(r, hi);
#pragma unroll
    for (int d0 = 0; d0 < 2; ++d0) { const unsigned w = cvtpk(o[d0][r] * rli[r], 0.f); stg[orow * 64 + d0 * 32 + r32] = (bf16_t)(w & 0xffffu); } }
  asm volatile("s_waitcnt lgkmcnt(0)" ::: "memory");
  bf16_t* Ow = Ob + (long)(wid * 32) * ldo;
#pragma unroll
  for (int i = 0; i < 4; ++i) { const int row = i * 8 + (lane >> 3), ch = lane & 7; const u32x4 v = *(const u32x4*)(stg + row * 64 + ch * 8); *(u32x4*)(Ow + (long)row * ldo + ch * 8) = v; }
  __syncthreads();
#undef SLOAD
#undef SWRITE
#undef SWAIT
#undef RESC
}
#undef SBAR
}

constexpr int NWAVES = 8;
constexpr int NB = 16, SEQ = 2048, DM = 1024, T = NB * SEQ;
constexpr int INW = 1312, INWP = 1536;
constexpr int NE = 16, CAP = 256, FF = 2816, PLE = 256;
constexpr int UQW = 768, UKVW = 1024;
constexpr float ALPHA = 1.189207115002721f;
constexpr float LN_EPS = 1e-5f, RMS_EPS = 1e-6f;

constexpr size_t MiB = 1u << 20;
constexpr size_t WS_CTL = 0;
constexpr size_t WS_WIN = 1 * MiB;
constexpr size_t WS_WUQ = 4 * MiB;
constexpr size_t WS_WUKV = 4 * MiB + 512 * 1024;
constexpr size_t WS_WOUT = 5 * MiB;
constexpr size_t WS_WPG = 7 * MiB;
constexpr size_t WS_WPP = 9 * MiB;
constexpr size_t WS_WRT = 9 * MiB + 512 * 1024;
constexpr size_t WS_AFF = 10 * MiB;
constexpr size_t WS_ROWMAP = 12 * MiB;
constexpr size_t WS_GVAL = 12 * MiB + 256 * 1024;
constexpr size_t WS_SEL = 12 * MiB + 512 * 1024;
constexpr size_t WS_WGU = 16 * MiB;
constexpr size_t WS_YEXP = 16 * MiB, WS_PB = 144 * MiB;
constexpr size_t WS_WDN = 192 * MiB;
constexpr size_t WS_X1B = 280 * MiB;
constexpr size_t WS_QMLA = 280 * MiB;
constexpr size_t WS_R1 = 344 * MiB;
constexpr size_t WS_XB = WS_R1;
constexpr size_t WS_PROJ = WS_R1 + 64 * MiB;
constexpr size_t WS_QG = WS_R1 + 256 * MiB, WS_KG = WS_QG + 32 * MiB, WS_VG = WS_KG + 8 * MiB, WS_CQ = WS_VG + 8 * MiB, WS_CKV = WS_CQ + 16 * MiB, WS_KPE = WS_CKV + 16 * MiB;
constexpr size_t WS_QM = WS_R1;
constexpr size_t WS_KV = WS_R1 + 96 * MiB;
constexpr size_t WS_VMLA = WS_R1 + 224 * MiB;
constexpr size_t WS_O = WS_R1;
constexpr size_t WS_H = WS_R1;
constexpr size_t WS_E = WS_R1, WS_G = WS_R1 + 128 * MiB;
constexpr size_t WS_END = 704 * MiB;
static_assert(WS_KPE + 2 * MiB <= WS_END && WS_H + (size_t)65536 * FF * 2 <= WS_END && WS_VMLA + 32 * MiB <= WS_QG, "d_ws map");

constexpr int LDS_BYTES = 147456;
static_assert(att::LDS_BYTES <= 131072, "attention LDS");

#define LAS __attribute__((address_space(3)))
typedef unsigned short bf16;
typedef unsigned v4u __attribute__((ext_vector_type(4)));
typedef unsigned v2u __attribute__((ext_vector_type(2)));
typedef float f32x4 __attribute__((ext_vector_type(4)));
__device__ __forceinline__ unsigned f2bf(float f) { unsigned u = __builtin_bit_cast(unsigned, f); return (u + 0x7fffu + ((u >> 16) & 1u)) >> 16; }
__device__ __forceinline__ unsigned pk2(float lo, float hi) { return f2bf(lo) | (f2bf(hi) << 16); }
__device__ __forceinline__ float bf2f(unsigned h) { return __builtin_bit_cast(float, h << 16); }
__device__ __forceinline__ float wave_sum(float v) {
#pragma unroll
    for (int o = 1; o < 64; o <<= 1) v += __shfl_xor(v, o);
    return v;
}
__device__ __forceinline__ float wave_max(float v) {
#pragma unroll
    for (int o = 1; o < 64; o <<= 1) v = fmaxf(v, __shfl_xor(v, o));
    return v;
}

struct Args { const float* in[22]; float* out; unsigned char* ws; int ph_lo, ph_hi; };
enum { I_X = 0, I_P, I_WIN, I_QN, I_KN, I_CQN, I_CKVN, I_WUQ, I_WUKV, I_WOUT, I_LNAG, I_LNAB, I_WR, I_WG, I_WU, I_WD, I_LNFG, I_LNFB, I_WPP, I_WPG, I_LNPG, I_LNPB };

struct Frame { LAS unsigned char* lds; int tid, lane, wave, vcu, G; };

__device__ __forceinline__ void tr_item(const float* W, int N, int k0, int n0, bf16* WT, int K, long dst_row0, LAS float* scr, int lane) {
#pragma unroll 8
    for (int i = 0; i < 32; ++i) { const int kk = 2 * i + (lane >> 5); scr[kk * 33 + (lane & 31)] = W[(size_t)(k0 + kk) * N + n0 + (lane & 31)]; }
    asm volatile("s_waitcnt lgkmcnt(0)" ::: "memory");
    const int c = lane & 7;
#pragma unroll
    for (int j = 0; j < 4; ++j) { const int n = (lane >> 3) + 8 * j; const LAS float* s = scr + (8 * c) * 33 + n;
        v4u o; o.x = pk2(s[0 * 33], s[1 * 33]); o.y = pk2(s[2 * 33], s[3 * 33]); o.z = pk2(s[4 * 33], s[5 * 33]); o.w = pk2(s[6 * 33], s[7 * 33]);
        *(v4u*)(WT + (size_t)(dst_row0 + n) * K + k0 + 8 * c) = o; }
    asm volatile("s_waitcnt lgkmcnt(0)" ::: "memory");
}
__device__ __forceinline__ void tr_dense(const float* W, int K, int N, bf16* WT, int r, LAS float* scr, int lane) {
    const int nblk = N / 32, kb = r / nblk, nb = r % nblk; tr_item(W, N, 64 * kb, 32 * nb, WT, K, 32 * nb, scr, lane);
}
__device__ __forceinline__ void p0_convert(const Frame& F, const Args& a) {
    LAS float* scr = (LAS float*)(F.lds + F.wave * 16384);
    const int gw = F.vcu * NWAVES + F.wave, NGW = F.G * NWAVES;
    unsigned char* ws = a.ws;
    constexpr int I_IN = (DM / 64) * (INW / 32), I_UQ = (256 / 64) * (UQW / 32), I_UKV = (256 / 64) * (UKVW / 32), I_OUT = (DM / 64) * (DM / 32), I_PG = I_OUT, I_PP = (PLE / 64) * (DM / 32);
    constexpr int I_GE = (DM / 64) * (FF / 32), I_DE = (FF / 64) * (DM / 32);
    constexpr int NITEMS = I_IN + I_UQ + I_UKV + I_OUT + I_PG + I_PP + 2 * NE * I_GE + NE * I_DE;
    for (int it = gw; it < NITEMS; it += NGW) {
        int r = it;
        if (r < I_IN) { tr_dense(a.in[I_WIN], DM, INW, (bf16*)(ws + WS_WIN), r, scr, F.lane); continue; } r -= I_IN;
        if (r < I_UQ) { tr_dense(a.in[I_WUQ], 256, UQW, (bf16*)(ws + WS_WUQ), r, scr, F.lane); continue; } r -= I_UQ;
        if (r < I_UKV) { tr_dense(a.in[I_WUKV], 256, UKVW, (bf16*)(ws + WS_WUKV), r, scr, F.lane); continue; } r -= I_UKV;
        if (r < I_OUT) { tr_dense(a.in[I_WOUT], DM, DM, (bf16*)(ws + WS_WOUT), r, scr, F.lane); continue; } r -= I_OUT;
        if (r < I_PG) { tr_dense(a.in[I_WPG], DM, DM, (bf16*)(ws + WS_WPG), r, scr, F.lane); continue; } r -= I_PG;
        if (r < I_PP) { tr_dense(a.in[I_WPP], PLE, DM, (bf16*)(ws + WS_WPP), r, scr, F.lane); continue; } r -= I_PP;
        if (r < 2 * NE * I_GE) {
            const int which = r / (NE * I_GE); r -= which * NE * I_GE; const int e = r / I_GE; r -= e * I_GE;
            const int nblk = FF / 32, kb = r / nblk, nb = r % nblk, n0 = 32 * nb;
            const float* W = a.in[which ? I_WU : I_WG] + (size_t)e * DM * FF;
            tr_item(W, FF, 64 * kb, n0, (bf16*)(ws + WS_WGU), DM, (long)e * (2 * FF) + (n0 / 128) * 256 + (n0 % 128) + (which ? 128 : 0), scr, F.lane); continue; }
        r -= 2 * NE * I_GE;
        { const int e = r / I_DE; r -= e * I_DE; const int nblk = DM / 32, kb = r / nblk, nb = r % nblk;
          tr_item(a.in[I_WD] + (size_t)e * FF * DM, DM, 64 * kb, 32 * nb, (bf16*)(ws + WS_WDN), FF, (long)e * DM + 32 * nb, scr, F.lane); }
    }
    { v4u* z = (v4u*)(ws + WS_WIN + (size_t)INW * DM * 2); const int n16 = (INWP - INW) * DM * 2 / 16;
      for (int i = (F.vcu * NWAVES + F.wave) * 64 + F.lane; i < n16; i += NGW * 64) z[i] = (v4u){0u, 0u, 0u, 0u}; }
    { float* wrt = (float*)(ws + WS_WRT); const float* wr = a.in[I_WR];
      for (int i = (F.vcu * NWAVES + F.wave) * 64 + F.lane; i < NE * DM; i += NGW * 64) { const int e = i / DM, k = i % DM; wrt[i] = wr[k * NE + e]; } }
    { const float* x = a.in[I_X]; bf16* xb = (bf16*)(ws + WS_XB);
      for (int m = gw; m < T; m += NGW) { const f32x4* xr = (const f32x4*)(x + (size_t)m * DM) + F.lane; v2u* o = (v2u*)(xb + (size_t)m * DM) + F.lane;
#pragma unroll
          for (int j = 0; j < 4; ++j) { const f32x4 v = xr[64 * j]; o[64 * j] = (v2u){pk2(v.x, v.y), pk2(v.z, v.w)}; } } }
}

__device__ __forceinline__ float rope_apply(float y, float yp, bool second, float pos, float invf) {
    float rev = pos * invf * 0.15915494309189535f; rev = rev - floorf(rev);
    const float s = __builtin_amdgcn_sinf(rev), c = __builtin_amdgcn_cosf(rev);
    return second ? y * c + yp * s : y * c - yp * s;
}

__device__ __forceinline__ void p2_qkv_post(const Frame& F, const Args& a) {
    const int gw = F.vcu * NWAVES + F.wave, NGW = F.G * NWAVES, l = F.lane;
    unsigned char* ws = a.ws;
    const float* PROJ = (const float*)(ws + WS_PROJ);
    bf16* QG = (bf16*)(ws + WS_QG); bf16* KG = (bf16*)(ws + WS_KG); bf16* VG = (bf16*)(ws + WS_VG); bf16* CQ = (bf16*)(ws + WS_CQ); bf16* CKV = (bf16*)(ws + WS_CKV); bf16* KPE = (bf16*)(ws + WS_KPE);
    const float qn = a.in[I_QN][l], kn = a.in[I_KN][l];
    const float invf64 = exp2f(-(float)(l & 15) * (13.287712379549449f / 16.0f));
    const float invf32 = exp2f(-(float)(l & 7) * (13.287712379549449f / 8.0f));
    for (int m = gw; m < T; m += NGW) {
        const float* pr = PROJ + (size_t)m * INWP; const int t = m & (SEQ - 1);
        const float pos64 = (l & 32) ? (float)(t & 63) : (float)(t >> 6);
        const float pos32 = (l & 16) ? (float)(t & 63) : (float)(t >> 6);
#pragma unroll
        for (int h = 0; h < 10; ++h) {
            const float v = pr[h * 64 + l]; const float ss = wave_sum(v * v);
            const float y = v * (1.0f / sqrtf(ss * (1.0f / 64.0f) + RMS_EPS)) * (h < 8 ? qn : kn);
            const float yp = __shfl_xor(y, 16);
            const float o = rope_apply(y, yp, (l & 16) != 0, pos64, invf64);
            if (h < 8) QG[(size_t)m * 512 + h * 64 + l] = (bf16)f2bf(o); else KG[(size_t)m * 128 + (h - 8) * 64 + l] = (bf16)f2bf(o);
        }
        VG[(size_t)m * 128 + l] = (bf16)f2bf(pr[640 + l]); VG[(size_t)m * 128 + 64 + l] = (bf16)f2bf(pr[704 + l]);
        { float v[4]; float ss = 0.f;
#pragma unroll
          for (int j = 0; j < 4; ++j) { v[j] = pr[768 + l + 64 * j]; ss += v[j] * v[j]; }
          ss = wave_sum(ss); const float rs = 1.0f / sqrtf(ss * (1.0f / 256.0f) + RMS_EPS);
#pragma unroll
          for (int j = 0; j < 4; ++j) CQ[(size_t)m * 256 + l + 64 * j] = (bf16)f2bf(v[j] * rs * a.in[I_CQN][l + 64 * j]); }
        { float v[4]; float ss = 0.f;
#pragma unroll
          for (int j = 0; j < 4; ++j) { v[j] = pr[1024 + l + 64 * j]; ss += v[j] * v[j]; }
          ss = wave_sum(ss); const float rs = 1.0f / sqrtf(ss * (1.0f / 256.0f) + RMS_EPS);
#pragma unroll
          for (int j = 0; j < 4; ++j) CKV[(size_t)m * 256 + l + 64 * j] = (bf16)f2bf(v[j] * rs * a.in[I_CKVN][l + 64 * j]); }
        { const float y = pr[1280 + (l & 31)]; const float yp = __shfl_xor(y, 8);
          const float o = rope_apply(y, yp, (l & 8) != 0, pos32, invf32);
          if (l < 32) KPE[(size_t)m * 32 + l] = (bf16)f2bf(o); }
    }
}
__device__ __forceinline__ void p4_mla_post(const Frame& F, const Args& a) {
    const int gw = F.vcu * NWAVES + F.wave, NGW = F.G * NWAVES, l = F.lane;
    unsigned char* ws = a.ws;
    const float* QM = (const float*)(ws + WS_QM); const float* KV = (const float*)(ws + WS_KV); const bf16* KPE = (const bf16*)(ws + WS_KPE);
    bf16* QMLA = (bf16*)(ws + WS_QMLA); bf16* KMLA = (bf16*)a.out; bf16* VMLA = (bf16*)(ws + WS_VMLA);
    const float invf32 = exp2f(-(float)(l & 7) * (13.287712379549449f / 8.0f));
    for (int m = gw; m < T; m += NGW) {
        const int t = m & (SEQ - 1); const float pos32 = (l & 16) ? (float)(t & 63) : (float)(t >> 6);
        const float* q = QM + (size_t)m * UQW; const float* kv = KV + (size_t)m * UKVW;
        const bf16 kpe = KPE[(size_t)m * 32 + (l & 31)];
#pragma unroll
        for (int h = 0; h < 8; ++h) {
            QMLA[(size_t)m * 768 + h * 96 + l] = (bf16)f2bf(q[h * 96 + l]);
            { const float y = q[h * 96 + 64 + (l & 31)]; const float yp = __shfl_xor(y, 8); const float o = rope_apply(y, yp, (l & 8) != 0, pos32, invf32);
              if (l < 32) QMLA[(size_t)m * 768 + h * 96 + 64 + l] = (bf16)f2bf(o); }
            KMLA[(size_t)m * 768 + h * 96 + l] = (bf16)f2bf(kv[h * 128 + l]);
            if (l < 32) KMLA[(size_t)m * 768 + h * 96 + 64 + l] = kpe;
            VMLA[(size_t)m * 512 + h * 64 + l] = (bf16)f2bf(kv[h * 128 + 64 + l]);
        }
    }
}
__device__ __forceinline__ void p5_attention(const Frame& F, const Args& a) {
    unsigned char* ws = a.ws; char* lds = (char*)F.lds;
    const bf16* QG = (const bf16*)(ws + WS_QG); const bf16* KG = (const bf16*)(ws + WS_KG); const bf16* VG = (const bf16*)(ws + WS_VG);
    const bf16* QMLA = (const bf16*)(ws + WS_QMLA); const bf16* KMLA = (const bf16*)a.out; const bf16* VMLA = (const bf16*)(ws + WS_VMLA);
    bf16* O = (bf16*)(ws + WS_O);
    for (int U = F.vcu; U < 2048; U += F.G) {
        if (U < 1024) { const int qb = U & 7, hq = (U >> 3) & 7, kvh = hq >> 2, b = U >> 6; const size_t r0 = (size_t)b * SEQ + qb * 256;
            att::attn_unit<64>(QG + r0 * 512 + hq * 64, 512, KG + (size_t)b * SEQ * 128 + kvh * 64, 128, VG + (size_t)b * SEQ * 128 + kvh * 64, 128, O + r0 * 1024 + hq * 64, 1024, lds); }
        else { const int V = U - 1024, qb = V & 7, h = (V >> 3) & 7, b = V >> 6; const size_t r0 = (size_t)b * SEQ + qb * 256;
            att::attn_unit<96>(QMLA + r0 * 768 + h * 96, 768, KMLA + (size_t)b * SEQ * 768 + h * 96, 768, VMLA + (size_t)b * SEQ * 512 + h * 64, 512, O + r0 * 1024 + 512 + h * 64, 1024, lds); }
    }
}
__device__ __forceinline__ void ln_row(f32x4 (&v)[4], const float* g, const float* bta, int lane) {
    float s = 0.f;
#pragma unroll
    for (int j = 0; j < 4; ++j) s += (v[j].x + v[j].y) + (v[j].z + v[j].w);
    const float mean = wave_sum(s) * (1.f / DM); float s2 = 0.f;
#pragma unroll
    for (int j = 0; j < 4; ++j) { v[j] = v[j] - mean; s2 += (v[j].x * v[j].x + v[j].y * v[j].y) + (v[j].z * v[j].z + v[j].w * v[j].w); }
    const float rstd = 1.f / sqrtf(wave_sum(s2) * (1.f / DM) + LN_EPS);
#pragma unroll
    for (int j = 0; j < 4; ++j) { const f32x4 gg = *((const f32x4*)g + lane + 64 * j), bb = *((const f32x4*)bta + lane + 64 * j); v[j] = v[j] * rstd * gg + bb; }
}
__device__ __forceinline__ void p7_ln1_router(const Frame& F, const Args& a) {
    const int gw = F.vcu * NWAVES + F.wave, NGW = F.G * NWAVES, l = F.lane;
    unsigned char* ws = a.ws; const float* x = a.in[I_X]; float* xo = a.out; bf16* x1b = (bf16*)(ws + WS_X1B); float* aff = (float*)(ws + WS_AFF);
    const f32x4* wrt = (const f32x4*)(ws + WS_WRT);
    for (int m = gw; m < T; m += NGW) {
        f32x4 v[4];
#pragma unroll
        for (int j = 0; j < 4; ++j) { const f32x4 xv = *((const f32x4*)(x + (size_t)m * DM) + l + 64 * j), mv = *((const f32x4*)(xo + (size_t)m * DM) + l + 64 * j); v[j] = xv * ALPHA + mv; }
        ln_row(v, a.in[I_LNAG], a.in[I_LNAB], l);
#pragma unroll
        for (int j = 0; j < 4; ++j) { *((f32x4*)(xo + (size_t)m * DM) + l + 64 * j) = v[j]; *((v2u*)(x1b + (size_t)m * DM) + l + 64 * j) = (v2u){pk2(v[j].x, v[j].y), pk2(v[j].z, v[j].w)}; }
        float lg[NE]; float mx = -1e30f;
#pragma unroll
        for (int e = 0; e < NE; ++e) { float s = 0.f;
#pragma unroll
            for (int j = 0; j < 4; ++j) { const f32x4 w = wrt[e * (DM / 4) + l + 64 * j]; s += (v[j].x * w.x + v[j].y * w.y) + (v[j].z * w.z + v[j].w * w.w); }
            lg[e] = wave_sum(s); mx = fmaxf(mx, lg[e]); }
        float den = 0.f;
#pragma unroll
        for (int e = 0; e < NE; ++e) { lg[e] = expf(lg[e] - mx); den += lg[e]; }
        const float inv = 1.0f / den; float mine = 0.f;
#pragma unroll
        for (int e = 0; e < NE; ++e) mine = (l == e) ? lg[e] * inv : mine;
        const int b = m >> 11, s_ = m & (SEQ - 1);
        if (l < NE) aff[((size_t)b * NE + l) * SEQ + s_] = mine;
    }
}
__device__ __forceinline__ unsigned block_excl_scan(const Frame& F, unsigned cnt, LAS unsigned* wsum, unsigned& total) {
    unsigned inc = cnt;
#pragma unroll
    for (int o = 1; o < 64; o <<= 1) { const unsigned t = __shfl_up(inc, o); if (F.lane >= o) inc += t; }
    __syncthreads();
    if (F.lane == 63) wsum[F.wave] = inc;
    __syncthreads();
    unsigned base = 0, tot = 0;
#pragma unroll
    for (int w = 0; w < NWAVES; ++w) { const unsigned s = wsum[w]; if (w < F.wave) base += s; tot += s; }
    total = tot; return base + inc - cnt;
}
__device__ __forceinline__ void p8_topk(const Frame& F, const Args& a) {
    unsigned char* ws = a.ws; const float* aff = (const float*)(ws + WS_AFF);
    int* rowmap = (int*)(ws + WS_ROWMAP); float* gval = (float*)(ws + WS_GVAL); int* sel = (int*)(ws + WS_SEL);
    LAS unsigned* hist = (LAS unsigned*)F.lds; LAS unsigned* wsum = hist + 256; LAS unsigned* bc = hist + 272;
    for (int task = F.vcu; task < NB * NE; task += F.G) {
        const int b = task / NE, e = task % NE;
        const f32x4 vv = *((const f32x4*)(aff + (size_t)task * SEQ) + F.tid);
        const float vf[4] = {vv.x, vv.y, vv.z, vv.w}; unsigned u[4];
#pragma unroll
        for (int i = 0; i < 4; ++i) u[i] = __builtin_bit_cast(unsigned, vf[i]);
        unsigned prefix = 0, kneed = CAP;
#pragma unroll 1
        for (int pass = 0; pass < 4; ++pass) {
            const int shift = 24 - 8 * pass;
            __syncthreads();
            if (F.tid < 256) hist[F.tid] = 0u;
            __syncthreads();
#pragma unroll
            for (int i = 0; i < 4; ++i) { const bool in = (pass == 0) || ((u[i] >> (shift + 8)) == prefix); if (in) atomicAdd((unsigned*)&hist[(u[i] >> shift) & 255u], 1u); }
            __syncthreads();
            if (F.wave == 0) {
                unsigned h0 = hist[4 * F.lane], h1 = hist[4 * F.lane + 1], h2 = hist[4 * F.lane + 2], h3 = hist[4 * F.lane + 3];
                const unsigned tl = h0 + h1 + h2 + h3; unsigned suf = tl;
#pragma unroll
                for (int o = 1; o < 64; o <<= 1) { const unsigned t = __shfl_down(suf, o); if (F.lane + o < 64) suf += t; }
                const unsigned above = suf - tl;
                const unsigned a3 = above, a2 = above + h3, a1 = a2 + h2, a0 = a1 + h1;
                int found = -1; unsigned nk = 0;
                if (a3 < kneed && kneed <= a3 + h3) { found = 4 * F.lane + 3; nk = kneed - a3; }
                else if (a2 < kneed && kneed <= a2 + h2) { found = 4 * F.lane + 2; nk = kneed - a2; }
                else if (a1 < kneed && kneed <= a1 + h1) { found = 4 * F.lane + 1; nk = kneed - a1; }
                else if (a0 < kneed && kneed <= a0 + h0) { found = 4 * F.lane; nk = kneed - a0; }
                if (found >= 0) { bc[0] = (unsigned)found; bc[1] = nk; }
            }
            __syncthreads();
            prefix = (prefix << 8) | bc[0]; kneed = bc[1];
        }
        unsigned ceq = 0;
#pragma unroll
        for (int i = 0; i < 4; ++i) ceq += (u[i] == prefix) ? 1u : 0u;
        unsigned tot; unsigned eqbase = block_excl_scan(F, ceq, wsum, tot);
        bool take[4]; unsigned csel = 0;
#pragma unroll
        for (int i = 0; i < 4; ++i) { const bool eq = (u[i] == prefix); take[i] = (u[i] > prefix) || (eq && eqbase < kneed); if (eq) ++eqbase; csel += take[i] ? 1u : 0u; }
        unsigned slot = block_excl_scan(F, csel, wsum, tot);
#pragma unroll
        for (int i = 0; i < 4; ++i) { const int tkn = F.tid * 4 + i; int sv = -1;
            if (take[i]) { sv = (int)slot; const size_t r = (size_t)e * (NB * CAP) + b * CAP + slot; rowmap[r] = b * SEQ + tkn; gval[r] = vf[i]; ++slot; }
            sel[((size_t)b * SEQ + tkn) * NE + e] = sv; }
    }
}
__device__ __forceinline__ void p11_ln2(const Frame& F, const Args& a) {
    const int gw = F.vcu * NWAVES + F.wave, NGW = F.G * NWAVES, l = F.lane;
    unsigned char* ws = a.ws; float* xo = a.out; bf16* x2b = (bf16*)(ws + WS_X1B); const bf16* yexp = (const bf16*)(ws + WS_YEXP); const int* sel = (const int*)(ws + WS_SEL);
    const float* p = a.in[I_P]; bf16* pb = (bf16*)(ws + WS_PB);
    for (int m = gw; m < T; m += NGW) {
        const int b = m >> 11;
        f32x4 v[4];
#pragma unroll
        for (int j = 0; j < 4; ++j) v[j] = *((const f32x4*)(xo + (size_t)m * DM) + l + 64 * j) * ALPHA;
        const int sv = (l < NE) ? sel[(size_t)m * NE + l] : -1;
#pragma unroll 1
        for (int e = 0; e < NE; ++e) { const int c = __shfl(sv, e); if (c >= 0) { const bf16* yr = yexp + ((size_t)e * (NB * CAP) + b * CAP + c) * DM;
#pragma unroll
            for (int j = 0; j < 4; ++j) { const v2u w = *((const v2u*)yr + l + 64 * j); v[j].x += bf2f(w.x & 0xffffu); v[j].y += bf2f(w.x >> 16); v[j].z += bf2f(w.y & 0xffffu); v[j].w += bf2f(w.y >> 16); } } }
        ln_row(v, a.in[I_LNFG], a.in[I_LNFB], l);
#pragma unroll
        for (int j = 0; j < 4; ++j) { *((f32x4*)(xo + (size_t)m * DM) + l + 64 * j) = v[j]; *((v2u*)(x2b + (size_t)m * DM) + l + 64 * j) = (v2u){pk2(v[j].x, v[j].y), pk2(v[j].z, v[j].w)}; }
        { const f32x4 pv = *((const f32x4*)(p + (size_t)m * PLE) + l); *((v2u*)(pb + (size_t)m * PLE) + l) = (v2u){pk2(pv.x, pv.y), pk2(pv.z, pv.w)}; }
    }
}
__device__ __forceinline__ void p13_ln3(const Frame& F, const Args& a) {
    const int gw = F.vcu * NWAVES + F.wave, NGW = F.G * NWAVES, l = F.lane;
    unsigned char* ws = a.ws; float* xo = a.out; const float* E = (const float*)(ws + WS_E); const float* Gt = (const float*)(ws + WS_G);
    for (int m = gw; m < T; m += NGW) {
        f32x4 v[4];
#pragma unroll
        for (int j = 0; j < 4; ++j) { const f32x4 xv = *((const f32x4*)(xo + (size_t)m * DM) + l + 64 * j), ev = *((const f32x4*)(E + (size_t)m * DM) + l + 64 * j), gv = *((const f32x4*)(Gt + (size_t)m * DM) + l + 64 * j);
            f32x4 sg; sg.x = 1.0f / (1.0f + expf(-gv.x)); sg.y = 1.0f / (1.0f + expf(-gv.y)); sg.z = 1.0f / (1.0f + expf(-gv.z)); sg.w = 1.0f / (1.0f + expf(-gv.w));
            v[j] = xv * ALPHA + sg * ev; }
        ln_row(v, a.in[I_LNPG], a.in[I_LNPB], l);
#pragma unroll
        for (int j = 0; j < 4; ++j) *((f32x4*)(xo + (size_t)m * DM) + l + 64 * j) = v[j];
    }
}

__global__ void __launch_bounds__(NWAVES * 64, 2) fwd(Args args) {
    extern __shared__ __attribute__((aligned(16))) unsigned char lds[];
    Frame F;
    F.lds = (LAS unsigned char*)lds; F.tid = threadIdx.x; F.lane = F.tid & 63; F.wave = __builtin_amdgcn_readfirstlane(F.tid >> 6);
    F.G = gridDim.x; { const int bx = blockIdx.x; F.vcu = (F.G % 8 == 0) ? (bx % 8) * (F.G / 8) + bx / 8 : bx; }
    unsigned char* ws = args.ws;
    const int lo = args.ph_lo, hi = args.ph_hi;
#define IN(k) (lo <= (k) && (k) < hi)
    if (IN(0)) p0_convert(F, args);
    if (IN(1)) { pg8::Gemm g{(const bf16*)(ws + WS_XB), (const bf16*)(ws + WS_WIN), T, INWP, DM}; pg8::StaticOrder S; S.init(T, INWP, F.G, (int)blockIdx.x);
        pg8::EpiF32 E{(float*)(ws + WS_PROJ), INWP}; pg8::gemm_phase<pg8::EpiF32, pg8::StaticOrder, true>(F.lds, g, S, E); }
    if (IN(2)) p2_qkv_post(F, args);
    if (IN(3)) {
        { pg8::Gemm g{(const bf16*)(ws + WS_CQ), (const bf16*)(ws + WS_WUQ), T, UQW, 256}; pg8::StaticOrder S; S.init(T, UQW, F.G, (int)blockIdx.x);
          pg8::EpiF32 E{(float*)(ws + WS_QM), UQW}; pg8::gemm_phase<pg8::EpiF32, pg8::StaticOrder, true>(F.lds, g, S, E); }
        { pg8::Gemm g{(const bf16*)(ws + WS_CKV), (const bf16*)(ws + WS_WUKV), T, UKVW, 256}; pg8::StaticOrder S; S.init(T, UKVW, F.G, (int)blockIdx.x);
          pg8::EpiF32 E{(float*)(ws + WS_KV), UKVW}; pg8::gemm_phase<pg8::EpiF32, pg8::StaticOrder, true>(F.lds, g, S, E); }
    }
    if (IN(4)) p4_mla_post(F, args);
    if (IN(5)) p5_attention(F, args);
    if (IN(6)) { pg8::Gemm g{(const bf16*)(ws + WS_O), (const bf16*)(ws + WS_WOUT), T, DM, DM}; pg8::StaticOrder S; S.init(T, DM, F.G, (int)blockIdx.x);
        pg8::EpiF32 E{args.out, DM}; pg8::gemm_phase<pg8::EpiF32, pg8::StaticOrder, true>(F.lds, g, S, E); }
    if (IN(7)) p7_ln1_router(F, args);
    if (IN(8)) p8_topk(F, args);
    if (IN(9)) { pg8::Gemm g{(const bf16*)(ws + WS_X1B), (const bf16*)(ws + WS_WGU), NE * NB * CAP, 2 * FF, DM}; pg8::GatherOrder S; S.init(NE * NB * CAP, 2 * FF, F.G, (int)blockIdx.x, NB * CAP / 256); S.rowmap = (const int*)(ws + WS_ROWMAP);
        pg8::EpiSwiGLU E{(bf16*)(ws + WS_H), FF}; pg8::gemm_phase<pg8::EpiSwiGLU, pg8::GatherOrder, true>(F.lds, g, S, E); }
    if (IN(10)) { pg8::Gemm g{(const bf16*)(ws + WS_H), (const bf16*)(ws + WS_WDN), NE * NB * CAP, DM, FF}; pg8::StaticOrder S; S.init(NE * NB * CAP, DM, F.G, (int)blockIdx.x, NB * CAP / 256);
        pg8::EpiRowScaleBf16 E{(bf16*)(ws + WS_YEXP), DM, (const float*)(ws + WS_GVAL)}; pg8::gemm_phase<pg8::EpiRowScaleBf16, pg8::StaticOrder, true>(F.lds, g, S, E); }
    if (IN(11)) p11_ln2(F, args);
    if (IN(12)) {
        { pg8::Gemm g{(const bf16*)(ws + WS_PB), (const bf16*)(ws + WS_WPP), T, DM, PLE}; pg8::StaticOrder S; S.init(T, DM, F.G, (int)blockIdx.x);
          pg8::EpiF32 E{(float*)(ws + WS_E), DM}; pg8::gemm_phase<pg8::EpiF32, pg8::StaticOrder, true>(F.lds, g, S, E); }
        { pg8::Gemm g{(const bf16*)(ws + WS_X1B), (const bf16*)(ws + WS_WPG), T, DM, DM}; pg8::StaticOrder S; S.init(T, DM, F.G, (int)blockIdx.x);
          pg8::EpiF32 E{(float*)(ws + WS_G), DM}; pg8::gemm_phase<pg8::EpiF32, pg8::StaticOrder, true>(F.lds, g, S, E); }
    }
    if (IN(13)) p13_ln3(F, args);
#undef IN
}

constexpr int NPHASES = 14;
extern "C" void kernel_launch(void* const* d_in, const int* in_sizes, int n_in, void* d_out, int out_size, void* d_ws, size_t ws_size, hipStream_t stream) {
    static int grid = 0;
    if (grid == 0) {
        if (n_in != 22 || in_sizes[0] != T * DM || out_size != T * DM || ws_size < WS_END) { fprintf(stderr, "kernel_launch: unexpected shapes (n_in %d, in0 %d, out %d, ws %zu < %zu?)\n", n_in, n_in > 0 ? in_sizes[0] : -1, out_size, ws_size, (size_t)WS_END); grid = -1; return; }
        if (hipFuncSetAttribute((const void*)fwd, hipFuncAttributeMaxDynamicSharedMemorySize, LDS_BYTES) != hipSuccess) { fprintf(stderr, "kernel_launch: hipFuncSetAttribute failed\n"); grid = -1; return; }
        grid = 256;
    }
    if (grid < 0) return;
    Args a{};
    for (int i = 0; i < 22; ++i) a.in[i] = (const float*)d_in[i];
    a.out = (float*)d_out; a.ws = (unsigned char*)d_ws;
    for (int ph = 0; ph < NPHASES; ++ph) {
        a.ph_lo = ph; a.ph_hi = ph + 1;
        hipLaunchKernelGGL(fwd, dim3(grid), dim3(NWAVES * 64), LDS_BYTES, stream, a);
    }
}
```

```cpp
#include <hip/hip_runtime.h>
#include <cstdio>
#include <cstdint>

#ifndef MK_ONE_LAUNCH
#define MK_ONE_LAUNCH 1
#endif

namespace pg8 {
#define PG8_LAS __attribute__((address_space(3)))
typedef unsigned short bf16_t;
typedef short bf16x8 __attribute__((ext_vector_type(8)));
typedef float f32x4 __attribute__((ext_vector_type(4)));
typedef unsigned u32x4 __attribute__((ext_vector_type(4)));
typedef unsigned u32x2 __attribute__((ext_vector_type(2)));
constexpr int BM = 256, BK = 64, HALF = 128, HTB = HALF * BK * 2  , STAGE_BYTES = 8 * HTB, NXCD = 8, WGM = 8;

__host__ __device__ __forceinline__ int lds_byte(int r, int c) { const int st = (r >> 4) * 2 + (c >> 5), rr = r & 15, cc = c & 31, ob = rr * 64 + cc * 2; return st * 1024 + (ob ^ (((ob >> 9) & 1) << 5)); }
__host__ __device__ __forceinline__ void stage_rc(int b, int& R, int& C) { const int st = b / 1024, sb = b % 1024, swz = sb ^ (((sb >> 9) & 1) << 5); R = (st >> 1) * 16 + swz / 64; C = (st & 1) * 32 + (swz % 64) / 2; }
__host__ __device__ __forceinline__ int perm32(int rho) { const int n = rho >> 4, i = rho & 15; return 8 * (i >> 2) + 4 * n + (i & 3); }

struct Unit { int pm, pn; };
struct Gemm { const bf16_t* A; const bf16_t* Bt; int M, N, K; };

struct StaticOrder {
    static constexpr bool GATHER = false;
    int nM, nN, nwg, G, c, mpe;
    __host__ __device__ void init(int M, int N, int G_, int c_, int mpe_ = 0) { nM = M / BM; nN = N / BM; nwg = nM * nN; G = G_; c = c_; mpe = mpe_; }
    __host__ __device__ bool next(int i, Unit& u) const {
        const long L = (long)i * G + c; if (L >= nwg) return false;
        int wgid = (int)L; { const int q = nwg / NXCD, r = nwg % NXCD, xcd = wgid % NXCD, off = wgid / NXCD; wgid = (xcd < r ? xcd * (q + 1) : r * (q + 1) + (xcd - r) * q) + off; }
        const int nig = WGM * nN, gid = wgid / nig, fm = gid * WGM, gsz = (nM - fm) < WGM ? (nM - fm) : WGM;
        u.pm = fm + ((wgid % nig) % gsz); u.pn = (wgid % nig) / gsz; return true;
    }
    __host__ __device__ __forceinline__ int btile(const Unit& u) const { return mpe ? (u.pm / mpe) * nN + u.pn : u.pn; }
    __device__ __forceinline__ unsigned arow(const Unit&, int) const { return 0u; }
};
struct GatherOrder : StaticOrder {
    static constexpr bool GATHER = true;
    const int* rowmap;
    __device__ __forceinline__ unsigned arow(const Unit& u, int r) const { return (unsigned)rowmap[u.pm * BM + r]; }
};

__device__ __forceinline__ unsigned cvt_pk_bf16(float lo, float hi) { unsigned r; asm volatile("v_cvt_pk_bf16_f32 %0, %1, %2" : "=v"(r) : "v"(lo), "v"(hi)); return r; }

struct EpiF32 {
    static constexpr bool PERM = false;
    float* O; int ldc;
    __device__ __forceinline__ void operator()(const f32x4 (&acc)[2][2][4][2], const Unit& u, int wr, int wc, int fr, int fq) const {
        const int row0 = u.pm * BM + wr * 64 + fr, col0 = u.pn * BM + wc * 32 + 4 * fq;
#pragma unroll
        for (int ai = 0; ai < 2; ++ai)
#pragma unroll
            for (int m = 0; m < 4; ++m) { float* rowp = O + (size_t)(row0 + ai * HALF + m * 16) * ldc + col0;
#pragma unroll
                for (int bj = 0; bj < 2; ++bj)
#pragma unroll
                    for (int n = 0; n < 2; ++n) *(f32x4*)(rowp + bj * HALF + n * 16) = acc[ai][bj][m][n]; }
    }
};
struct EpiSwiGLU {
    static constexpr bool PERM = false;
    bf16_t* H; int ldh;
    __device__ __forceinline__ void operator()(const f32x4 (&acc)[2][2][4][2], const Unit& u, int wr, int wc, int fr, int fq) const {
        const int row0 = u.pm * BM + wr * 64 + fr, col0 = u.pn * HALF + wc * 32 + 4 * fq;
#pragma unroll
        for (int ai = 0; ai < 2; ++ai)
#pragma unroll
            for (int m = 0; m < 4; ++m) { bf16_t* rowp = H + (size_t)(row0 + ai * HALF + m * 16) * ldh + col0;
#pragma unroll
                for (int n = 0; n < 2; ++n) { const f32x4 g = acc[ai][0][m][n], up = acc[ai][1][m][n]; float h[4];
#pragma unroll
                    for (int j = 0; j < 4; ++j) { const float s = __builtin_amdgcn_rcpf(1.0f + __builtin_amdgcn_exp2f(-1.4426950408889634f * g[j])); h[j] = g[j] * s * up[j]; }
                    u32x2 w; w.x = cvt_pk_bf16(h[0], h[1]); w.y = cvt_pk_bf16(h[2], h[3]); *(u32x2*)(rowp + n * 16) = w; } }
    }
};
struct EpiRowScaleBf16 {
    static constexpr bool PERM = false;
    bf16_t* O; int ldc; const float* rs;
    __device__ __forceinline__ void operator()(const f32x4 (&acc)[2][2][4][2], const Unit& u, int wr, int wc, int fr, int fq) const {
        const int row0 = u.pm * BM + wr * 64 + fr, col0 = u.pn * BM + wc * 32 + 4 * fq;
#pragma unroll
        for (int ai = 0; ai < 2; ++ai)
#pragma unroll
            for (int m = 0; m < 4; ++m) { const int row = row0 + ai * HALF + m * 16; const float s = rs[row]; bf16_t* rowp = O + (size_t)row * ldc + col0;
#pragma unroll
                for (int bj = 0; bj < 2; ++bj)
#pragma unroll
                    for (int n = 0; n < 2; ++n) { const f32x4 v = acc[ai][bj][m][n] * s; u32x2 w; w.x = cvt_pk_bf16(v[0], v[1]); w.y = cvt_pk_bf16(v[2], v[3]); *(u32x2*)(rowp + bj * HALF + n * 16) = w; } }
    }
};

template <class Epi, class Sched, bool ALIGN_EPI>
__device__ __forceinline__ void gemm_phase(PG8_LAS unsigned char* lds, const Gemm g, const Sched& S, const Epi& E) {
    constexpr bool GATHER = Sched::GATHER;
    const int tid = threadIdx.x, wid = __builtin_amdgcn_readfirstlane(tid >> 6), lane = tid & 63, wr = wid >> 2, wc = wid & 3, fr = lane & 15, fq = lane >> 4;
    const int K = g.K, nt = K / BK;
    unsigned voffB[2], vC0[2], vC1[2], vN0[2], vN1[2]; int RA[2]; unsigned cofA[2];
#pragma unroll
    for (int i = 0; i < 2; ++i) { int R, C; stage_rc(tid * 16 + i * 8192, R, C); const int Rb = Epi::PERM ? ((R & ~31) + perm32(R & 31)) : R;
        vC0[i] = (unsigned)(R * K + C) * 2u; vC1[i] = vC0[i]; vN0[i] = vC0[i]; vN1[i] = vC0[i]; voffB[i] = (unsigned)(Rb * K + C) * 2u; RA[i] = R; cofA[i] = (unsigned)C * 2u; }
    const size_t kstep = (size_t)(BK * 2);
    const size_t hstep = (size_t)HALF * K * 2;
    const size_t hstepA = GATHER ? (size_t)0 : hstep;
    const size_t tstep = 2 * hstep;
    const unsigned ldsw = (unsigned)wid * 1024u;
    const int aoff = lds_byte(wr * 64 + fr, fq * 8), boff = lds_byte(wc * 32 + fr, fq * 8);
#define PG8_SA(b, h) (((b) * 2 + (h)) * HTB)
#define PG8_SB(b, h) ((4 + (b) * 2 + (h)) * HTB)
#define PG8_STAGE(bufoff, gbase, voff) do { _Pragma("unroll") for (int _i = 0; _i < 2; ++_i) \
        __builtin_amdgcn_global_load_lds((const unsigned*)((const char*)(gbase) + (voff)[_i]), (PG8_LAS unsigned*)(lds + (bufoff) + ldsw + _i * 8192), 16, 0, 0); } while (0)
#define PG8_LDA(dst, b, h) do { _Pragma("unroll") for (int m = 0; m < 4; ++m) _Pragma("unroll") for (int k = 0; k < 2; ++k) dst[m][k] = *(const PG8_LAS bf16x8*)(lds + PG8_SA(b, h) + aoff + m * 2048 + k * 1024); } while (0)
#define PG8_LDB(dst, b, h) do { _Pragma("unroll") for (int n = 0; n < 2; ++n) _Pragma("unroll") for (int k = 0; k < 2; ++k) dst[n][k] = *(const PG8_LAS bf16x8*)(lds + PG8_SB(b, h) + boff + n * 2048 + k * 1024); } while (0)
#define PG8_MMA(ai, bj, At, Bt) do { __builtin_amdgcn_s_setprio(1); _Pragma("unroll") for (int m = 0; m < 4; ++m) _Pragma("unroll") for (int n = 0; n < 2; ++n) _Pragma("unroll") for (int k = 0; k < 2; ++k) \
        acc[ai][bj][m][n] = __builtin_amdgcn_mfma_f32_16x16x32_bf16(Bt[n][k], At[m][k], acc[ai][bj][m][n], 0, 0, 0); __builtin_amdgcn_s_setprio(0); } while (0)
#define PG8_WAIT_V(n) asm volatile("s_waitcnt vmcnt(" #n ")" ::: "memory")
#define PG8_WAIT_L(n) asm volatile("s_waitcnt lgkmcnt(" #n ")" ::: "memory")
#define PG8_BAR __builtin_amdgcn_s_barrier()
#define PG8_SCHED __builtin_amdgcn_sched_barrier(0)
#define PG8_AROWS(u, d0, d1) do { if constexpr (GATHER) { _Pragma("unroll") for (int _i = 0; _i < 2; ++_i) { \
        d0[_i] = S.arow(u, RA[_i]) * (unsigned)(K * 2) + cofA[_i]; d1[_i] = S.arow(u, HALF + RA[_i]) * (unsigned)(K * 2) + cofA[_i]; } } } while (0)
    Unit cur, nxt; int ui = 0;
    if (!S.next(0, cur)) return;
    f32x4 acc[2][2][4][2];
#pragma unroll
    for (int a = 0; a < 2; ++a)
#pragma unroll
        for (int b = 0; b < 2; ++b)
#pragma unroll
            for (int m = 0; m < 4; ++m)
#pragma unroll
                for (int n = 0; n < 2; ++n) acc[a][b][m][n] = (f32x4){0.f, 0.f, 0.f, 0.f};
    bf16x8 At[4][2], B0[2][2], B1[2][2];
    const char* cA = GATHER ? (const char*)g.A : (const char*)g.A + (size_t)cur.pm * tstep; const char* cB = (const char*)g.Bt + (size_t)S.btile(cur) * tstep;
    PG8_AROWS(cur, vC0, vC1);
    PG8_STAGE(PG8_SB(0, 0), cB, voffB); PG8_STAGE(PG8_SB(0, 1), cB + hstep, voffB); PG8_STAGE(PG8_SA(0, 0), cA, vC0); PG8_STAGE(PG8_SA(0, 1), cA + hstepA, vC1);
    if (wr == 1) PG8_BAR;
    PG8_WAIT_V(2); PG8_BAR;
    PG8_STAGE(PG8_SB(1, 0), cB + kstep, voffB); PG8_STAGE(PG8_SA(1, 0), cA + kstep, vC0); PG8_STAGE(PG8_SB(1, 1), cB + hstep + kstep, voffB);
    PG8_WAIT_V(6); PG8_BAR;
    for (;;) {
        const bool has_next = S.next(ui + 1, nxt);
        const char* nA = GATHER ? (const char*)g.A : (has_next ? (const char*)g.A + (size_t)nxt.pm * tstep : cA); const char* nB = has_next ? (const char*)g.Bt + (size_t)S.btile(nxt) * tstep : cB;
        if constexpr (GATHER) { if (has_next) { PG8_AROWS(nxt, vN0, vN1); } else { vN0[0] = vC0[0]; vN0[1] = vC0[1]; vN1[0] = vC1[0]; vN1[1] = vC1[1]; } }
        for (int t = 0; t < nt; t += 2) {
            const bool last = (t == nt - 2);
            const char* a1 = cA + (size_t)(t + 1) * kstep;
            const char* a2 = last ? nA : cA + (size_t)(t + 2) * kstep; const char* b2 = last ? nB : cB + (size_t)(t + 2) * kstep;
            const char* a3 = a2 + kstep; const char* b3 = b2 + kstep;
            PG8_LDB(B0, 0, 0); PG8_LDB(B1, 0, 1); PG8_SCHED; PG8_LDA(At, 0, 0); PG8_STAGE(PG8_SA(1, 1), a1 + hstepA, vC1);
            if constexpr (GATHER) { if (last) { vC0[0] = vN0[0]; vC0[1] = vN0[1]; vC1[0] = vN1[0]; vC1[1] = vN1[1]; } }
            PG8_WAIT_V(8); PG8_WAIT_L(0); PG8_BAR; PG8_MMA(0, 0, At, B0); PG8_MMA(0, 1, At, B1); PG8_BAR; PG8_SCHED;
            PG8_LDA(At, 0, 1); PG8_STAGE(PG8_SB(0, 0), b2, voffB); PG8_STAGE(PG8_SB(0, 1), b2 + hstep, voffB); PG8_STAGE(PG8_SA(0, 0), a2, vC0);
            PG8_WAIT_V(8); PG8_WAIT_L(0); PG8_BAR; PG8_MMA(1, 0, At, B0); PG8_MMA(1, 1, At, B1); PG8_BAR; PG8_SCHED;
            PG8_LDB(B0, 1, 0); PG8_LDB(B1, 1, 1); PG8_SCHED; PG8_LDA(At, 1, 0); PG8_STAGE(PG8_SA(0, 1), a2 + hstepA, vC1);
            PG8_WAIT_V(8); PG8_WAIT_L(0); PG8_BAR; PG8_MMA(0, 0, At, B0); PG8_MMA(0, 1, At, B1); PG8_BAR; PG8_SCHED;
            PG8_LDA(At, 1, 1); PG8_STAGE(PG8_SB(1, 0), b3, voffB); PG8_STAGE(PG8_SB(1, 1), b3 + hstep, voffB); PG8_STAGE(PG8_SA(1, 0), a3, vC0);
            PG8_WAIT_V(8); PG8_WAIT_L(0); PG8_BAR; PG8_MMA(1, 0, At, B0); PG8_MMA(1, 1, At, B1); PG8_BAR; PG8_SCHED;
        }
        if constexpr (ALIGN_EPI) { if (wr == 0) PG8_BAR; }
        E(acc, cur, wr, wc, fr, fq);
        if (!has_next) break;
#pragma unroll
        for (int a = 0; a < 2; ++a)
#pragma unroll
            for (int b = 0; b < 2; ++b)
#pragma unroll
                for (int m = 0; m < 4; ++m)
#pragma unroll
                    for (int n = 0; n < 2; ++n) acc[a][b][m][n] = (f32x4){0.f, 0.f, 0.f, 0.f};
        cur = nxt; cA = nA; cB = nB; ++ui;
        if constexpr (ALIGN_EPI) { if (wr == 1) PG8_BAR; }
    }
    PG8_WAIT_V(0);
    if constexpr (!ALIGN_EPI) { if (wr == 0) PG8_BAR; }
    PG8_BAR;
#undef PG8_SA
#undef PG8_SB
#undef PG8_STAGE
#undef PG8_LDA
#undef PG8_LDB
#undef PG8_MMA
#undef PG8_WAIT_V
#undef PG8_WAIT_L
#undef PG8_BAR
#undef PG8_SCHED
#undef PG8_AROWS
}
}

namespace att {
using bf16_t = unsigned short;
using bf16x8 = __attribute__((ext_vector_type(8))) short;
using s16x4  = __attribute__((ext_vector_type(4))) short;
using f32x16 = __attribute__((ext_vector_type(16))) float;
using u32x4  = __attribute__((ext_vector_type(4))) unsigned;
#define SBAR() __builtin_amdgcn_sched_barrier(0)
constexpr float THR = 8.f;
__device__ __forceinline__ int crow(int r, int hi) { return (r & 3) + 8 * (r >> 2) + 4 * hi; }
__device__ __forceinline__ unsigned cvtpk(float lo, float hi) { unsigned r; asm volatile("v_cvt_pk_bf16_f32 %0, %1, %2" : "=v"(r) : "v"(lo), "v"(hi)); return r; }
template <int DK> struct KCfg;
template <> struct KCfg<64> { static constexpr float SCALE = 0.125f;
    static __device__ __forceinline__ int swz(int row, int cb) { return row * 128 + (cb ^ (((row >> 1) & 7) << 4)); } };
template <> struct KCfg<96> { static constexpr float SCALE = 0.10206207261596577f;
    static __device__ __forceinline__ int swz(int row, int cb) { return row * 192 + (cb ^ (((row >> 2) & 3) << 4)); } };

template <int DK> __device__ __forceinline__ void partialSM(f32x16& p0, f32x16& p1, float& m_reg, float& mn, float& alpha) {
  constexpr float SCALE = KCfg<DK>::SCALE, C = SCALE * 1.4426950408889634f;
  float pmax = p0[0];
#pragma unroll
  for (int r = 1; r < 16; ++r) pmax = fmaxf(pmax, p0[r]);
#pragma unroll
  for (int r = 0; r < 16; ++r) pmax = fmaxf(pmax, p1[r]);
  { auto rr = __builtin_amdgcn_permlane32_swap(__float_as_uint(pmax), __float_as_uint(pmax), false, false);
    pmax = fmaxf(__uint_as_float(rr[0]), __uint_as_float(rr[1])); }
  if (__builtin_expect(__all(pmax - m_reg <= THR / SCALE), 1)) { mn = m_reg; alpha = 1.f; }
  else { mn = fmaxf(m_reg, pmax); alpha = __builtin_amdgcn_exp2f((m_reg - mn) * C); m_reg = mn; }
  float mnC = -mn * C;
#pragma unroll
  for (int r = 0; r < 16; ++r) p0[r] = fmaf(p0[r], C, mnC);
#pragma unroll
  for (int r = 0; r < 16; ++r) p1[r] = fmaf(p1[r], C, mnC);
#pragma unroll
  for (int r = 0; r < 16; ++r) p0[r] = __builtin_amdgcn_exp2f(p0[r]);
}
__device__ __forceinline__ void finishSM(f32x16& p0, f32x16& p1, float alpha, float& l_reg, bf16x8& pa0, bf16x8& pa1, bf16x8& pa2, bf16x8& pa3) {
#pragma unroll
  for (int r = 0; r < 16; ++r) p1[r] = __builtin_amdgcn_exp2f(p1[r]);
  float ps = 0;
#pragma unroll
  for (int r = 0; r < 16; ++r) ps += p0[r];
#pragma unroll
  for (int r = 0; r < 16; ++r) ps += p1[r];
  { auto rr = __builtin_amdgcn_permlane32_swap(__float_as_uint(ps), __float_as_uint(ps), false, false);
    ps = __uint_as_float(rr[0]) + __uint_as_float(rr[1]); }
  l_reg = l_reg * alpha + ps;
#define PK4(P, BASE, OUT) do { unsigned a0 = cvtpk(P[BASE + 0], P[BASE + 1]), a1 = cvtpk(P[BASE + 2], P[BASE + 3]);   \
    unsigned b0 = cvtpk(P[BASE + 4], P[BASE + 5]), b1 = cvtpk(P[BASE + 6], P[BASE + 7]);                              \
    auto r0 = __builtin_amdgcn_permlane32_swap(a0, b0, false, false); auto r1 = __builtin_amdgcn_permlane32_swap(a1, b1, false, false); \
    u32x4 w = {r0[0], r1[0], r0[1], r1[1]}; OUT = *reinterpret_cast<bf16x8*>(&w); } while (0)
  PK4(p0, 0, pa0); PK4(p0, 8, pa1); PK4(p1, 0, pa2); PK4(p1, 8, pa3);
#undef PK4
}
template <int DK> __device__ __forceinline__ void qkt(f32x16& p0, f32x16& p1, const char* Ks, const bf16x8* qr, int r32, int hi) {
  p0 = f32x16{}; p1 = f32x16{};
#pragma unroll
  for (int d0 = 0; d0 < DK / 16; ++d0) { const int cb = (d0 * 16 + hi * 8) * 2;
    bf16x8 b0 = *reinterpret_cast<const bf16x8*>(Ks + KCfg<DK>::swz(r32, cb));
    bf16x8 b1 = *reinterpret_cast<const bf16x8*>(Ks + KCfg<DK>::swz(32 + r32, cb));
    p0 = __builtin_amdgcn_mfma_f32_32x32x16_bf16(b0, qr[d0], p0, 0, 0, 0);
    p1 = __builtin_amdgcn_mfma_f32_32x32x16_bf16(b1, qr[d0], p1, 0, 0, 0); }
}
__device__ __forceinline__ int v_st(int k, int c) { const int kk = (k & ~0xC) | ((k & 4) << 1) | ((k & 8) >> 1); return ((kk >> 3) * 2 + (c >> 5)) * 512 + ((kk & 7) * 32 + (c & 31)) * 2; }
__device__ __forceinline__ int v_rd_base(int lane) { return ((lane & 3) << 3) | (((lane >> 2) & 3) << 6) | (((lane >> 4) & 1) << 5) | (((lane >> 5) & 1) << 8); }
constexpr int v_rd_off(int d0, int ks, int half) { return d0 * 512 + ks * 2048 + half * 1024; }
template <int OFF> __device__ __forceinline__ s16x4 tr_read(int vb) {
  s16x4 r; asm volatile("ds_read_b64_tr_b16 %0, %1 offset:%2" : "=&v"(r) : "v"(vb), "i"(OFF) : "memory"); return r;
}
template <int D0> __device__ __forceinline__ void pv_one(f32x16& od, int vb, bf16x8 pa0, bf16x8 pa1, bf16x8 pa2, bf16x8 pa3) {
  const s16x4 l0 = tr_read<v_rd_off(D0, 0, 0)>(vb), h0 = tr_read<v_rd_off(D0, 0, 1)>(vb), l1 = tr_read<v_rd_off(D0, 1, 0)>(vb), h1 = tr_read<v_rd_off(D0, 1, 1)>(vb);
  const s16x4 l2 = tr_read<v_rd_off(D0, 2, 0)>(vb), h2 = tr_read<v_rd_off(D0, 2, 1)>(vb), l3 = tr_read<v_rd_off(D0, 3, 0)>(vb), h3 = tr_read<v_rd_off(D0, 3, 1)>(vb);
  asm volatile("s_waitcnt lgkmcnt(0)" ::: "memory"); SBAR();
#define PK(L, H) (bf16x8){L[0], L[1], L[2], L[3], H[0], H[1], H[2], H[3]}
  od = __builtin_amdgcn_mfma_f32_32x32x16_bf16(pa0, PK(l0, h0), od, 0, 0, 0);
  od = __builtin_amdgcn_mfma_f32_32x32x16_bf16(pa1, PK(l1, h1), od, 0, 0, 0);
  od = __builtin_amdgcn_mfma_f32_32x32x16_bf16(pa2, PK(l2, h2), od, 0, 0, 0);
  od = __builtin_amdgcn_mfma_f32_32x32x16_bf16(pa3, PK(l3, h3), od, 0, 0, 0);
#undef PK
}
__device__ __forceinline__ void pv_d0(f32x16* o, int vb, bf16x8 pa0, bf16x8 pa1, bf16x8 pa2, bf16x8 pa3) {
  pv_one<0>(o[0], vb, pa0, pa1, pa2, pa3); pv_one<1>(o[1], vb, pa0, pa1, pa2, pa3);
}
constexpr int SEQK = 2048, KVBLK = 64, NT = SEQK / KVBLK, SHM_V = 64 * 64 * 2;
constexpr int LDS_BYTES = 2 * SHM_V + 2 * (64 * 96 * 2) + 2048 + 8 * 4096;
template <int DK>
__device__ __forceinline__ void attn_unit(const bf16_t* __restrict__ Qb, int ldq, const bf16_t* __restrict__ Kh, int ldk, const bf16_t* __restrict__ Vh, int ldv, bf16_t* __restrict__ Ob, int ldo, char* lds) {
  constexpr int KCH = DK / 8, SHM_K = 64 * DK * 2; constexpr bool K2 = (64 * KCH > 512);
  const int tid = threadIdx.x, wid = tid >> 6, lane = tid & 63, r32 = lane & 31, hi = lane >> 5;
  char* V_lds = lds; char* K_lds = lds + 2 * SHM_V;
  float* ws = (float*)(lds + 2 * SHM_V + 2 * SHM_K) + wid * 64; float* li_l = ws; float* al_l = ws + 32;
  bf16_t* stg = (bf16_t*)(lds + 2 * SHM_V + 2 * SHM_K + 2048) + wid * 2048;
  float m_reg = -1e30f, l_reg = 0; f32x16 o[2] = {}; bf16x8 qr[DK / 16];
  const bf16_t* Qw = Qb + (long)(wid * 32 + r32) * ldq + hi * 8;
#pragma unroll
  for (int d0 = 0; d0 < DK / 16; ++d0) qr[d0] = *reinterpret_cast<const bf16x8*>(Qw + d0 * 16);
  const int kr0 = tid / KCH, kc0 = (tid % KCH) * 8, kr1 = (tid + 512) / KCH, kc1 = ((tid + 512) % KCH) * 8; const bool has2 = K2 && (tid < 64 * KCH - 512);
  const int vr = tid >> 3, vc = (tid & 7) * 8, vst0 = v_st(vr, vc);
  const int vb0 = (int)(uintptr_t)V_lds + v_rd_base(lane);
  bf16x8 sk0, sk1, sv0;
#define SLOAD(k0) do { sk0 = *reinterpret_cast<const bf16x8*>(&Kh[(long)((k0) + kr0) * ldk + kc0]); if (has2) sk1 = *reinterpret_cast<const bf16x8*>(&Kh[(long)((k0) + kr1) * ldk + kc1]); \
    sv0 = *reinterpret_cast<const bf16x8*>(&Vh[(long)((k0) + vr) * ldv + vc]); } while (0)
#define SWRITE(b) do { *(bf16x8*)(K_lds + (b) * SHM_K + KCfg<DK>::swz(kr0, kc0 * 2)) = sk0; if (has2) *(bf16x8*)(K_lds + (b) * SHM_K + KCfg<DK>::swz(kr1, kc1 * 2)) = sk1; \
    *(bf16x8*)(V_lds + (b) * SHM_V + vst0) = sv0; } while (0)
#define SWAIT() asm volatile("s_waitcnt vmcnt(0)" ::: "memory")
#define RESC(a) do { if (__any((a) < 1.f)) { if (hi == 0) al_l[r32] = (a); asm volatile("s_waitcnt lgkmcnt(0)" ::: "memory"); \
    _Pragma("unroll") for (int d = 0; d < 2; ++d) _Pragma("unroll") for (int r = 0; r < 16; ++r) o[d][r] *= al_l[crow(r, hi)]; } } while (0)
  f32x16 pA0, pA1, pB0, pB1; float mnA, mnB, alA, alB; bf16x8 pa0, pa1, pa2, pa3;
  SLOAD(0); SWAIT(); SWRITE(0); __syncthreads();
  qkt<DK>(pA0, pA1, K_lds, qr, r32, hi); partialSM<DK>(pA0, pA1, m_reg, mnA, alA);
  SLOAD(KVBLK);
  SWAIT(); SWRITE(1); __syncthreads();
  for (int j = 1; j + 1 < NT; j += 2) {
    SBAR(); qkt<DK>(pB0, pB1, K_lds + SHM_K, qr, r32, hi);
    finishSM(pA0, pA1, alA, l_reg, pa0, pa1, pa2, pa3); SBAR();
    SLOAD((j + 1) * KVBLK); SBAR();
    pv_d0(o, vb0, pa0, pa1, pa2, pa3); partialSM<DK>(pB0, pB1, m_reg, mnB, alB);
    __syncthreads(); SWAIT(); SWRITE(0);
    RESC(alB); __syncthreads();
    SBAR(); qkt<DK>(pA0, pA1, K_lds, qr, r32, hi);
    finishSM(pB0, pB1, alB, l_reg, pa0, pa1, pa2, pa3); SBAR();
    SLOAD((j + 2) * KVBLK); SBAR();
    pv_d0(o, vb0 + SHM_V, pa0, pa1, pa2, pa3); partialSM<DK>(pA0, pA1, m_reg, mnA, alA);
    __syncthreads(); SWAIT(); SWRITE(1);
    RESC(alA); __syncthreads();
  }
  SBAR(); qkt<DK>(pB0, pB1, K_lds + SHM_K, qr, r32, hi);
  finishSM(pA0, pA1, alA, l_reg, pa0, pa1, pa2, pa3); SBAR();
  pv_d0(o, vb0, pa0, pa1, pa2, pa3); partialSM<DK>(pB0, pB1, m_reg, mnB, alB);
  __syncthreads(); RESC(alB);
  finishSM(pB0, pB1, alB, l_reg, pa0, pa1, pa2, pa3); SBAR();
  pv_d0(o, vb0 + SHM_V, pa0, pa1, pa2, pa3);
  if (hi == 0) li_l[r32] = l_reg; asm volatile("s_waitcnt lgkmcnt(0)" ::: "memory");
  float rli[16];
#pragma unroll
  for (int r = 0; r < 16; ++r) rli[r] = __builtin_amdgcn_rcpf(li_l[crow(r, hi)]);
#pragma unroll
  for (int r = 0; r < 16; ++r) { const int orow = crow(r, hi);
#pragma unroll
    for (int d0 = 0; d0 < 2; ++d0) { const unsigned w = cvtpk(o[d0][r] * rli[r], 0.f); stg[orow * 64 + d0 * 32 + r32] = (bf16_t)(w & 0xffffu); } }
  asm volatile("s_waitcnt lgkmcnt(0)" ::: "memory");
  bf16_t* Ow = Ob + (long)(wid * 32) * ldo;
#pragma unroll
  for (int i = 0; i < 4; ++i) { const int row = i * 8 + (lane >> 3), ch = lane & 7; const u32x4 v = *(const u32x4*)(stg + row * 64 + ch * 8); *(u32x4*)(Ow + (long)row * ldo + ch * 8) = v; }
  __syncthreads();
#undef SLOAD
#undef SWRITE
#undef SWAIT
#undef RESC
}
#undef SBAR
}

constexpr int NWAVES = 8;
constexpr int NB = 16, SEQ = 2048, DM = 1024, T = NB * SEQ;
constexpr int INW = 1312, INWP = 1536;
constexpr int NE = 16, CAP = 256, FF = 2816, PLE = 256;
constexpr int UQW = 768, UKVW = 1024;
constexpr float ALPHA = 1.189207115002721f;
constexpr float LN_EPS = 1e-5f, RMS_EPS = 1e-6f;

constexpr size_t MiB = 1u << 20;
constexpr size_t WS_CTL = 0;
constexpr size_t WS_WIN = 1 * MiB;
constexpr size_t WS_WUQ = 4 * MiB;
constexpr size_t WS_WUKV = 4 * MiB + 512 * 1024;
constexpr size_t WS_WOUT = 5 * MiB;
constexpr size_t WS_WPG = 7 * MiB;
constexpr size_t WS_WPP = 9 * MiB;
constexpr size_t WS_WRT = 9 * MiB + 512 * 1024;
constexpr size_t WS_AFF = 10 * MiB;
constexpr size_t WS_ROWMAP = 12 * MiB;
constexpr size_t WS_GVAL = 12 * MiB + 256 * 1024;
constexpr size_t WS_SEL = 12 * MiB + 512 * 1024;
constexpr size_t WS_WGU = 16 * MiB;
constexpr size_t WS_YEXP = 16 * MiB, WS_PB = 144 * MiB;
constexpr size_t WS_WDN = 192 * MiB;
constexpr size_t WS_X1B = 280 * MiB;
constexpr size_t WS_QMLA = 280 * MiB;
constexpr size_t WS_R1 = 344 * MiB;
constexpr size_t WS_XB = WS_R1;
constexpr size_t WS_PROJ = WS_R1 + 64 * MiB;
constexpr size_t WS_QG = WS_R1 + 256 * MiB, WS_KG = WS_QG + 32 * MiB, WS_VG = WS_KG + 8 * MiB, WS_CQ = WS_VG + 8 * MiB, WS_CKV = WS_CQ + 16 * MiB, WS_KPE = WS_CKV + 16 * MiB;
constexpr size_t WS_QM = WS_R1;
constexpr size_t WS_KV = WS_R1 + 96 * MiB;
constexpr size_t WS_VMLA = WS_R1 + 224 * MiB;
constexpr size_t WS_O = WS_R1;
constexpr size_t WS_H = WS_R1;
constexpr size_t WS_E = WS_R1, WS_G = WS_R1 + 128 * MiB;
constexpr size_t WS_END = 704 * MiB;
static_assert(WS_KPE + 2 * MiB <= WS_END && WS_H + (size_t)65536 * FF * 2 <= WS_END && WS_VMLA + 32 * MiB <= WS_QG, "d_ws map");

constexpr int LDS_BYTES = 147456;
static_assert(att::LDS_BYTES <= 131072, "attention LDS");

#define LAS __attribute__((address_space(3)))
typedef unsigned short bf16;
typedef unsigned v4u __attribute__((ext_vector_type(4)));
typedef unsigned v2u __attribute__((ext_vector_type(2)));
typedef float f32x4 __attribute__((ext_vector_type(4)));
__device__ __forceinline__ unsigned f2bf(float f) { unsigned u = __builtin_bit_cast(unsigned, f); return (u + 0x7fffu + ((u >> 16) & 1u)) >> 16; }
__device__ __forceinline__ unsigned pk2(float lo, float hi) { return f2bf(lo) | (f2bf(hi) << 16); }
__device__ __forceinline__ float bf2f(unsigned h) { return __builtin_bit_cast(float, h << 16); }
__device__ __forceinline__ float wave_sum(float v) {
#pragma unroll
    for (int o = 1; o < 64; o <<= 1) v += __shfl_xor(v, o);
    return v;
}
__device__ __forceinline__ float wave_max(float v) {
#pragma unroll
    for (int o = 1; o < 64; o <<= 1) v = fmaxf(v, __shfl_xor(v, o));
    return v;
}


#define GAS __attribute__((address_space(1)))
typedef GAS unsigned gu32;
#define RLX_AGENT __ATOMIC_RELAXED, __HIP_MEMORY_SCOPE_AGENT
#define XB_TMO      128
#define XB_XCNT(j)  (256  + 64 * (j))
#define XB_XSUB(j)  (1280 + 64 * (j))
#define XB_XGEN(j)  (2304 + 64 * (j))
#define XB_TOP      3328
#define XB_TOPGEN   3392
#define XCD_BAR_WORDS 3456
#define XB_SPIN_CAP (1u << 18)

__device__ __forceinline__ unsigned xb_ld(unsigned* p)              { return __hip_atomic_load(p, __ATOMIC_RELAXED, __HIP_MEMORY_SCOPE_AGENT); }
__device__ __forceinline__ unsigned xb_add(unsigned* p, unsigned v) { return __hip_atomic_fetch_add(p, v, __ATOMIC_RELAXED, __HIP_MEMORY_SCOPE_AGENT); }
__device__ __forceinline__ unsigned xb_xcc_id() { return (unsigned)__builtin_amdgcn_s_getreg((3 << 11) | 20) & 0xFu; }
#define XB_SPIN(cond, bar) do { unsigned _sp = 0; while (cond) { __builtin_amdgcn_s_sleep(1); \
    if ((++_sp & 255u) == 0u) { if (xb_ld(&(bar)[XB_TMO])) break; if (_sp > XB_SPIN_CAP) { atomicAdd(&(bar)[XB_TMO], 1u); break; } } } } while (0)

struct XcdBarrier {
    unsigned* bar; unsigned x;
    volatile LAS unsigned* st;
};

__device__ __forceinline__ XcdBarrier xcd_barrier_post(unsigned* bar, volatile LAS unsigned* st) {
    XcdBarrier b; b.bar = bar; b.x = xb_xcc_id(); b.st = st;
    if (threadIdx.x == 0) (void)xb_add(&bar[XB_XCNT(b.x)], 1u);
    return b;
}
__device__ __forceinline__ void xcd_barrier_complete(unsigned* bar, unsigned x, unsigned& nloc, unsigned& nx) {
    const unsigned G = gridDim.x * gridDim.y * gridDim.z;
    unsigned sum, cnt, mine, sp = 0u;
    for (;;) {
        sum = 0u; cnt = 0u; mine = 0u;
#pragma unroll
        for (unsigned j = 0; j < 16; ++j) { const unsigned c = xb_ld(&bar[XB_XCNT(j)]); sum += c; cnt += (c > 0u) ? 1u : 0u; mine = (j == x) ? c : mine; }
        if (sum == G) break;
        __builtin_amdgcn_s_sleep(1);
        if ((++sp & 255u) == 0u) { if (xb_ld(&bar[XB_TMO])) break; if (sp > XB_SPIN_CAP) { atomicAdd(&bar[XB_TMO], 1u); break; } }
    }
    nloc = mine > 0u ? mine : 1u; nx = cnt > 0u ? cnt : 1u;
}

__device__ __forceinline__ void xcd_barrier(const XcdBarrier& b) {
    asm volatile("s_waitcnt vmcnt(0)" ::: "memory");
    __syncthreads();
    if (threadIdx.x == 0) {
        unsigned* bar = b.bar;
        __builtin_amdgcn_s_waitcnt(0);
        unsigned nloc = b.st[0], nx = b.st[1];
        if (nloc == 0u) { xcd_barrier_complete(bar, b.x, nloc, nx); b.st[0] = nloc; b.st[1] = nx; }
        const unsigned old = xb_add(&bar[XB_XSUB(b.x)], 1u);
        const unsigned gen = old / nloc;
        if (old + 1u == (gen + 1u) * nloc) {
            __builtin_amdgcn_fence(__ATOMIC_RELEASE, "agent");
            asm volatile("s_waitcnt vmcnt(0)" ::: "memory");
            const unsigned og = xb_add(&bar[XB_TOP], 1u);
            const unsigned tg = og / nx;
            if (og + 1u == (tg + 1u) * nx) xb_add(&bar[XB_TOPGEN], 1u);
            else XB_SPIN(xb_ld(&bar[XB_TOPGEN]) == tg, bar);
            __builtin_amdgcn_fence(__ATOMIC_ACQUIRE, "agent");
            xb_add(&bar[XB_XGEN(b.x)], 1u);
            asm volatile("s_waitcnt vmcnt(0)" ::: "memory");
        } else {
            XB_SPIN(xb_ld(&bar[XB_XGEN(b.x)]) == gen, bar);
            __builtin_amdgcn_fence(__ATOMIC_ACQUIRE, "agent");
            asm volatile("s_waitcnt vmcnt(0)" ::: "memory");
        }
    }
    __syncthreads();
}
struct Args { const float* in[22]; float* out; unsigned char* ws; int ph_lo, ph_hi; };
enum { I_X = 0, I_P, I_WIN, I_QN, I_KN, I_CQN, I_CKVN, I_WUQ, I_WUKV, I_WOUT, I_LNAG, I_LNAB, I_WR, I_WG, I_WU, I_WD, I_LNFG, I_LNFB, I_WPP, I_WPG, I_LNPG, I_LNPB };

struct Frame { LAS unsigned char* lds; int tid, lane, wave, vcu, G; };

__device__ __forceinline__ void tr_item(const float* W, int N, int k0, int n0, bf16* WT, int K, long dst_row0, LAS float* scr, int lane) {
#pragma unroll 8
    for (int i = 0; i < 32; ++i) { const int kk = 2 * i + (lane >> 5); scr[kk * 33 + (lane & 31)] = W[(size_t)(k0 + kk) * N + n0 + (lane & 31)]; }
    asm volatile("s_waitcnt lgkmcnt(0)" ::: "memory");
    const int c = lane & 7;
#pragma unroll
    for (int j = 0; j < 4; ++j) { const int n = (lane >> 3) + 8 * j; const LAS float* s = scr + (8 * c) * 33 + n;
        v4u o; o.x = pk2(s[0 * 33], s[1 * 33]); o.y = pk2(s[2 * 33], s[3 * 33]); o.z = pk2(s[4 * 33], s[5 * 33]); o.w = pk2(s[6 * 33], s[7 * 33]);
        *(v4u*)(WT + (size_t)(dst_row0 + n) * K + k0 + 8 * c) = o; }
    asm volatile("s_waitcnt lgkmcnt(0)" ::: "memory");
}
__device__ __forceinline__ void tr_dense(const float* W, int K, int N, bf16* WT, int r, LAS float* scr, int lane) {
    const int nblk = N / 32, kb = r / nblk, nb = r % nblk; tr_item(W, N, 64 * kb, 32 * nb, WT, K, 32 * nb, scr, lane);
}
__device__ __forceinline__ void p0_convert(const Frame& F, const Args& a) {
    LAS float* scr = (LAS float*)(F.lds + F.wave * 16384);
    const int gw = F.vcu * NWAVES + F.wave, NGW = F.G * NWAVES;
    unsigned char* ws = a.ws;
    constexpr int I_IN = (DM / 64) * (INW / 32), I_UQ = (256 / 64) * (UQW / 32), I_UKV = (256 / 64) * (UKVW / 32), I_OUT = (DM / 64) * (DM / 32), I_PG = I_OUT, I_PP = (PLE / 64) * (DM / 32);
    constexpr int I_GE = (DM / 64) * (FF / 32), I_DE = (FF / 64) * (DM / 32);
    constexpr int NITEMS = I_IN + I_UQ + I_UKV + I_OUT + I_PG + I_PP + 2 * NE * I_GE + NE * I_DE;
    for (int it = gw; it < NITEMS; it += NGW) {
        int r = it;
        if (r < I_IN) { tr_dense(a.in[I_WIN], DM, INW, (bf16*)(ws + WS_WIN), r, scr, F.lane); continue; } r -= I_IN;
        if (r < I_UQ) { tr_dense(a.in[I_WUQ], 256, UQW, (bf16*)(ws + WS_WUQ), r, scr, F.lane); continue; } r -= I_UQ;
        if (r < I_UKV) { tr_dense(a.in[I_WUKV], 256, UKVW, (bf16*)(ws + WS_WUKV), r, scr, F.lane); continue; } r -= I_UKV;
        if (r < I_OUT) { tr_dense(a.in[I_WOUT], DM, DM, (bf16*)(ws + WS_WOUT), r, scr, F.lane); continue; } r -= I_OUT;
        if (r < I_PG) { tr_dense(a.in[I_WPG], DM, DM, (bf16*)(ws + WS_WPG), r, scr, F.lane); continue; } r -= I_PG;
        if (r < I_PP) { tr_dense(a.in[I_WPP], PLE, DM, (bf16*)(ws + WS_WPP), r, scr, F.lane); continue; } r -= I_PP;
        if (r < 2 * NE * I_GE) {
            const int which = r / (NE * I_GE); r -= which * NE * I_GE; const int e = r / I_GE; r -= e * I_GE;
            const int nblk = FF / 32, kb = r / nblk, nb = r % nblk, n0 = 32 * nb;
            const float* W = a.in[which ? I_WU : I_WG] + (size_t)e * DM * FF;
            tr_item(W, FF, 64 * kb, n0, (bf16*)(ws + WS_WGU), DM, (long)e * (2 * FF) + (n0 / 128) * 256 + (n0 % 128) + (which ? 128 : 0), scr, F.lane); continue; }
        r -= 2 * NE * I_GE;
        { const int e = r / I_DE; r -= e * I_DE; const int nblk = DM / 32, kb = r / nblk, nb = r % nblk;
          tr_item(a.in[I_WD] + (size_t)e * FF * DM, DM, 64 * kb, 32 * nb, (bf16*)(ws + WS_WDN), FF, (long)e * DM + 32 * nb, scr, F.lane); }
    }
    { v4u* z = (v4u*)(ws + WS_WIN + (size_t)INW * DM * 2); const int n16 = (INWP - INW) * DM * 2 / 16;
      for (int i = (F.vcu * NWAVES + F.wave) * 64 + F.lane; i < n16; i += NGW * 64) z[i] = (v4u){0u, 0u, 0u, 0u}; }
    { float* wrt = (float*)(ws + WS_WRT); const float* wr = a.in[I_WR];
      for (int i = (F.vcu * NWAVES + F.wave) * 64 + F.lane; i < NE * DM; i += NGW * 64) { const int e = i / DM, k = i % DM; wrt[i] = wr[k * NE + e]; } }
    { const float* x = a.in[I_X]; bf16* xb = (bf16*)(ws + WS_XB);
      for (int m = gw; m < T; m += NGW) { const f32x4* xr = (const f32x4*)(x + (size_t)m * DM) + F.lane; v2u* o = (v2u*)(xb + (size_t)m * DM) + F.lane;
#pragma unroll
          for (int j = 0; j < 4; ++j) { const f32x4 v = xr[64 * j]; o[64 * j] = (v2u){pk2(v.x, v.y), pk2(v.z, v.w)}; } } }
}

__device__ __forceinline__ float rope_apply(float y, float yp, bool second, float pos, float invf) {
    float rev = pos * invf * 0.15915494309189535f; rev = rev - floorf(rev);
    const float s = __builtin_amdgcn_sinf(rev), c = __builtin_amdgcn_cosf(rev);
    return second ? y * c + yp * s : y * c - yp * s;
}

__device__ __forceinline__ void p2_qkv_post(const Frame& F, const Args& a) {
    const int gw = F.vcu * NWAVES + F.wave, NGW = F.G * NWAVES, l = F.lane;
    unsigned char* ws = a.ws;
    const float* PROJ = (const float*)(ws + WS_PROJ);
    bf16* QG = (bf16*)(ws + WS_QG); bf16* KG = (bf16*)(ws + WS_KG); bf16* VG = (bf16*)(ws + WS_VG); bf16* CQ = (bf16*)(ws + WS_CQ); bf16* CKV = (bf16*)(ws + WS_CKV); bf16* KPE = (bf16*)(ws + WS_KPE);
    const float qn = a.in[I_QN][l], kn = a.in[I_KN][l];
    const float invf64 = exp2f(-(float)(l & 15) * (13.287712379549449f / 16.0f));
    const float invf32 = exp2f(-(float)(l & 7) * (13.287712379549449f / 8.0f));
    for (int m = gw; m < T; m += NGW) {
        const float* pr = PROJ + (size_t)m * INWP; const int t = m & (SEQ - 1);
        const float pos64 = (l & 32) ? (float)(t & 63) : (float)(t >> 6);
        const float pos32 = (l & 16) ? (float)(t & 63) : (float)(t >> 6);
#pragma unroll
        for (int h = 0; h < 10; ++h) {
            const float v = pr[h * 64 + l]; const float ss = wave_sum(v * v);
            const float y = v * (1.0f / sqrtf(ss * (1.0f / 64.0f) + RMS_EPS)) * (h < 8 ? qn : kn);
            const float yp = __shfl_xor(y, 16);
            const float o = rope_apply(y, yp, (l & 16) != 0, pos64, invf64);
            if (h < 8) QG[(size_t)m * 512 + h * 64 + l] = (bf16)f2bf(o); else KG[(size_t)m * 128 + (h - 8) * 64 + l] = (bf16)f2bf(o);
        }
        VG[(size_t)m * 128 + l] = (bf16)f2bf(pr[640 + l]); VG[(size_t)m * 128 + 64 + l] = (bf16)f2bf(pr[704 + l]);
        { float v[4]; float ss = 0.f;
#pragma unroll
          for (int j = 0; j < 4; ++j) { v[j] = pr[768 + l + 64 * j]; ss += v[j] * v[j]; }
          ss = wave_sum(ss); const float rs = 1.0f / sqrtf(ss * (1.0f / 256.0f) + RMS_EPS);
#pragma unroll
          for (int j = 0; j < 4; ++j) CQ[(size_t)m * 256 + l + 64 * j] = (bf16)f2bf(v[j] * rs * a.in[I_CQN][l + 64 * j]); }
        { float v[4]; float ss = 0.f;
#pragma unroll
          for (int j = 0; j < 4; ++j) { v[j] = pr[1024 + l + 64 * j]; ss += v[j] * v[j]; }
          ss = wave_sum(ss); const float rs = 1.0f / sqrtf(ss * (1.0f / 256.0f) + RMS_EPS);
#pragma unroll
          for (int j = 0; j < 4; ++j) CKV[(size_t)m * 256 + l + 64 * j] = (bf16)f2bf(v[j] * rs * a.in[I_CKVN][l + 64 * j]); }
        { const float y = pr[1280 + (l & 31)]; const float yp = __shfl_xor(y, 8);
          const float o = rope_apply(y, yp, (l & 8) != 0, pos32, invf32);
          if (l < 32) KPE[(size_t)m * 32 + l] = (bf16)f2bf(o); }
    }
}
__device__ __forceinline__ void p4_mla_post(const Frame& F, const Args& a) {
    const int gw = F.vcu * NWAVES + F.wave, NGW = F.G * NWAVES, l = F.lane;
    unsigned char* ws = a.ws;
    const float* QM = (const float*)(ws + WS_QM); const float* KV = (const float*)(ws + WS_KV); const bf16* KPE = (const bf16*)(ws + WS_KPE);
    bf16* QMLA = (bf16*)(ws + WS_QMLA); bf16* KMLA = (bf16*)a.out; bf16* VMLA = (bf16*)(ws + WS_VMLA);
    const float invf32 = exp2f(-(float)(l & 7) * (13.287712379549449f / 8.0f));
    for (int m = gw; m < T; m += NGW) {
        const int t = m & (SEQ - 1); const float pos32 = (l & 16) ? (float)(t & 63) : (float)(t >> 6);
        const float* q = QM + (size_t)m * UQW; const float* kv = KV + (size_t)m * UKVW;
        const bf16 kpe = KPE[(size_t)m * 32 + (l & 31)];
#pragma unroll
        for (int h = 0; h < 8; ++h) {
            QMLA[(size_t)m * 768 + h * 96 + l] = (bf16)f2bf(q[h * 96 + l]);
            { const float y = q[h * 96 + 64 + (l & 31)]; const float yp = __shfl_xor(y, 8); const float o = rope_apply(y, yp, (l & 8) != 0, pos32, invf32);
              if (l < 32) QMLA[(size_t)m * 768 + h * 96 + 64 + l] = (bf16)f2bf(o); }
            KMLA[(size_t)m * 768 + h * 96 + l] = (bf16)f2bf(kv[h * 128 + l]);
            if (l < 32) KMLA[(size_t)m * 768 + h * 96 + 64 + l] = kpe;
            VMLA[(size_t)m * 512 + h * 64 + l] = (bf16)f2bf(kv[h * 128 + 64 + l]);
        }
    }
}
__device__ __forceinline__ void p5_attention(const Frame& F, const Args& a) {
    unsigned char* ws = a.ws; char* lds = (char*)F.lds;
    const bf16* QG = (const bf16*)(ws + WS_QG); const bf16* KG = (const bf16*)(ws + WS_KG); const bf16* VG = (const bf16*)(ws + WS_VG);
    const bf16* QMLA = (const bf16*)(ws + WS_QMLA); const bf16* KMLA = (const bf16*)a.out; const bf16* VMLA = (const bf16*)(ws + WS_VMLA);
    bf16* O = (bf16*)(ws + WS_O);
    for (int U = F.vcu; U < 2048; U += F.G) {
        if (U < 1024) { const int qb = U & 7, hq = (U >> 3) & 7, kvh = hq >> 2, b = U >> 6; const size_t r0 = (size_t)b * SEQ + qb * 256;
            att::attn_unit<64>(QG + r0 * 512 + hq * 64, 512, KG + (size_t)b * SEQ * 128 + kvh * 64, 128, VG + (size_t)b * SEQ * 128 + kvh * 64, 128, O + r0 * 1024 + hq * 64, 1024, lds); }
        else { const int V = U - 1024, qb = V & 7, h = (V >> 3) & 7, b = V >> 6; const size_t r0 = (size_t)b * SEQ + qb * 256;
            att::attn_unit<96>(QMLA + r0 * 768 + h * 96, 768, KMLA + (size_t)b * SEQ * 768 + h * 96, 768, VMLA + (size_t)b * SEQ * 512 + h * 64, 512, O + r0 * 1024 + 512 + h * 64, 1024, lds); }
    }
}
__device__ __forceinline__ void ln_row(f32x4 (&v)[4], const float* g, const float* bta, int lane) {
    float s = 0.f;
#pragma unroll
    for (int j = 0; j < 4; ++j) s += (v[j].x + v[j].y) + (v[j].z + v[j].w);
    const float mean = wave_sum(s) * (1.f / DM); float s2 = 0.f;
#pragma unroll
    for (int j = 0; j < 4; ++j) { v[j] = v[j] - mean; s2 += (v[j].x * v[j].x + v[j].y * v[j].y) + (v[j].z * v[j].z + v[j].w * v[j].w); }
    const float rstd = 1.f / sqrtf(wave_sum(s2) * (1.f / DM) + LN_EPS);
#pragma unroll
    for (int j = 0; j < 4; ++j) { const f32x4 gg = *((const f32x4*)g + lane + 64 * j), bb = *((const f32x4*)bta + lane + 64 * j); v[j] = v[j] * rstd * gg + bb; }
}
__device__ __forceinline__ void p7_ln1_router(const Frame& F, const Args& a) {
    const int gw = F.vcu * NWAVES + F.wave, NGW = F.G * NWAVES, l = F.lane;
    unsigned char* ws = a.ws; const float* x = a.in[I_X]; float* xo = a.out; bf16* x1b = (bf16*)(ws + WS_X1B); float* aff = (float*)(ws + WS_AFF);
    const f32x4* wrt = (const f32x4*)(ws + WS_WRT);
    for (int m = gw; m < T; m += NGW) {
        f32x4 v[4];
#pragma unroll
        for (int j = 0; j < 4; ++j) { const f32x4 xv = *((const f32x4*)(x + (size_t)m * DM) + l + 64 * j), mv = *((const f32x4*)(xo + (size_t)m * DM) + l + 64 * j); v[j] = xv * ALPHA + mv; }
        ln_row(v, a.in[I_LNAG], a.in[I_LNAB], l);
#pragma unroll
        for (int j = 0; j < 4; ++j) { *((f32x4*)(xo + (size_t)m * DM) + l + 64 * j) = v[j]; *((v2u*)(x1b + (size_t)m * DM) + l + 64 * j) = (v2u){pk2(v[j].x, v[j].y), pk2(v[j].z, v[j].w)}; }
        float lg[NE]; float mx = -1e30f;
#pragma unroll
        for (int e = 0; e < NE; ++e) { float s = 0.f;
#pragma unroll
            for (int j = 0; j < 4; ++j) { const f32x4 w = wrt[e * (DM / 4) + l + 64 * j]; s += (v[j].x * w.x + v[j].y * w.y) + (v[j].z * w.z + v[j].w * w.w); }
            lg[e] = wave_sum(s); mx = fmaxf(mx, lg[e]); }
        float den = 0.f;
#pragma unroll
        for (int e = 0; e < NE; ++e) { lg[e] = expf(lg[e] - mx); den += lg[e]; }
        const float inv = 1.0f / den; float mine = 0.f;
#pragma unroll
        for (int e = 0; e < NE; ++e) mine = (l == e) ? lg[e] * inv : mine;
        const int b = m >> 11, s_ = m & (SEQ - 1);
        if (l < NE) aff[((size_t)b * NE + l) * SEQ + s_] = mine;
    }
}
__device__ __forceinline__ unsigned block_excl_scan(const Frame& F, unsigned cnt, LAS unsigned* wsum, unsigned& total) {
    unsigned inc = cnt;
#pragma unroll
    for (int o = 1; o < 64; o <<= 1) { const unsigned t = __shfl_up(inc, o); if (F.lane >= o) inc += t; }
    __syncthreads();
    if (F.lane == 63) wsum[F.wave] = inc;
    __syncthreads();
    unsigned base = 0, tot = 0;
#pragma unroll
    for (int w = 0; w < NWAVES; ++w) { const unsigned s = wsum[w]; if (w < F.wave) base += s; tot += s; }
    total = tot; return base + inc - cnt;
}
__device__ __forceinline__ void p8_topk(const Frame& F, const Args& a) {
    unsigned char* ws = a.ws; const float* aff = (const float*)(ws + WS_AFF);
    int* rowmap = (int*)(ws + WS_ROWMAP); float* gval = (float*)(ws + WS_GVAL); int* sel = (int*)(ws + WS_SEL);
    LAS unsigned* hist = (LAS unsigned*)F.lds; LAS unsigned* wsum = hist + 256; LAS unsigned* bc = hist + 272;
    for (int task = F.vcu; task < NB * NE; task += F.G) {
        const int b = task / NE, e = task % NE;
        const f32x4 vv = *((const f32x4*)(aff + (size_t)task * SEQ) + F.tid);
        const float vf[4] = {vv.x, vv.y, vv.z, vv.w}; unsigned u[4];
#pragma unroll
        for (int i = 0; i < 4; ++i) u[i] = __builtin_bit_cast(unsigned, vf[i]);
        unsigned prefix = 0, kneed = CAP;
#pragma unroll 1
        for (int pass = 0; pass < 4; ++pass) {
            const int shift = 24 - 8 * pass;
            __syncthreads();
            if (F.tid < 256) hist[F.tid] = 0u;
            __syncthreads();
#pragma unroll
            for (int i = 0; i < 4; ++i) { const bool in = (pass == 0) || ((u[i] >> (shift + 8)) == prefix); if (in) atomicAdd((unsigned*)&hist[(u[i] >> shift) & 255u], 1u); }
            __syncthreads();
            if (F.wave == 0) {
                unsigned h0 = hist[4 * F.lane], h1 = hist[4 * F.lane + 1], h2 = hist[4 * F.lane + 2], h3 = hist[4 * F.lane + 3];
                const unsigned tl = h0 + h1 + h2 + h3; unsigned suf = tl;
#pragma unroll
                for (int o = 1; o < 64; o <<= 1) { const unsigned t = __shfl_down(suf, o); if (F.lane + o < 64) suf += t; }
                const unsigned above = suf - tl;
                const unsigned a3 = above, a2 = above + h3, a1 = a2 + h2, a0 = a1 + h1;
                int found = -1; unsigned nk = 0;
                if (a3 < kneed && kneed <= a3 + h3) { found = 4 * F.lane + 3; nk = kneed - a3; }
                else if (a2 < kneed && kneed <= a2 + h2) { found = 4 * F.lane + 2; nk = kneed - a2; }
                else if (a1 < kneed && kneed <= a1 + h1) { found = 4 * F.lane + 1; nk = kneed - a1; }
                else if (a0 < kneed && kneed <= a0 + h0) { found = 4 * F.lane; nk = kneed - a0; }
                if (found >= 0) { bc[0] = (unsigned)found; bc[1] = nk; }
            }
            __syncthreads();
            prefix = (prefix << 8) | bc[0]; kneed = bc[1];
        }
        unsigned ceq = 0;
#pragma unroll
        for (int i = 0; i < 4; ++i) ceq += (u[i] == prefix) ? 1u : 0u;
        unsigned tot; unsigned eqbase = block_excl_scan(F, ceq, wsum, tot);
        bool take[4]; unsigned csel = 0;
#pragma unroll
        for (int i = 0; i < 4; ++i) { const bool eq = (u[i] == prefix); take[i] = (u[i] > prefix) || (eq && eqbase < kneed); if (eq) ++eqbase; csel += take[i] ? 1u : 0u; }
        unsigned slot = block_excl_scan(F, csel, wsum, tot);
#pragma unroll
        for (int i = 0; i < 4; ++i) { const int tkn = F.tid * 4 + i; int sv = -1;
            if (take[i]) { sv = (int)slot; const size_t r = (size_t)e * (NB * CAP) + b * CAP + slot; rowmap[r] = b * SEQ + tkn; gval[r] = vf[i]; ++slot; }
            sel[((size_t)b * SEQ + tkn) * NE + e] = sv; }
    }
}
__device__ __forceinline__ void p11_ln2(const Frame& F, const Args& a) {
    const int gw = F.vcu * NWAVES + F.wave, NGW = F.G * NWAVES, l = F.lane;
    unsigned char* ws = a.ws; float* xo = a.out; bf16* x2b = (bf16*)(ws + WS_X1B); const bf16* yexp = (const bf16*)(ws + WS_YEXP); const int* sel = (const int*)(ws + WS_SEL);
    const float* p = a.in[I_P]; bf16* pb = (bf16*)(ws + WS_PB);
    for (int m = gw; m < T; m += NGW) {
        const int b = m >> 11;
        f32x4 v[4];
#pragma unroll
        for (int j = 0; j < 4; ++j) v[j] = *((const f32x4*)(xo + (size_t)m * DM) + l + 64 * j) * ALPHA;
        const int sv = (l < NE) ? sel[(size_t)m * NE + l] : -1;
#pragma unroll 1
        for (int e = 0; e < NE; ++e) { const int c = __shfl(sv, e); if (c >= 0) { const bf16* yr = yexp + ((size_t)e * (NB * CAP) + b * CAP + c) * DM;
#pragma unroll
            for (int j = 0; j < 4; ++j) { const v2u w = *((const v2u*)yr + l + 64 * j); v[j].x += bf2f(w.x & 0xffffu); v[j].y += bf2f(w.x >> 16); v[j].z += bf2f(w.y & 0xffffu); v[j].w += bf2f(w.y >> 16); } } }
        ln_row(v, a.in[I_LNFG], a.in[I_LNFB], l);
#pragma unroll
        for (int j = 0; j < 4; ++j) { *((f32x4*)(xo + (size_t)m * DM) + l + 64 * j) = v[j]; *((v2u*)(x2b + (size_t)m * DM) + l + 64 * j) = (v2u){pk2(v[j].x, v[j].y), pk2(v[j].z, v[j].w)}; }
        { const f32x4 pv = *((const f32x4*)(p + (size_t)m * PLE) + l); *((v2u*)(pb + (size_t)m * PLE) + l) = (v2u){pk2(pv.x, pv.y), pk2(pv.z, pv.w)}; }
    }
}
__device__ __forceinline__ void p13_ln3(const Frame& F, const Args& a) {
    const int gw = F.vcu * NWAVES + F.wave, NGW = F.G * NWAVES, l = F.lane;
    unsigned char* ws = a.ws; float* xo = a.out; const float* E = (const float*)(ws + WS_E); const float* Gt = (const float*)(ws + WS_G);
    for (int m = gw; m < T; m += NGW) {
        f32x4 v[4];
#pragma unroll
        for (int j = 0; j < 4; ++j) { const f32x4 xv = *((const f32x4*)(xo + (size_t)m * DM) + l + 64 * j), ev = *((const f32x4*)(E + (size_t)m * DM) + l + 64 * j), gv = *((const f32x4*)(Gt + (size_t)m * DM) + l + 64 * j);
            f32x4 sg; sg.x = 1.0f / (1.0f + expf(-gv.x)); sg.y = 1.0f / (1.0f + expf(-gv.y)); sg.z = 1.0f / (1.0f + expf(-gv.z)); sg.w = 1.0f / (1.0f + expf(-gv.w));
            v[j] = xv * ALPHA + sg * ev; }
        ln_row(v, a.in[I_LNPG], a.in[I_LNPB], l);
#pragma unroll
        for (int j = 0; j < 4; ++j) *((f32x4*)(xo + (size_t)m * DM) + l + 64 * j) = v[j];
    }
}

__global__ void __launch_bounds__(NWAVES * 64, 2) fwd(Args args) {
    extern __shared__ __attribute__((aligned(16))) unsigned char lds[];
    Frame F;
    F.lds = (LAS unsigned char*)lds; F.tid = threadIdx.x; F.lane = F.tid & 63; F.wave = __builtin_amdgcn_readfirstlane(F.tid >> 6);
    F.G = gridDim.x; { const int bx = blockIdx.x; F.vcu = (F.G % 8 == 0) ? (bx % 8) * (F.G / 8) + bx / 8 : bx; }
    unsigned char* ws = args.ws;
    const int lo = args.ph_lo, hi = args.ph_hi;
#define IN(k) (lo <= (k) && (k) < hi)
    volatile LAS unsigned* MISC = (volatile LAS unsigned*)(F.lds + 131072 + 320);
    for (int u = F.tid; u < (LDS_BYTES - 131072) / 4; u += NWAVES * 64) ((LAS unsigned*)(F.lds + 131072))[u] = 0u;
    __syncthreads();
    XcdBarrier bar; bar.bar = (unsigned*)(ws + WS_CTL) + 4096; bar.x = 0; bar.st = nullptr;
    if (hi - lo > 1) bar = xcd_barrier_post((unsigned*)(ws + WS_CTL) + 4096, MISC + 8);
#define SEAM(k) do { if (IN(k) && IN((k) + 1)) xcd_barrier(bar); } while (0)
    if (IN(0)) p0_convert(F, args);
    SEAM(0);
    if (IN(1)) { pg8::Gemm g{(const bf16*)(ws + WS_XB), (const bf16*)(ws + WS_WIN), T, INWP, DM}; pg8::StaticOrder S; S.init(T, INWP, F.G, (int)blockIdx.x);
        pg8::EpiF32 E{(float*)(ws + WS_PROJ), INWP}; pg8::gemm_phase<pg8::EpiF32, pg8::StaticOrder, true>(F.lds, g, S, E); }
    SEAM(1);
    if (IN(2)) p2_qkv_post(F, args);
    SEAM(2);
    if (IN(3)) {
        { pg8::Gemm g{(const bf16*)(ws + WS_CQ), (const bf16*)(ws + WS_WUQ), T, UQW, 256}; pg8::StaticOrder S; S.init(T, UQW, F.G, (int)blockIdx.x);
          pg8::EpiF32 E{(float*)(ws + WS_QM), UQW}; pg8::gemm_phase<pg8::EpiF32, pg8::StaticOrder, true>(F.lds, g, S, E); }
        { pg8::Gemm g{(const bf16*)(ws + WS_CKV), (const bf16*)(ws + WS_WUKV), T, UKVW, 256}; pg8::StaticOrder S; S.init(T, UKVW, F.G, (int)blockIdx.x);
          pg8::EpiF32 E{(float*)(ws + WS_KV), UKVW}; pg8::gemm_phase<pg8::EpiF32, pg8::StaticOrder, true>(F.lds, g, S, E); }
    }
    SEAM(3);
    if (IN(4)) p4_mla_post(F, args);
    SEAM(4);
    if (IN(5)) p5_attention(F, args);
    SEAM(5);
    if (IN(6)) { pg8::Gemm g{(const bf16*)(ws + WS_O), (const bf16*)(ws + WS_WOUT), T, DM, DM}; pg8::StaticOrder S; S.init(T, DM, F.G, (int)blockIdx.x);
        pg8::EpiF32 E{args.out, DM}; pg8::gemm_phase<pg8::EpiF32, pg8::StaticOrder, true>(F.lds, g, S, E); }
    SEAM(6);
    if (IN(7)) p7_ln1_router(F, args);
    SEAM(7);
    if (IN(8)) p8_topk(F, args);
    SEAM(8);
    if (IN(9)) { pg8::Gemm g{(const bf16*)(ws + WS_X1B), (const bf16*)(ws + WS_WGU), NE * NB * CAP, 2 * FF, DM}; pg8::GatherOrder S; S.init(NE * NB * CAP, 2 * FF, F.G, (int)blockIdx.x, NB * CAP / 256); S.rowmap = (const int*)(ws + WS_ROWMAP);
        pg8::EpiSwiGLU E{(bf16*)(ws + WS_H), FF}; pg8::gemm_phase<pg8::EpiSwiGLU, pg8::GatherOrder, true>(F.lds, g, S, E); }
    SEAM(9);
    if (IN(10)) { pg8::Gemm g{(const bf16*)(ws + WS_H), (const bf16*)(ws + WS_WDN), NE * NB * CAP, DM, FF}; pg8::StaticOrder S; S.init(NE * NB * CAP, DM, F.G, (int)blockIdx.x, NB * CAP / 256);
        pg8::EpiRowScaleBf16 E{(bf16*)(ws + WS_YEXP), DM, (const float*)(ws + WS_GVAL)}; pg8::gemm_phase<pg8::EpiRowScaleBf16, pg8::StaticOrder, true>(F.lds, g, S, E); }
    SEAM(10);
    if (IN(11)) p11_ln2(F, args);
    SEAM(11);
    if (IN(12)) {
        { pg8::Gemm g{(const bf16*)(ws + WS_PB), (const bf16*)(ws + WS_WPP), T, DM, PLE}; pg8::StaticOrder S; S.init(T, DM, F.G, (int)blockIdx.x);
          pg8::EpiF32 E{(float*)(ws + WS_E), DM}; pg8::gemm_phase<pg8::EpiF32, pg8::StaticOrder, true>(F.lds, g, S, E); }
        { pg8::Gemm g{(const bf16*)(ws + WS_X1B), (const bf16*)(ws + WS_WPG), T, DM, DM}; pg8::StaticOrder S; S.init(T, DM, F.G, (int)blockIdx.x);
          pg8::EpiF32 E{(float*)(ws + WS_G), DM}; pg8::gemm_phase<pg8::EpiF32, pg8::StaticOrder, true>(F.lds, g, S, E); }
    }
    SEAM(12);
    if (IN(13)) p13_ln3(F, args);
#undef IN
#undef SEAM
}

constexpr int NPHASES = 14;
extern "C" void kernel_launch(void* const* d_in, const int* in_sizes, int n_in, void* d_out, int out_size, void* d_ws, size_t ws_size, hipStream_t stream) {
    static int grid = 0;
    if (grid == 0) {
        if (n_in != 22 || in_sizes[0] != T * DM || out_size != T * DM || ws_size < WS_END) { fprintf(stderr, "kernel_launch: unexpected shapes (n_in %d, in0 %d, out %d, ws %zu < %zu?)\n", n_in, n_in > 0 ? in_sizes[0] : -1, out_size, ws_size, (size_t)WS_END); grid = -1; return; }
        if (hipFuncSetAttribute((const void*)fwd, hipFuncAttributeMaxDynamicSharedMemorySize, LDS_BYTES) != hipSuccess) { fprintf(stderr, "kernel_launch: hipFuncSetAttribute failed\n"); grid = -1; return; }
        int dev = 0, cus = 0, per_cu = 0;
        if (hipGetDevice(&dev) != hipSuccess || hipDeviceGetAttribute(&cus, hipDeviceAttributeMultiprocessorCount, dev) != hipSuccess) { fprintf(stderr, "kernel_launch: device query failed\n"); grid = -1; return; }
        if (hipOccupancyMaxActiveBlocksPerMultiprocessor(&per_cu, (const void*)fwd, NWAVES * 64, LDS_BYTES) != hipSuccess || per_cu < 1) { fprintf(stderr, "kernel_launch: occupancy query says %d blocks per CU\n", per_cu); (void)hipGetLastError(); grid = -1; return; }
        grid = cus;
    }
    if (grid < 0) return;
    Args a{};
    for (int i = 0; i < 22; ++i) a.in[i] = (const float*)d_in[i];
    a.out = (float*)d_out; a.ws = (unsigned char*)d_ws;
#if MK_ONE_LAUNCH
    hipMemsetAsync((char*)d_ws + WS_CTL, 0, 65536, stream);
    a.ph_lo = 0; a.ph_hi = NPHASES;
    hipLaunchKernelGGL(fwd, dim3(grid), dim3(NWAVES * 64), LDS_BYTES, stream, a);
#else
    for (int ph = 0; ph < NPHASES; ++ph) {
        a.ph_lo = ph; a.ph_hi = ph + 1;
        hipLaunchKernelGGL(fwd, dim3(grid), dim3(NWAVES * 64), LDS_BYTES, stream, a);
    }
#endif
}
```

```cpp
#include <hip/hip_runtime.h>
#include <cstdio>
#include <cstdint>

#ifndef MK_ONE_LAUNCH
#define MK_ONE_LAUNCH 1
#endif

__device__ __forceinline__ int fresh_lane() { int l = (int)__builtin_amdgcn_mbcnt_hi(~0u, __builtin_amdgcn_mbcnt_lo(~0u, 0u)); asm volatile("" : "+v"(l)); return l; }
namespace pg8 {
#define PG8_LAS __attribute__((address_space(3)))
typedef unsigned short bf16_t;
typedef short bf16x8 __attribute__((ext_vector_type(8)));
typedef float f32x4 __attribute__((ext_vector_type(4)));
typedef unsigned u32x4 __attribute__((ext_vector_type(4)));
typedef unsigned u32x2 __attribute__((ext_vector_type(2)));
constexpr int BM = 256, BK = 64, HALF = 128, HTB = HALF * BK * 2  , STAGE_BYTES = 8 * HTB, NXCD = 8, WGM = 8;

__host__ __device__ __forceinline__ int lds_byte(int r, int c) { const int st = (r >> 4) * 2 + (c >> 5), rr = r & 15, cc = c & 31, ob = rr * 64 + cc * 2; return st * 1024 + (ob ^ (((ob >> 9) & 1) << 5)); }
__host__ __device__ __forceinline__ void stage_rc(int b, int& R, int& C) { const int st = b / 1024, sb = b % 1024, swz = sb ^ (((sb >> 9) & 1) << 5); R = (st >> 1) * 16 + swz / 64; C = (st & 1) * 32 + (swz % 64) / 2; }
__host__ __device__ __forceinline__ int perm32(int rho) { const int n = rho >> 4, i = rho & 15; return 8 * (i >> 2) + 4 * n + (i & 3); }

struct Unit { int pm, pn; };
struct Gemm { const bf16_t* A; const bf16_t* Bt; int M, N, K; };

struct StaticOrder {
    static constexpr bool GATHER = false;
    int nM, nN, nwg, G, c, mpe;
    __host__ __device__ void init(int M, int N, int G_, int c_, int mpe_ = 0) { nM = M / BM; nN = N / BM; nwg = nM * nN; G = G_; c = c_; mpe = mpe_; }
    __host__ __device__ bool next(int i, Unit& u) const {
        const long L = (long)i * G + c; if (L >= nwg) return false;
        int wgid = (int)L; { const int q = nwg / NXCD, r = nwg % NXCD, xcd = wgid % NXCD, off = wgid / NXCD; wgid = (xcd < r ? xcd * (q + 1) : r * (q + 1) + (xcd - r) * q) + off; }
        const int nig = WGM * nN, gid = wgid / nig, fm = gid * WGM, gsz = (nM - fm) < WGM ? (nM - fm) : WGM;
        u.pm = fm + ((wgid % nig) % gsz); u.pn = (wgid % nig) / gsz; return true;
    }
    __host__ __device__ __forceinline__ int btile(const Unit& u) const { return mpe ? (u.pm / mpe) * nN + u.pn : u.pn; }
    __device__ __forceinline__ unsigned arow(const Unit&, int) const { return 0u; }
};
struct GatherOrder : StaticOrder {
    static constexpr bool GATHER = true;
    const int* rowmap;
    __device__ __forceinline__ unsigned arow(const Unit& u, int r) const { return (unsigned)rowmap[u.pm * BM + r]; }
};

__device__ __forceinline__ unsigned cvt_pk_bf16(float lo, float hi) { unsigned r; asm volatile("v_cvt_pk_bf16_f32 %0, %1, %2" : "=v"(r) : "v"(lo), "v"(hi)); return r; }

struct EpiF32 {
    static constexpr bool PERM = false;
    float* O; int ldc;
    __device__ __forceinline__ void operator()(const f32x4 (&acc)[2][2][4][2], const Unit& u, int wr, int wc, int fr, int fq) const {
        asm volatile("" : "+v"(fr), "+v"(fq));
        const int row0 = u.pm * BM + wr * 64 + fr, col0 = u.pn * BM + wc * 32 + 4 * fq;
#pragma unroll
        for (int ai = 0; ai < 2; ++ai)
#pragma unroll
            for (int m = 0; m < 4; ++m) { float* rowp = O + (size_t)(row0 + ai * HALF + m * 16) * ldc + col0;
#pragma unroll
                for (int bj = 0; bj < 2; ++bj)
#pragma unroll
                    for (int n = 0; n < 2; ++n) *(f32x4*)(rowp + bj * HALF + n * 16) = acc[ai][bj][m][n]; }
    }
};
struct EpiSwiGLU {
    static constexpr bool PERM = false;
    bf16_t* H; int ldh;
    __device__ __forceinline__ void operator()(const f32x4 (&acc)[2][2][4][2], const Unit& u, int wr, int wc, int fr, int fq) const {
        asm volatile("" : "+v"(fr), "+v"(fq));
        const int row0 = u.pm * BM + wr * 64 + fr, col0 = u.pn * HALF + wc * 32 + 4 * fq;
#pragma unroll
        for (int ai = 0; ai < 2; ++ai)
#pragma unroll
            for (int m = 0; m < 4; ++m) { bf16_t* rowp = H + (size_t)(row0 + ai * HALF + m * 16) * ldh + col0;
#pragma unroll
                for (int n = 0; n < 2; ++n) { const f32x4 g = acc[ai][0][m][n], up = acc[ai][1][m][n]; float h[4];
#pragma unroll
                    for (int j = 0; j < 4; ++j) { const float s = __builtin_amdgcn_rcpf(1.0f + __builtin_amdgcn_exp2f(-1.4426950408889634f * g[j])); h[j] = g[j] * s * up[j]; }
                    u32x2 w; w.x = cvt_pk_bf16(h[0], h[1]); w.y = cvt_pk_bf16(h[2], h[3]); *(u32x2*)(rowp + n * 16) = w; } }
    }
};
struct EpiRowScaleBf16 {
    static constexpr bool PERM = false;
    bf16_t* O; int ldc; const float* rs;
    __device__ __forceinline__ void operator()(const f32x4 (&acc)[2][2][4][2], const Unit& u, int wr, int wc, int fr, int fq) const {
        asm volatile("" : "+v"(fr), "+v"(fq));
        const int row0 = u.pm * BM + wr * 64 + fr, col0 = u.pn * BM + wc * 32 + 4 * fq;
#pragma unroll
        for (int ai = 0; ai < 2; ++ai)
#pragma unroll
            for (int m = 0; m < 4; ++m) { int row = row0 + ai * HALF + m * 16; asm volatile("" : "+v"(row) :: "memory"); const float s = rs[row]; bf16_t* rowp = O + (size_t)row * ldc + col0;
#pragma unroll
                for (int bj = 0; bj < 2; ++bj)
#pragma unroll
                    for (int n = 0; n < 2; ++n) { const f32x4 v = acc[ai][bj][m][n] * s; u32x2 w; w.x = cvt_pk_bf16(v[0], v[1]); w.y = cvt_pk_bf16(v[2], v[3]); *(u32x2*)(rowp + bj * HALF + n * 16) = w; } }
    }
};

constexpr int TAB_OFF = 131072 + 1024, TAB_COS64 = TAB_OFF, TAB_SIN64 = TAB_OFF + 4096, TAB_COS32 = TAB_OFF + 8192, TAB_SIN32 = TAB_OFF + 10240;
constexpr float kRmsEps = 1e-6f, kAlpha = 1.189207115002721f, kInv2Pi = 0.15915494309189535f, kLog2Base = 13.287712379549449f;
__device__ __forceinline__ void sincos_rev(float pos, float ivr, float& s, float& c) { float rev = pos * ivr; rev = rev - floorf(rev); s = __builtin_amdgcn_sinf(rev); c = __builtin_amdgcn_cosf(rev); }
__device__ __forceinline__ void st_bf16x4(bf16_t* p, const f32x4 v) { u32x2 w; w.x = cvt_pk_bf16(v[0], v[1]); w.y = cvt_pk_bf16(v[2], v[3]); *(u32x2*)p = w; }
__device__ __forceinline__ float sumsq4(const f32x4 x) { return (x[0] * x[0] + x[1] * x[1]) + (x[2] * x[2] + x[3] * x[3]); }
struct EpiProj {
    static constexpr bool PERM = false;
    bf16_t *QG, *KG, *VG, *CQ, *CKV, *KPE; float *SSQ, *SSKV; const float *qn, *kn; PG8_LAS const unsigned char* lds;
    __device__ __forceinline__ void operator()(const f32x4 (&acc)[2][2][4][2], const Unit& u, int wr, int wc, int fr, int fq) const {
        asm volatile("" : "+v"(fr), "+v"(fq));
        const int pn = u.pn, row0 = u.pm * BM + wr * 64 + fr;
        if (pn <= 2) {
            if (pn == 2 && wc >= 2) {
#pragma unroll
                for (int ai = 0; ai < 2; ++ai)
#pragma unroll
                    for (int m = 0; m < 4; ++m) { bf16_t* rowp = VG + (size_t)(row0 + ai * HALF + m * 16) * 128 + (wc - 2) * 64 + 4 * fq;
#pragma unroll
                        for (int bj = 0; bj < 2; ++bj)
#pragma unroll
                            for (int n = 0; n < 2; ++n) st_bf16x4(rowp + 32 * bj + 16 * n, acc[ai][bj][m][n]); }
            } else {
                const float* gn = (pn < 2) ? qn : kn;
                bf16_t* dst = (pn < 2) ? QG + (pn * 4 + wc) * 64 : KG + wc * 64; const int ldd = (pn < 2) ? 512 : 128;
                const int prow = 4 * (u.pm & 7) + wr;
#pragma unroll
                for (int m = 0; m < 4; ++m)
#pragma unroll
                    for (int ai = 0; ai < 2; ++ai) {
                        float ss = (sumsq4(acc[ai][0][m][0]) + sumsq4(acc[ai][0][m][1])) + (sumsq4(acc[ai][1][m][0]) + sumsq4(acc[ai][1][m][1]));
                        ss += __shfl_xor(ss, 16); ss += __shfl_xor(ss, 32);
                        const float rs = 1.0f / sqrtf(ss * (1.0f / 64.0f) + kRmsEps);
                        int row = row0 + ai * HALF + m * 16; asm volatile("" : "+v"(row) :: "memory");
                        bf16_t* rowp = dst + (size_t)row * ldd + 4 * fq;
#pragma unroll
                        for (int bj = 0; bj < 2; ++bj) { const int pos = bj ? (16 * m + fr) : (prow + 2 * ai);
                            const f32x4 c = *(const PG8_LAS f32x4*)(lds + TAB_COS64 + pos * 64 + fq * 16), s = *(const PG8_LAS f32x4*)(lds + TAB_SIN64 + pos * 64 + fq * 16);
                            const f32x4 g0 = *(const f32x4*)(gn + 32 * bj + 4 * fq), g1 = *(const f32x4*)(gn + 32 * bj + 16 + 4 * fq);
                            const f32x4 x1 = acc[ai][bj][m][0] * rs * g0, x2 = acc[ai][bj][m][1] * rs * g1;
                            st_bf16x4(rowp + 32 * bj, x1 * c - x2 * s); st_bf16x4(rowp + 32 * bj + 16, x2 * c + x1 * s); }
                        asm volatile("" ::: "memory"); }
            }
        } else if (pn <= 4) {
            bf16_t* dst = (pn == 3) ? CQ : CKV; float* sd = (pn == 3) ? SSQ : SSKV;
#pragma unroll
            for (int ai = 0; ai < 2; ++ai)
#pragma unroll
                for (int m = 0; m < 4; ++m) { int row = row0 + ai * HALF + m * 16; asm volatile("" : "+v"(row) :: "memory");
                    float ss = (sumsq4(acc[ai][0][m][0]) + sumsq4(acc[ai][0][m][1])) + (sumsq4(acc[ai][1][m][0]) + sumsq4(acc[ai][1][m][1]));
                    ss += __shfl_xor(ss, 16); ss += __shfl_xor(ss, 32);
                    if (fq == 0) sd[(size_t)row * 4 + wc] = ss;
                    bf16_t* rowp = dst + (size_t)row * 256 + wc * 32 + 4 * fq;
#pragma unroll
                    for (int bj = 0; bj < 2; ++bj)
#pragma unroll
                        for (int n = 0; n < 2; ++n) st_bf16x4(rowp + 128 * bj + 16 * n, acc[ai][bj][m][n]); }
        } else if (wc == 0) {
            const int prow = 4 * (u.pm & 7) + wr;
#pragma unroll
            for (int ai = 0; ai < 2; ++ai)
#pragma unroll
                for (int m = 0; m < 4; ++m) { const int pos = (fq >> 1) ? (16 * m + fr) : (prow + 2 * ai);
                    const f32x4 c = *(const PG8_LAS f32x4*)(lds + TAB_COS32 + pos * 32 + (fq & 1) * 16), s = *(const PG8_LAS f32x4*)(lds + TAB_SIN32 + pos * 32 + (fq & 1) * 16);
                    const f32x4 x1 = acc[ai][0][m][0], x2 = acc[ai][0][m][1];
                    bf16_t* rowp = KPE + (size_t)(row0 + ai * HALF + m * 16) * 32 + 16 * (fq >> 1) + 4 * (fq & 1);
                    st_bf16x4(rowp, x1 * c - x2 * s); st_bf16x4(rowp + 8, x2 * c + x1 * s); }
        }
    }
};
struct EpiMlaQ {
    static constexpr bool PERM = false;
    bf16_t* QM; const float* SSQ; PG8_LAS const unsigned char* lds;
    __device__ __forceinline__ void operator()(const f32x4 (&acc)[2][2][4][2], const Unit& u, int wr, int wc, int fr, int fq) const {
        asm volatile("" : "+v"(fr), "+v"(fq));
        const int pn = u.pn, row0 = u.pm * BM + wr * 64 + fr, prow = 4 * (u.pm & 7) + wr;
#pragma unroll
        for (int ai = 0; ai < 2; ++ai)
#pragma unroll
            for (int m = 0; m < 4; ++m) { int row = row0 + ai * HALF + m * 16; asm volatile("" : "+v"(row) :: "memory"); const f32x4 p = *(const f32x4*)(SSQ + (size_t)row * 4);
                const float rs = 1.0f / sqrtf(((p[0] + p[1]) + (p[2] + p[3])) * (1.0f / 256.0f) + kRmsEps); bf16_t* rowp = QM + (size_t)row * 768;
                if (pn < 2) {
#pragma unroll
                    for (int bj = 0; bj < 2; ++bj)
#pragma unroll
                        for (int n = 0; n < 2; ++n) st_bf16x4(rowp + (4 * pn + 2 * bj + (wc >> 1)) * 96 + 32 * (wc & 1) + 16 * n + 4 * fq, acc[ai][bj][m][n] * rs);
                } else {
                    const int pos = (fq >> 1) ? (16 * m + fr) : (prow + 2 * ai);
                    const f32x4 c = *(const PG8_LAS f32x4*)(lds + TAB_COS32 + pos * 32 + (fq & 1) * 16), s = *(const PG8_LAS f32x4*)(lds + TAB_SIN32 + pos * 32 + (fq & 1) * 16);
#pragma unroll
                    for (int bj = 0; bj < 2; ++bj) { const f32x4 x1 = acc[ai][bj][m][0] * rs, x2 = acc[ai][bj][m][1] * rs;
                        bf16_t* hp = rowp + (4 * bj + wc) * 96 + 64 + 16 * (fq >> 1) + 4 * (fq & 1); st_bf16x4(hp, x1 * c - x2 * s); st_bf16x4(hp + 8, x2 * c + x1 * s); }
                }
                asm volatile("" ::: "memory"); }
    }
};
struct EpiMlaKV {
    static constexpr bool PERM = false;
    bf16_t *KN, *VM; const float* SSKV;
    __device__ __forceinline__ void operator()(const f32x4 (&acc)[2][2][4][2], const Unit& u, int wr, int wc, int fr, int fq) const {
        asm volatile("" : "+v"(fr), "+v"(fq));
        const int row0 = u.pm * BM + wr * 64 + fr;
#pragma unroll
        for (int ai = 0; ai < 2; ++ai)
#pragma unroll
            for (int m = 0; m < 4; ++m) { int row = row0 + ai * HALF + m * 16; asm volatile("" : "+v"(row) :: "memory"); const f32x4 p = *(const f32x4*)(SSKV + (size_t)row * 4);
                const float rs = 1.0f / sqrtf(((p[0] + p[1]) + (p[2] + p[3])) * (1.0f / 256.0f) + kRmsEps);
                bf16_t* rowp = ((wc < 2) ? KN : VM) + (size_t)row * 512 + (wc & 1) * 32 + 4 * fq;
#pragma unroll
                for (int bj = 0; bj < 2; ++bj)
#pragma unroll
                    for (int n = 0; n < 2; ++n) st_bf16x4(rowp + (2 * u.pn + bj) * 64 + 16 * n, acc[ai][bj][m][n] * rs); }
    }
};
struct EpiResid {
    static constexpr bool PERM = false;
    float* O; const float* X; int ldc;
    __device__ __forceinline__ void operator()(const f32x4 (&acc)[2][2][4][2], const Unit& u, int wr, int wc, int fr, int fq) const {
        asm volatile("" : "+v"(fr), "+v"(fq));
        const int row0 = u.pm * BM + wr * 64 + fr, col0 = u.pn * BM + wc * 32 + 4 * fq;
#pragma unroll
        for (int ai = 0; ai < 2; ++ai)
#pragma unroll
            for (int m = 0; m < 4; ++m) { int row = row0 + ai * HALF + m * 16; asm volatile("" : "+v"(row) :: "memory"); const size_t off = (size_t)row * ldc + col0;
#pragma unroll
                for (int bj = 0; bj < 2; ++bj)
#pragma unroll
                    for (int n = 0; n < 2; ++n) { const f32x4 xv = *(const f32x4*)(X + off + bj * HALF + n * 16); *(f32x4*)(O + off + bj * HALF + n * 16) = xv * kAlpha + acc[ai][bj][m][n]; } }
    }
};
struct EpiPle {
    static constexpr bool PERM = false;
    float* O; const float* E; int ldc;
    __device__ __forceinline__ void operator()(const f32x4 (&acc)[2][2][4][2], const Unit& u, int wr, int wc, int fr, int fq) const {
        asm volatile("" : "+v"(fr), "+v"(fq));
        const int row0 = u.pm * BM + wr * 64 + fr, col0 = u.pn * BM + wc * 32 + 4 * fq;
#pragma unroll
        for (int ai = 0; ai < 2; ++ai)
#pragma unroll
            for (int m = 0; m < 4; ++m) { int row = row0 + ai * HALF + m * 16; asm volatile("" : "+v"(row) :: "memory"); const size_t off = (size_t)row * ldc + col0;
#pragma unroll
                for (int bj = 0; bj < 2; ++bj)
#pragma unroll
                    for (int n = 0; n < 2; ++n) { const f32x4 xv = *(const f32x4*)(O + off + bj * HALF + n * 16), ev = *(const f32x4*)(E + off + bj * HALF + n * 16), a = acc[ai][bj][m][n]; f32x4 o;
#pragma unroll
                        for (int j = 0; j < 4; ++j) o[j] = xv[j] * kAlpha + ev[j] * __builtin_amdgcn_rcpf(1.0f + __builtin_amdgcn_exp2f(-1.4426950408889634f * a[j]));
                        *(f32x4*)(O + off + bj * HALF + n * 16) = o; } }
    }
};

template <class Epi, class Sched, bool ALIGN_EPI>
__device__ __forceinline__ void gemm_phase(PG8_LAS unsigned char* lds, const Gemm g, const Sched& S, const Epi& E, int wid) {
    constexpr bool GATHER = Sched::GATHER;
    const int lane = fresh_lane(), tid = wid * 64 + lane, wr = wid >> 2, wc = wid & 3, fr = lane & 15, fq = lane >> 4;
    const int K = g.K, nt = K / BK;
    unsigned voffB[2], vC0[2], vC1[2], vN0[2], vN1[2]; int RA[2]; unsigned cofA[2];
#pragma unroll
    for (int i = 0; i < 2; ++i) { int R, C; stage_rc(tid * 16 + i * 8192, R, C); const int Rb = Epi::PERM ? ((R & ~31) + perm32(R & 31)) : R;
        vC0[i] = (unsigned)(R * K + C) * 2u; vC1[i] = vC0[i]; vN0[i] = vC0[i]; vN1[i] = vC0[i]; voffB[i] = (unsigned)(Rb * K + C) * 2u; RA[i] = R; cofA[i] = (unsigned)C * 2u; }
    const size_t kstep = (size_t)(BK * 2);
    const size_t hstep = (size_t)HALF * K * 2;
    const size_t hstepA = GATHER ? (size_t)0 : hstep;
    const size_t tstep = 2 * hstep;
    const unsigned ldsw = (unsigned)wid * 1024u;
    const int aoff = lds_byte(wr * 64 + fr, fq * 8), boff = lds_byte(wc * 32 + fr, fq * 8);
#define PG8_SA(b, h) (((b) * 2 + (h)) * HTB)
#define PG8_SB(b, h) ((4 + (b) * 2 + (h)) * HTB)
#define PG8_STAGE(bufoff, gbase, voff) do { _Pragma("unroll") for (int _i = 0; _i < 2; ++_i) \
        __builtin_amdgcn_global_load_lds((const unsigned*)((const char*)(gbase) + (voff)[_i]), (PG8_LAS unsigned*)(lds + (bufoff) + ldsw + _i * 8192), 16, 0, 0); } while (0)
#define PG8_LDA(dst, b, h) do { _Pragma("unroll") for (int m = 0; m < 4; ++m) _Pragma("unroll") for (int k = 0; k < 2; ++k) dst[m][k] = *(const PG8_LAS bf16x8*)(lds + PG8_SA(b, h) + aoff + m * 2048 + k * 1024); } while (0)
#define PG8_LDB(dst, b, h) do { _Pragma("unroll") for (int n = 0; n < 2; ++n) _Pragma("unroll") for (int k = 0; k < 2; ++k) dst[n][k] = *(const PG8_LAS bf16x8*)(lds + PG8_SB(b, h) + boff + n * 2048 + k * 1024); } while (0)
#define PG8_MMA(ai, bj, At, Bt) do { __builtin_amdgcn_s_setprio(1); _Pragma("unroll") for (int m = 0; m < 4; ++m) _Pragma("unroll") for (int n = 0; n < 2; ++n) _Pragma("unroll") for (int k = 0; k < 2; ++k) \
        acc[ai][bj][m][n] = __builtin_amdgcn_mfma_f32_16x16x32_bf16(Bt[n][k], At[m][k], acc[ai][bj][m][n], 0, 0, 0); __builtin_amdgcn_s_setprio(0); } while (0)
#define PG8_WAIT_V(n) asm volatile("s_waitcnt vmcnt(" #n ")" ::: "memory")
#define PG8_WAIT_L(n) asm volatile("s_waitcnt lgkmcnt(" #n ")" ::: "memory")
#define PG8_BAR __builtin_amdgcn_s_barrier()
#define PG8_SCHED __builtin_amdgcn_sched_barrier(0)
#define PG8_AROWS(u, d0, d1) do { if constexpr (GATHER) { _Pragma("unroll") for (int _i = 0; _i < 2; ++_i) { \
        d0[_i] = S.arow(u, RA[_i]) * (unsigned)(K * 2) + cofA[_i]; d1[_i] = S.arow(u, HALF + RA[_i]) * (unsigned)(K * 2) + cofA[_i]; } } } while (0)
    Unit cur, nxt; int ui = 0;
    if (!S.next(0, cur)) return;
    f32x4 acc[2][2][4][2];
#pragma unroll
    for (int a = 0; a < 2; ++a)
#pragma unroll
        for (int b = 0; b < 2; ++b)
#pragma unroll
            for (int m = 0; m < 4; ++m)
#pragma unroll
                for (int n = 0; n < 2; ++n) acc[a][b][m][n] = (f32x4){0.f, 0.f, 0.f, 0.f};
    bf16x8 At[4][2], B0[2][2], B1[2][2];
    const char* cA = GATHER ? (const char*)g.A : (const char*)g.A + (size_t)cur.pm * tstep; const char* cB = (const char*)g.Bt + (size_t)S.btile(cur) * tstep;
    PG8_AROWS(cur, vC0, vC1);
    PG8_STAGE(PG8_SB(0, 0), cB, voffB); PG8_STAGE(PG8_SB(0, 1), cB + hstep, voffB); PG8_STAGE(PG8_SA(0, 0), cA, vC0); PG8_STAGE(PG8_SA(0, 1), cA + hstepA, vC1);
    if (wr == 1) PG8_BAR;
    PG8_WAIT_V(2); PG8_BAR;
    PG8_STAGE(PG8_SB(1, 0), cB + kstep, voffB); PG8_STAGE(PG8_SA(1, 0), cA + kstep, vC0); PG8_STAGE(PG8_SB(1, 1), cB + hstep + kstep, voffB);
    PG8_WAIT_V(6); PG8_BAR;
    for (;;) {
        const bool has_next = S.next(ui + 1, nxt);
        const char* nA = GATHER ? (const char*)g.A : (has_next ? (const char*)g.A + (size_t)nxt.pm * tstep : cA); const char* nB = has_next ? (const char*)g.Bt + (size_t)S.btile(nxt) * tstep : cB;
        if constexpr (GATHER) { if (has_next) { PG8_AROWS(nxt, vN0, vN1); } else { vN0[0] = vC0[0]; vN0[1] = vC0[1]; vN1[0] = vC1[0]; vN1[1] = vC1[1]; } }
        for (int t = 0; t < nt; t += 2) {
            const bool last = (t == nt - 2);
            const char* a1 = cA + (size_t)(t + 1) * kstep;
            const char* a2 = last ? nA : cA + (size_t)(t + 2) * kstep; const char* b2 = last ? nB : cB + (size_t)(t + 2) * kstep;
            const char* a3 = a2 + kstep; const char* b3 = b2 + kstep;
            PG8_LDB(B0, 0, 0); PG8_LDB(B1, 0, 1); PG8_SCHED; PG8_LDA(At, 0, 0); PG8_STAGE(PG8_SA(1, 1), a1 + hstepA, vC1);
            if constexpr (GATHER) { if (last) { vC0[0] = vN0[0]; vC0[1] = vN0[1]; vC1[0] = vN1[0]; vC1[1] = vN1[1]; } }
            PG8_WAIT_V(8); PG8_WAIT_L(0); PG8_BAR; PG8_MMA(0, 0, At, B0); PG8_MMA(0, 1, At, B1); PG8_BAR; PG8_SCHED;
            PG8_LDA(At, 0, 1); PG8_STAGE(PG8_SB(0, 0), b2, voffB); PG8_STAGE(PG8_SB(0, 1), b2 + hstep, voffB); PG8_STAGE(PG8_SA(0, 0), a2, vC0);
            PG8_WAIT_V(8); PG8_WAIT_L(0); PG8_BAR; PG8_MMA(1, 0, At, B0); PG8_MMA(1, 1, At, B1); PG8_BAR; PG8_SCHED;
            PG8_LDB(B0, 1, 0); PG8_LDB(B1, 1, 1); PG8_SCHED; PG8_LDA(At, 1, 0); PG8_STAGE(PG8_SA(0, 1), a2 + hstepA, vC1);
            PG8_WAIT_V(8); PG8_WAIT_L(0); PG8_BAR; PG8_MMA(0, 0, At, B0); PG8_MMA(0, 1, At, B1); PG8_BAR; PG8_SCHED;
            PG8_LDA(At, 1, 1); PG8_STAGE(PG8_SB(1, 0), b3, voffB); PG8_STAGE(PG8_SB(1, 1), b3 + hstep, voffB); PG8_STAGE(PG8_SA(1, 0), a3, vC0);
            PG8_WAIT_V(8); PG8_WAIT_L(0); PG8_BAR; PG8_MMA(1, 0, At, B0); PG8_MMA(1, 1, At, B1); PG8_BAR; PG8_SCHED;
        }
        if constexpr (ALIGN_EPI) { if (wr == 0) PG8_BAR; }
        E(acc, cur, wr, wc, fr, fq);
        if (!has_next) break;
#pragma unroll
        for (int a = 0; a < 2; ++a)
#pragma unroll
            for (int b = 0; b < 2; ++b)
#pragma unroll
                for (int m = 0; m < 4; ++m)
#pragma unroll
                    for (int n = 0; n < 2; ++n) acc[a][b][m][n] = (f32x4){0.f, 0.f, 0.f, 0.f};
        cur = nxt; cA = nA; cB = nB; ++ui;
        if constexpr (ALIGN_EPI) { if (wr == 1) PG8_BAR; }
    }
    PG8_WAIT_V(0);
    if constexpr (!ALIGN_EPI) { if (wr == 0) PG8_BAR; }
    PG8_BAR;
#undef PG8_SA
#undef PG8_SB
#undef PG8_STAGE
#undef PG8_LDA
#undef PG8_LDB
#undef PG8_MMA
#undef PG8_WAIT_V
#undef PG8_WAIT_L
#undef PG8_BAR
#undef PG8_SCHED
#undef PG8_AROWS
}
}

namespace att {
using bf16_t = unsigned short;
using bf16x8 = __attribute__((ext_vector_type(8))) short;
using s16x4  = __attribute__((ext_vector_type(4))) short;
using f32x16 = __attribute__((ext_vector_type(16))) float;
using u32x4  = __attribute__((ext_vector_type(4))) unsigned;
#define SBAR() __builtin_amdgcn_sched_barrier(0)
constexpr float THR = 8.f;
__device__ __forceinline__ int crow(int r, int hi) { return (r & 3) + 8 * (r >> 2) + 4 * hi; }
__device__ __forceinline__ unsigned cvtpk(float lo, float hi) { unsigned r; asm volatile("v_cvt_pk_bf16_f32 %0, %1, %2" : "=v"(r) : "v"(lo), "v"(hi)); return r; }
template <int DK> struct KCfg;
template <> struct KCfg<64> { static constexpr float SCALE = 0.125f;
    static __device__ __forceinline__ int swz(int row, int cb) { return row * 128 + (cb ^ (((row >> 1) & 7) << 4)); } };
template <> struct KCfg<96> { static constexpr float SCALE = 0.10206207261596577f;
    static __device__ __forceinline__ int swz(int row, int cb) { return row * 192 + (cb ^ (((row >> 2) & 3) << 4)); } };

template <int DK> __device__ __forceinline__ void partialSM(f32x16& p0, f32x16& p1, float& m_reg, float& mn, float& alpha) {
  constexpr float SCALE = KCfg<DK>::SCALE, C = SCALE * 1.4426950408889634f;
  float pmax = p0[0];
#pragma unroll
  for (int r = 1; r < 16; ++r) pmax = fmaxf(pmax, p0[r]);
#pragma unroll
  for (int r = 0; r < 16; ++r) pmax = fmaxf(pmax, p1[r]);
  { auto rr = __builtin_amdgcn_permlane32_swap(__float_as_uint(pmax), __float_as_uint(pmax), false, false);
    pmax = fmaxf(__uint_as_float(rr[0]), __uint_as_float(rr[1])); }
  if (__builtin_expect(__all(pmax - m_reg <= THR / SCALE), 1)) { mn = m_reg; alpha = 1.f; }
  else { mn = fmaxf(m_reg, pmax); alpha = __builtin_amdgcn_exp2f((m_reg - mn) * C); m_reg = mn; }
  float mnC = -mn * C;
#pragma unroll
  for (int r = 0; r < 16; ++r) p0[r] = fmaf(p0[r], C, mnC);
#pragma unroll
  for (int r = 0; r < 16; ++r) p1[r] = fmaf(p1[r], C, mnC);
#pragma unroll
  for (int r = 0; r < 16; ++r) p0[r] = __builtin_amdgcn_exp2f(p0[r]);
}
__device__ __forceinline__ void finishSM(f32x16& p0, f32x16& p1, float alpha, float& l_reg, bf16x8& pa0, bf16x8& pa1, bf16x8& pa2, bf16x8& pa3) {
#pragma unroll
  for (int r = 0; r < 16; ++r) p1[r] = __builtin_amdgcn_exp2f(p1[r]);
  float ps = 0;
#pragma unroll
  for (int r = 0; r < 16; ++r) ps += p0[r];
#pragma unroll
  for (int r = 0; r < 16; ++r) ps += p1[r];
  { auto rr = __builtin_amdgcn_permlane32_swap(__float_as_uint(ps), __float_as_uint(ps), false, false);
    ps = __uint_as_float(rr[0]) + __uint_as_float(rr[1]); }
  l_reg = l_reg * alpha + ps;
#define PK4(P, BASE, OUT) do { unsigned a0 = cvtpk(P[BASE + 0], P[BASE + 1]), a1 = cvtpk(P[BASE + 2], P[BASE + 3]);   \
    unsigned b0 = cvtpk(P[BASE + 4], P[BASE + 5]), b1 = cvtpk(P[BASE + 6], P[BASE + 7]);                              \
    auto r0 = __builtin_amdgcn_permlane32_swap(a0, b0, false, false); auto r1 = __builtin_amdgcn_permlane32_swap(a1, b1, false, false); \
    u32x4 w = {r0[0], r1[0], r0[1], r1[1]}; OUT = *reinterpret_cast<bf16x8*>(&w); } while (0)
  PK4(p0, 0, pa0); PK4(p0, 8, pa1); PK4(p1, 0, pa2); PK4(p1, 8, pa3);
#undef PK4
}
template <int DK> __device__ __forceinline__ void qkt(f32x16& p0, f32x16& p1, const char* Ks, const bf16x8* qr, int r32, int hi) {
  p0 = f32x16{}; p1 = f32x16{};
#pragma unroll
  for (int d0 = 0; d0 < DK / 16; ++d0) { const int cb = (d0 * 16 + hi * 8) * 2;
    bf16x8 b0 = *reinterpret_cast<const bf16x8*>(Ks + KCfg<DK>::swz(r32, cb));
    bf16x8 b1 = *reinterpret_cast<const bf16x8*>(Ks + KCfg<DK>::swz(32 + r32, cb));
    p0 = __builtin_amdgcn_mfma_f32_32x32x16_bf16(b0, qr[d0], p0, 0, 0, 0);
    p1 = __builtin_amdgcn_mfma_f32_32x32x16_bf16(b1, qr[d0], p1, 0, 0, 0); }
}
__device__ __forceinline__ int v_st(int k, int c) { const int kk = (k & ~0xC) | ((k & 4) << 1) | ((k & 8) >> 1); return ((kk >> 3) * 2 + (c >> 5)) * 512 + ((kk & 7) * 32 + (c & 31)) * 2; }
__device__ __forceinline__ int v_rd_base(int lane) { return ((lane & 3) << 3) | (((lane >> 2) & 3) << 6) | (((lane >> 4) & 1) << 5) | (((lane >> 5) & 1) << 8); }
constexpr int v_rd_off(int d0, int ks, int half) { return d0 * 512 + ks * 2048 + half * 1024; }
template <int OFF> __device__ __forceinline__ s16x4 tr_read(int vb) {
  s16x4 r; asm volatile("ds_read_b64_tr_b16 %0, %1 offset:%2" : "=&v"(r) : "v"(vb), "i"(OFF) : "memory"); return r;
}
template <int D0> __device__ __forceinline__ void pv_one(f32x16& od, int vb, bf16x8 pa0, bf16x8 pa1, bf16x8 pa2, bf16x8 pa3) {
  const s16x4 l0 = tr_read<v_rd_off(D0, 0, 0)>(vb), h0 = tr_read<v_rd_off(D0, 0, 1)>(vb), l1 = tr_read<v_rd_off(D0, 1, 0)>(vb), h1 = tr_read<v_rd_off(D0, 1, 1)>(vb);
  const s16x4 l2 = tr_read<v_rd_off(D0, 2, 0)>(vb), h2 = tr_read<v_rd_off(D0, 2, 1)>(vb), l3 = tr_read<v_rd_off(D0, 3, 0)>(vb), h3 = tr_read<v_rd_off(D0, 3, 1)>(vb);
  asm volatile("s_waitcnt lgkmcnt(0)" ::: "memory"); SBAR();
#define PK(L, H) (bf16x8){L[0], L[1], L[2], L[3], H[0], H[1], H[2], H[3]}
  od = __builtin_amdgcn_mfma_f32_32x32x16_bf16(pa0, PK(l0, h0), od, 0, 0, 0);
  od = __builtin_amdgcn_mfma_f32_32x32x16_bf16(pa1, PK(l1, h1), od, 0, 0, 0);
  od = __builtin_amdgcn_mfma_f32_32x32x16_bf16(pa2, PK(l2, h2), od, 0, 0, 0);
  od = __builtin_amdgcn_mfma_f32_32x32x16_bf16(pa3, PK(l3, h3), od, 0, 0, 0);
#undef PK
}
__device__ __forceinline__ void pv_d0(f32x16* o, int vb, bf16x8 pa0, bf16x8 pa1, bf16x8 pa2, bf16x8 pa3) {
  pv_one<0>(o[0], vb, pa0, pa1, pa2, pa3); pv_one<1>(o[1], vb, pa0, pa1, pa2, pa3);
}
constexpr int SEQK = 2048, KVBLK = 64, NT = SEQK / KVBLK, SHM_V = 64 * 64 * 2;
constexpr int LDS_BYTES = 2 * SHM_V + 2 * (64 * 96 * 2) + 2048 + 8 * 4096;
template <int DK>
__device__ __forceinline__ void attn_unit(const bf16_t* __restrict__ Qb, int ldq, const bf16_t* __restrict__ Kh, int ldk, const bf16_t* __restrict__ Kp, int ldp, const bf16_t* __restrict__ Vh, int ldv, bf16_t* __restrict__ Ob, int ldo, char* lds, int wid) {
  constexpr int KCH = DK / 8, SHM_K = 64 * DK * 2; constexpr bool K2 = (64 * KCH > 512);
  const int lane = fresh_lane(), tid = wid * 64 + lane, r32 = lane & 31, hi = lane >> 5;
  char* V_lds = lds; char* K_lds = lds + 2 * SHM_V;
  float* ws = (float*)(lds + 2 * SHM_V + 2 * SHM_K) + wid * 64; float* li_l = ws; float* al_l = ws + 32;
  bf16_t* stg = (bf16_t*)(lds + 2 * SHM_V + 2 * SHM_K + 2048) + wid * 2048;
  float m_reg = -1e30f, l_reg = 0; f32x16 o[2] = {}; bf16x8 qr[DK / 16];
  const bf16_t* Qw = Qb + (long)(wid * 32 + r32) * ldq + hi * 8;
#pragma unroll
  for (int d0 = 0; d0 < DK / 16; ++d0) qr[d0] = *reinterpret_cast<const bf16x8*>(Qw + d0 * 16);
  const int kr0 = tid / KCH, kc0 = (tid % KCH) * 8, kr1 = (tid + 512) / KCH, kc1 = ((tid + 512) % KCH) * 8; const bool has2 = K2 && (tid < 64 * KCH - 512);
  const bf16_t* kp0 = (kc0 < 64) ? Kh + (long)kr0 * ldk + kc0 : Kp + (long)kr0 * ldp + (kc0 - 64); const long ks0 = (kc0 < 64) ? ldk : ldp;
  const bf16_t* kp1 = (kc1 < 64) ? Kh + (long)kr1 * ldk + kc1 : Kp + (long)kr1 * ldp + (kc1 - 64); const long ks1 = (kc1 < 64) ? ldk : ldp;
  const int vr = tid >> 3, vc = (tid & 7) * 8, vst0 = v_st(vr, vc);
  const int vb0 = (int)(uintptr_t)V_lds + v_rd_base(lane);
  bf16x8 sk0, sk1, sv0;
#define SLOAD(k0) do { sk0 = *reinterpret_cast<const bf16x8*>(kp0 + (long)(k0) * ks0); if (has2) sk1 = *reinterpret_cast<const bf16x8*>(kp1 + (long)(k0) * ks1); \
    sv0 = *reinterpret_cast<const bf16x8*>(&Vh[(long)((k0) + vr) * ldv + vc]); } while (0)
#define SWRITE(b) do { *(bf16x8*)(K_lds + (b) * SHM_K + KCfg<DK>::swz(kr0, kc0 * 2)) = sk0; if (has2) *(bf16x8*)(K_lds + (b) * SHM_K + KCfg<DK>::swz(kr1, kc1 * 2)) = sk1; \
    *(bf16x8*)(V_lds + (b) * SHM_V + vst0) = sv0; } while (0)
#define SWAIT() asm volatile("s_waitcnt vmcnt(0)" ::: "memory")
#define RESC(a) do { if (__any((a) < 1.f)) { if (hi == 0) al_l[r32] = (a); asm volatile("s_waitcnt lgkmcnt(0)" ::: "memory"); \
    _Pragma("unroll") for (int d = 0; d < 2; ++d) _Pragma("unroll") for (int r = 0; r < 16; ++r) o[d][r] *= al_l[crow(r, hi)]; } } while (0)
  f32x16 pA0, pA1, pB0, pB1; float mnA, mnB, alA, alB; bf16x8 pa0, pa1, pa2, pa3;
  SLOAD(0); SWAIT(); SWRITE(0); __syncthreads();
  qkt<DK>(pA0, pA1, K_lds, qr, r32, hi); partialSM<DK>(pA0, pA1, m_reg, mnA, alA);
  SLOAD(KVBLK);
  SWAIT(); SWRITE(1); __syncthreads();
  for (int j = 1; j + 1 < NT; j += 2) {
    SBAR(); qkt<DK>(pB0, pB1, K_lds + SHM_K, qr, r32, hi);
    finishSM(pA0, pA1, alA, l_reg, pa0, pa1, pa2, pa3); SBAR();
    SLOAD((j + 1) * KVBLK); SBAR();
    pv_d0(o, vb0, pa0, pa1, pa2, pa3); partialSM<DK>(pB0, pB1, m_reg, mnB, alB);
    __syncthreads(); SWAIT(); SWRITE(0);
    RESC(alB); __syncthreads();
    SBAR(); qkt<DK>(pA0, pA1, K_lds, qr, r32, hi);
    finishSM(pB0, pB1, alB, l_reg, pa0, pa1, pa2, pa3); SBAR();
    SLOAD((j + 2) * KVBLK); SBAR();
    pv_d0(o, vb0 + SHM_V, pa0, pa1, pa2, pa3); partialSM<DK>(pA0, pA1, m_reg, mnA, alA);
    __syncthreads(); SWAIT(); SWRITE(1);
    RESC(alA); __syncthreads();
  }
  SBAR(); qkt<DK>(pB0, pB1, K_lds + SHM_K, qr, r32, hi);
  finishSM(pA0, pA1, alA, l_reg, pa0, pa1, pa2, pa3); SBAR();
  pv_d0(o, vb0, pa0, pa1, pa2, pa3); partialSM<DK>(pB0, pB1, m_reg, mnB, alB);
  __syncthreads(); RESC(alB);
  finishSM(pB0, pB1, alB, l_reg, pa0, pa1, pa2, pa3); SBAR();
  pv_d0(o, vb0 + SHM_V, pa0, pa1, pa2, pa3);
  if (hi == 0) li_l[r32] = l_reg; asm volatile("s_waitcnt lgkmcnt(0)" ::: "memory");
  float rli[16];
#pragma unroll
  for (int r = 0; r < 16; ++r) rli[r] = __builtin_amdgcn_rcpf(li_l[crow(r, hi)]);
#pragma unroll
  for (int r = 0; r < 16; ++r) { const int orow = crow(r, hi);
#pragma unroll
    for (int d0 = 0; d0 < 2; ++d0) { const unsigned w = cvtpk(o[d0][r] * rli[r], 0.f); stg[orow * 64 + d0 * 32 + r32] = (bf16_t)(w & 0xffffu); } }
  asm volatile("s_waitcnt lgkmcnt(0)" ::: "memory");
  bf16_t* Ow = Ob + (long)(wid * 32) * ldo;
#pragma unroll
  for (int i = 0; i < 4; ++i) { const int row = i * 8 + (lane >> 3), ch = lane & 7; const u32x4 v = *(const u32x4*)(stg + row * 64 + ch * 8); *(u32x4*)(Ow + (long)row * ldo + ch * 8) = v; }
  __syncthreads();
#undef SLOAD
#undef SWRITE
#undef SWAIT
#undef RESC
}
#undef SBAR
}

constexpr int NWAVES = 8;
constexpr int NB = 16, SEQ = 2048, DM = 1024, T = NB * SEQ;
constexpr int INW = 1312, INWP = 1536;
constexpr int NE = 16, CAP = 256, FF = 2816, PLE = 256;
constexpr int UQW = 768, UKVW = 1024;
constexpr float ALPHA = 1.189207115002721f;
constexpr float LN_EPS = 1e-5f, RMS_EPS = 1e-6f;

constexpr size_t MiB = 1u << 20;
constexpr size_t WS_CTL = 0;
constexpr size_t WS_WIN = 1 * MiB;
constexpr size_t WS_WUQ = 4 * MiB;
constexpr size_t WS_WUKV = 4 * MiB + 512 * 1024;
constexpr size_t WS_WOUT = 5 * MiB;
constexpr size_t WS_WPG = 7 * MiB;
constexpr size_t WS_WPP = 9 * MiB;
constexpr size_t WS_WRT = 9 * MiB + 512 * 1024;
constexpr size_t WS_AFF = 10 * MiB;
constexpr size_t WS_ROWMAP = 12 * MiB;
constexpr size_t WS_GVAL = 12 * MiB + 256 * 1024;
constexpr size_t WS_SEL = 12 * MiB + 512 * 1024;
constexpr size_t WS_SSQ = 14 * MiB + 512 * 1024, WS_SSKV = 15 * MiB;
constexpr size_t WS_WGU = 16 * MiB;
constexpr size_t WS_YEXP = 16 * MiB, WS_PB = 144 * MiB;
constexpr size_t WS_WDN = 192 * MiB;
constexpr size_t WS_X1B = 280 * MiB;
constexpr size_t WS_QMLA = 280 * MiB;
constexpr size_t WS_R1 = 344 * MiB;
constexpr size_t WS_XB = WS_R1;
constexpr size_t WS_PROJ = WS_R1 + 64 * MiB;
constexpr size_t WS_QG = WS_R1 + 256 * MiB, WS_KG = WS_QG + 32 * MiB, WS_VG = WS_KG + 8 * MiB, WS_CQ = WS_VG + 8 * MiB, WS_CKV = WS_CQ + 16 * MiB, WS_KPE = WS_CKV + 16 * MiB;
constexpr size_t WS_QM = WS_R1;
constexpr size_t WS_KV = WS_R1 + 96 * MiB;
constexpr size_t WS_VMLA = WS_R1 + 224 * MiB;
constexpr size_t WS_KN = WS_R1 + 96 * MiB;
constexpr size_t WS_O = WS_R1;
constexpr size_t WS_H = WS_R1;
constexpr size_t WS_E = WS_R1, WS_G = WS_R1 + 128 * MiB;
constexpr size_t WS_END = 704 * MiB;
static_assert(WS_KPE + 2 * MiB <= WS_END && WS_H + (size_t)65536 * FF * 2 <= WS_END && WS_VMLA + 32 * MiB <= WS_QG, "d_ws map");

constexpr int LDS_BYTES = 147456;
static_assert(att::LDS_BYTES <= 131072, "attention LDS");

#define LAS __attribute__((address_space(3)))
typedef unsigned short bf16;
typedef unsigned v4u __attribute__((ext_vector_type(4)));
typedef unsigned v2u __attribute__((ext_vector_type(2)));
typedef float f32x4 __attribute__((ext_vector_type(4)));
__device__ __forceinline__ unsigned f2bf(float f) { unsigned u = __builtin_bit_cast(unsigned, f); return (u + 0x7fffu + ((u >> 16) & 1u)) >> 16; }
__device__ __forceinline__ unsigned pk2(float lo, float hi) { return f2bf(lo) | (f2bf(hi) << 16); }
__device__ __forceinline__ float bf2f(unsigned h) { return __builtin_bit_cast(float, h << 16); }
__device__ __forceinline__ float wave_sum(float v) {
#pragma unroll
    for (int o = 1; o < 64; o <<= 1) v += __shfl_xor(v, o);
    return v;
}
__device__ __forceinline__ float wave_max(float v) {
#pragma unroll
    for (int o = 1; o < 64; o <<= 1) v = fmaxf(v, __shfl_xor(v, o));
    return v;
}


#define GAS __attribute__((address_space(1)))
typedef GAS unsigned gu32;
#define RLX_AGENT __ATOMIC_RELAXED, __HIP_MEMORY_SCOPE_AGENT
#define XB_TMO      128
#define XB_XCNT(j)  (256  + 64 * (j))
#define XB_XSUB(j)  (1280 + 64 * (j))
#define XB_XGEN(j)  (2304 + 64 * (j))
#define XB_TOP      3328
#define XB_TOPGEN   3392
#define XCD_BAR_WORDS 3456
#define XB_SPIN_CAP (1u << 18)

__device__ __forceinline__ unsigned xb_ld(unsigned* p)              { return __hip_atomic_load(p, __ATOMIC_RELAXED, __HIP_MEMORY_SCOPE_AGENT); }
__device__ __forceinline__ unsigned xb_add(unsigned* p, unsigned v) { return __hip_atomic_fetch_add(p, v, __ATOMIC_RELAXED, __HIP_MEMORY_SCOPE_AGENT); }
__device__ __forceinline__ unsigned xb_xcc_id() { return (unsigned)__builtin_amdgcn_s_getreg((3 << 11) | 20) & 0xFu; }
#define XB_SPIN(cond, bar) do { unsigned _sp = 0; while (cond) { __builtin_amdgcn_s_sleep(1); \
    if ((++_sp & 255u) == 0u) { if (xb_ld(&(bar)[XB_TMO])) break; if (_sp > XB_SPIN_CAP) { atomicAdd(&(bar)[XB_TMO], 1u); break; } } } } while (0)

struct XcdBarrier {
    unsigned* bar; unsigned x; int w;
    volatile LAS unsigned* st;
};

__device__ __forceinline__ XcdBarrier xcd_barrier_post(unsigned* bar, volatile LAS unsigned* st, int w) {
    XcdBarrier b; b.bar = bar; b.x = xb_xcc_id(); b.st = st; b.w = w;
    if (w == 0 && fresh_lane() == 0) (void)xb_add(&bar[XB_XCNT(b.x)], 1u);
    return b;
}
__device__ __forceinline__ void xcd_barrier_complete(unsigned* bar, unsigned x, unsigned& nloc, unsigned& nx) {
    const unsigned G = gridDim.x * gridDim.y * gridDim.z;
    unsigned sum, cnt, mine, sp = 0u;
    for (;;) {
        sum = 0u; cnt = 0u; mine = 0u;
#pragma unroll
        for (unsigned j = 0; j < 16; ++j) { const unsigned c = xb_ld(&bar[XB_XCNT(j)]); sum += c; cnt += (c > 0u) ? 1u : 0u; mine = (j == x) ? c : mine; }
        if (sum == G) break;
        __builtin_amdgcn_s_sleep(1);
        if ((++sp & 255u) == 0u) { if (xb_ld(&bar[XB_TMO])) break; if (sp > XB_SPIN_CAP) { atomicAdd(&bar[XB_TMO], 1u); break; } }
    }
    nloc = mine > 0u ? mine : 1u; nx = cnt > 0u ? cnt : 1u;
}

__device__ __forceinline__ void xcd_barrier(const XcdBarrier& b) {
    asm volatile("s_waitcnt vmcnt(0)" ::: "memory");
    __syncthreads();
    if (b.w == 0 && fresh_lane() == 0) {
        unsigned* bar = b.bar;
        __builtin_amdgcn_s_waitcnt(0);
        unsigned nloc = b.st[0], nx = b.st[1];
        if (nloc == 0u) { xcd_barrier_complete(bar, b.x, nloc, nx); b.st[0] = nloc; b.st[1] = nx; }
        const unsigned old = xb_add(&bar[XB_XSUB(b.x)], 1u);
        const unsigned gen = old / nloc;
        if (old + 1u == (gen + 1u) * nloc) {
            __builtin_amdgcn_fence(__ATOMIC_RELEASE, "agent");
            asm volatile("s_waitcnt vmcnt(0)" ::: "memory");
            const unsigned og = xb_add(&bar[XB_TOP], 1u);
            const unsigned tg = og / nx;
            if (og + 1u == (tg + 1u) * nx) xb_add(&bar[XB_TOPGEN], 1u);
            else XB_SPIN(xb_ld(&bar[XB_TOPGEN]) == tg, bar);
            __builtin_amdgcn_fence(__ATOMIC_ACQUIRE, "agent");
            xb_add(&bar[XB_XGEN(b.x)], 1u);
            asm volatile("s_waitcnt vmcnt(0)" ::: "memory");
        } else {
            XB_SPIN(xb_ld(&bar[XB_XGEN(b.x)]) == gen, bar);
            __builtin_amdgcn_fence(__ATOMIC_ACQUIRE, "agent");
            asm volatile("s_waitcnt vmcnt(0)" ::: "memory");
        }
    }
    __syncthreads();
}
struct Args { const float* in[22]; float* out; unsigned char* ws; int ph_lo, ph_hi; };
enum { I_X = 0, I_P, I_WIN, I_QN, I_KN, I_CQN, I_CKVN, I_WUQ, I_WUKV, I_WOUT, I_LNAG, I_LNAB, I_WR, I_WG, I_WU, I_WD, I_LNFG, I_LNFB, I_WPP, I_WPG, I_LNPG, I_LNPB };

struct Frame { LAS unsigned char* lds; int tid, lane, wave, vcu, G; };

__device__ __forceinline__ void tr_item(const float* W, int N, int k0, int n0, bf16* WT, int K, long dst_row0, LAS float* scr, int lane, const float* kscale = nullptr, int nmode = 0) {
#pragma unroll 8
    for (int i = 0; i < 32; ++i) { const int kk = 2 * i + (lane >> 5); float v = W[(size_t)(k0 + kk) * N + n0 + (lane & 31)]; if (kscale) v *= kscale[k0 + kk]; scr[kk * 33 + (lane & 31)] = v; }
    asm volatile("s_waitcnt lgkmcnt(0)" ::: "memory");
    const int c = lane & 7;
#pragma unroll
    for (int j = 0; j < 4; ++j) { const int n = (lane >> 3) + 8 * j; const LAS float* s = scr + (8 * c) * 33 + n;
        v4u o; o.x = pk2(s[0 * 33], s[1 * 33]); o.y = pk2(s[2 * 33], s[3 * 33]); o.z = pk2(s[4 * 33], s[5 * 33]); o.w = pk2(s[6 * 33], s[7 * 33]);
        const int nd = nmode ? (16 * ((n >> 3) & 1) + 8 * (n >> 4) + (n & 7)) : n;
        *(v4u*)(WT + (size_t)(dst_row0 + nd) * K + k0 + 8 * c) = o; }
    asm volatile("s_waitcnt lgkmcnt(0)" ::: "memory");
}
__device__ __forceinline__ void tr_dense(const float* W, int K, int N, bf16* WT, int r, LAS float* scr, int lane, const float* kscale = nullptr) {
    const int nblk = N / 32, kb = r / nblk, nb = r % nblk; tr_item(W, N, 64 * kb, 32 * nb, WT, K, 32 * nb, scr, lane, kscale);
}
__device__ __forceinline__ void p0_convert(const Frame& F, const Args& a) {
    LAS float* scr = (LAS float*)(F.lds + F.wave * 16384);
    const int gw = F.vcu * NWAVES + F.wave, NGW = F.G * NWAVES;
    unsigned char* ws = a.ws;
    constexpr int I_IN = (DM / 64) * (INW / 32), I_UQ = (256 / 64) * (UQW / 32), I_UKV = (256 / 64) * (UKVW / 32), I_OUT = (DM / 64) * (DM / 32), I_PG = I_OUT, I_PP = (PLE / 64) * (DM / 32);
    constexpr int I_GE = (DM / 64) * (FF / 32), I_DE = (FF / 64) * (DM / 32);
    constexpr int NITEMS = I_IN + I_UQ + I_UKV + I_OUT + I_PG + I_PP + 2 * NE * I_GE + NE * I_DE;
    for (int it = gw; it < NITEMS; it += NGW) {
        int r = it;
        if (r < I_IN) {
            const int nblk = INW / 32, kb = r / nblk, nb = r % nblk, n0 = 32 * nb, pn = n0 >> 8, cw = n0 & 255;
            const int d0 = (pn <= 2) ? 256 * pn + ((cw >> 5) & 1) * 128 + (cw >> 6) * 32 : n0;
            tr_item(a.in[I_WIN], INW, 64 * kb, n0, (bf16*)(ws + WS_WIN), DM, d0, scr, F.lane, nullptr, pn == 5 ? 1 : 0); continue; } r -= I_IN;
        if (r < I_UQ) {
            const int nblk = UQW / 32, kb = r / nblk, nb = r % nblk, n0 = 32 * nb, head = n0 / 96, off = n0 % 96;
            const int d0 = (off < 64) ? (head >> 2) * 256 + (head & 3) * 64 + off : 512 + head * 32;
            tr_item(a.in[I_WUQ], UQW, 64 * kb, n0, (bf16*)(ws + WS_WUQ), 256, d0, scr, F.lane, a.in[I_CQN], off < 64 ? 0 : 1); continue; } r -= I_UQ;
        if (r < I_UKV) { tr_dense(a.in[I_WUKV], 256, UKVW, (bf16*)(ws + WS_WUKV), r, scr, F.lane, a.in[I_CKVN]); continue; } r -= I_UKV;
        if (r < I_OUT) { tr_dense(a.in[I_WOUT], DM, DM, (bf16*)(ws + WS_WOUT), r, scr, F.lane); continue; } r -= I_OUT;
        if (r < I_PG) { tr_dense(a.in[I_WPG], DM, DM, (bf16*)(ws + WS_WPG), r, scr, F.lane); continue; } r -= I_PG;
        if (r < I_PP) { tr_dense(a.in[I_WPP], PLE, DM, (bf16*)(ws + WS_WPP), r, scr, F.lane); continue; } r -= I_PP;
        if (r < 2 * NE * I_GE) {
            const int which = r / (NE * I_GE); r -= which * NE * I_GE; const int e = r / I_GE; r -= e * I_GE;
            const int nblk = FF / 32, kb = r / nblk, nb = r % nblk, n0 = 32 * nb;
            const float* W = a.in[which ? I_WU : I_WG] + (size_t)e * DM * FF;
            tr_item(W, FF, 64 * kb, n0, (bf16*)(ws + WS_WGU), DM, (long)e * (2 * FF) + (n0 / 128) * 256 + (n0 % 128) + (which ? 128 : 0), scr, F.lane); continue; }
        r -= 2 * NE * I_GE;
        { const int e = r / I_DE; r -= e * I_DE; const int nblk = DM / 32, kb = r / nblk, nb = r % nblk;
          tr_item(a.in[I_WD] + (size_t)e * FF * DM, DM, 64 * kb, 32 * nb, (bf16*)(ws + WS_WDN), FF, (long)e * DM + 32 * nb, scr, F.lane); }
    }
    { v4u* z = (v4u*)(ws + WS_WIN + (size_t)INW * DM * 2); const int n16 = (INWP - INW) * DM * 2 / 16;
      for (int i = (F.vcu * NWAVES + F.wave) * 64 + F.lane; i < n16; i += NGW * 64) z[i] = (v4u){0u, 0u, 0u, 0u}; }
    { float* wrt = (float*)(ws + WS_WRT); const float* wr = a.in[I_WR];
      for (int i = (F.vcu * NWAVES + F.wave) * 64 + F.lane; i < NE * DM; i += NGW * 64) { const int e = i / DM, k = i % DM; wrt[i] = wr[k * NE + e]; } }
    { const float* x = a.in[I_X]; bf16* xb = (bf16*)(ws + WS_XB);
      for (int m = gw; m < T; m += NGW) { const f32x4* xr = (const f32x4*)(x + (size_t)m * DM) + F.lane; v2u* o = (v2u*)(xb + (size_t)m * DM) + F.lane;
#pragma unroll
          for (int j = 0; j < 4; ++j) { const f32x4 v = xr[64 * j]; o[64 * j] = (v2u){pk2(v.x, v.y), pk2(v.z, v.w)}; } } }
}

__device__ __forceinline__ void p_attention(const Frame& F, const Args& a) {
    unsigned char* ws = a.ws; char* lds = (char*)F.lds;
    const bf16* QG = (const bf16*)(ws + WS_QG); const bf16* KG = (const bf16*)(ws + WS_KG); const bf16* VG = (const bf16*)(ws + WS_VG);
    const bf16* QMLA = (const bf16*)(ws + WS_QMLA); const bf16* KN = (const bf16*)(ws + WS_KN); const bf16* KPE = (const bf16*)(ws + WS_KPE); const bf16* VMLA = (const bf16*)(ws + WS_VMLA);
    bf16* O = (bf16*)(ws + WS_O);
    for (int U = F.vcu; U < 2048; U += F.G) {
        if (U < 1024) { const int qb = U & 7, hq = (U >> 3) & 7, kvh = hq >> 2, b = U >> 6; const size_t r0 = (size_t)b * SEQ + qb * 256;
            att::attn_unit<64>(QG + r0 * 512 + hq * 64, 512, KG + (size_t)b * SEQ * 128 + kvh * 64, 128, KG, 128, VG + (size_t)b * SEQ * 128 + kvh * 64, 128, O + r0 * 1024 + hq * 64, 1024, lds, F.wave); }
        else { const int V = U - 1024, qb = V & 7, h = (V >> 3) & 7, b = V >> 6; const size_t r0 = (size_t)b * SEQ + qb * 256;
            att::attn_unit<96>(QMLA + r0 * 768 + h * 96, 768, KN + (size_t)b * SEQ * 512 + h * 64, 512, KPE + (size_t)b * SEQ * 32, 32, VMLA + (size_t)b * SEQ * 512 + h * 64, 512, O + r0 * 1024 + 512 + h * 64, 1024, lds, F.wave); }
    }
}
__device__ __forceinline__ void ln_row(f32x4 (&v)[4], const float* g, const float* bta, int lane) {
    float s = 0.f;
#pragma unroll
    for (int j = 0; j < 4; ++j) s += (v[j].x + v[j].y) + (v[j].z + v[j].w);
    const float mean = wave_sum(s) * (1.f / DM); float s2 = 0.f;
#pragma unroll
    for (int j = 0; j < 4; ++j) { v[j] = v[j] - mean; s2 += (v[j].x * v[j].x + v[j].y * v[j].y) + (v[j].z * v[j].z + v[j].w * v[j].w); }
    const float rstd = 1.f / sqrtf(wave_sum(s2) * (1.f / DM) + LN_EPS);
#pragma unroll
    for (int j = 0; j < 4; ++j) { const f32x4 gg = *((const f32x4*)g + lane + 64 * j), bb = *((const f32x4*)bta + lane + 64 * j); v[j] = v[j] * rstd * gg + bb; }
}
__device__ __forceinline__ void p7_ln1_router(const Frame& F, const Args& a) {
    const int gw = F.vcu * NWAVES + F.wave, NGW = F.G * NWAVES, l = F.lane;
    unsigned char* ws = a.ws; float* xo = a.out; bf16* x1b = (bf16*)(ws + WS_X1B); float* aff = (float*)(ws + WS_AFF);
    const f32x4* wrt = (const f32x4*)(ws + WS_WRT);
    for (int m = gw; m < T; m += NGW) {
        f32x4 v[4];
#pragma unroll
        for (int j = 0; j < 4; ++j) v[j] = *((const f32x4*)(xo + (size_t)m * DM) + l + 64 * j);
        ln_row(v, a.in[I_LNAG], a.in[I_LNAB], l);
#pragma unroll
        for (int j = 0; j < 4; ++j) { *((f32x4*)(xo + (size_t)m * DM) + l + 64 * j) = v[j]; *((v2u*)(x1b + (size_t)m * DM) + l + 64 * j) = (v2u){pk2(v[j].x, v[j].y), pk2(v[j].z, v[j].w)}; }
        float lg[NE]; float mx = -1e30f;
#pragma unroll
        for (int e = 0; e < NE; ++e) { float s = 0.f;
#pragma unroll
            for (int j = 0; j < 4; ++j) { const f32x4 w = wrt[e * (DM / 4) + l + 64 * j]; s += (v[j].x * w.x + v[j].y * w.y) + (v[j].z * w.z + v[j].w * w.w); }
            lg[e] = wave_sum(s); mx = fmaxf(mx, lg[e]); }
        float den = 0.f;
#pragma unroll
        for (int e = 0; e < NE; ++e) { lg[e] = expf(lg[e] - mx); den += lg[e]; }
        const float inv = 1.0f / den; float mine = 0.f;
#pragma unroll
        for (int e = 0; e < NE; ++e) mine = (l == e) ? lg[e] * inv : mine;
        const int b = m >> 11, s_ = m & (SEQ - 1);
        if (l < NE) aff[((size_t)b * NE + l) * SEQ + s_] = mine;
    }
}
__device__ __forceinline__ unsigned block_excl_scan(const Frame& F, unsigned cnt, LAS unsigned* wsum, unsigned& total) {
    unsigned inc = cnt;
#pragma unroll
    for (int o = 1; o < 64; o <<= 1) { const unsigned t = __shfl_up(inc, o); if (F.lane >= o) inc += t; }
    __syncthreads();
    if (F.lane == 63) wsum[F.wave] = inc;
    __syncthreads();
    unsigned base = 0, tot = 0;
#pragma unroll
    for (int w = 0; w < NWAVES; ++w) { const unsigned s = wsum[w]; if (w < F.wave) base += s; tot += s; }
    total = tot; return base + inc - cnt;
}
__device__ __forceinline__ void p8_topk(const Frame& F, const Args& a) {
    unsigned char* ws = a.ws; const float* aff = (const float*)(ws + WS_AFF);
    int* rowmap = (int*)(ws + WS_ROWMAP); float* gval = (float*)(ws + WS_GVAL); int* sel = (int*)(ws + WS_SEL);
    LAS unsigned* hist = (LAS unsigned*)F.lds; LAS unsigned* wsum = hist + 256; LAS unsigned* bc = hist + 272;
    for (int task = F.vcu; task < NB * NE; task += F.G) {
        const int b = task / NE, e = task % NE;
        const f32x4 vv = *((const f32x4*)(aff + (size_t)task * SEQ) + F.tid);
        const float vf[4] = {vv.x, vv.y, vv.z, vv.w}; unsigned u[4];
#pragma unroll
        for (int i = 0; i < 4; ++i) u[i] = __builtin_bit_cast(unsigned, vf[i]);
        unsigned prefix = 0, kneed = CAP;
#pragma unroll 1
        for (int pass = 0; pass < 4; ++pass) {
            const int shift = 24 - 8 * pass;
            __syncthreads();
            if (F.tid < 256) hist[F.tid] = 0u;
            __syncthreads();
#pragma unroll
            for (int i = 0; i < 4; ++i) { const bool in = (pass == 0) || ((u[i] >> (shift + 8)) == prefix); if (in) atomicAdd((unsigned*)&hist[(u[i] >> shift) & 255u], 1u); }
            __syncthreads();
            if (F.wave == 0) {
                unsigned h0 = hist[4 * F.lane], h1 = hist[4 * F.lane + 1], h2 = hist[4 * F.lane + 2], h3 = hist[4 * F.lane + 3];
                const unsigned tl = h0 + h1 + h2 + h3; unsigned suf = tl;
#pragma unroll
                for (int o = 1; o < 64; o <<= 1) { const unsigned t = __shfl_down(suf, o); if (F.lane + o < 64) suf += t; }
                const unsigned above = suf - tl;
                const unsigned a3 = above, a2 = above + h3, a1 = a2 + h2, a0 = a1 + h1;
                int found = -1; unsigned nk = 0;
                if (a3 < kneed && kneed <= a3 + h3) { found = 4 * F.lane + 3; nk = kneed - a3; }
                else if (a2 < kneed && kneed <= a2 + h2) { found = 4 * F.lane + 2; nk = kneed - a2; }
                else if (a1 < kneed && kneed <= a1 + h1) { found = 4 * F.lane + 1; nk = kneed - a1; }
                else if (a0 < kneed && kneed <= a0 + h0) { found = 4 * F.lane; nk = kneed - a0; }
                if (found >= 0) { bc[0] = (unsigned)found; bc[1] = nk; }
            }
            __syncthreads();
            prefix = (prefix << 8) | bc[0]; kneed = bc[1];
        }
        unsigned ceq = 0;
#pragma unroll
        for (int i = 0; i < 4; ++i) ceq += (u[i] == prefix) ? 1u : 0u;
        unsigned tot; unsigned eqbase = block_excl_scan(F, ceq, wsum, tot);
        bool take[4]; unsigned csel = 0;
#pragma unroll
        for (int i = 0; i < 4; ++i) { const bool eq = (u[i] == prefix); take[i] = (u[i] > prefix) || (eq && eqbase < kneed); if (eq) ++eqbase; csel += take[i] ? 1u : 0u; }
        unsigned slot = block_excl_scan(F, csel, wsum, tot);
#pragma unroll
        for (int i = 0; i < 4; ++i) { const int tkn = F.tid * 4 + i; int sv = -1;
            if (take[i]) { sv = (int)slot; const size_t r = (size_t)e * (NB * CAP) + b * CAP + slot; rowmap[r] = b * SEQ + tkn; gval[r] = vf[i]; ++slot; }
            sel[((size_t)b * SEQ + tkn) * NE + e] = sv; }
    }
}
__device__ __forceinline__ void p11_ln2(const Frame& F, const Args& a) {
    const int gw = F.vcu * NWAVES + F.wave, NGW = F.G * NWAVES, l = F.lane;
    unsigned char* ws = a.ws; float* xo = a.out; bf16* x2b = (bf16*)(ws + WS_X1B); const bf16* yexp = (const bf16*)(ws + WS_YEXP); const int* sel = (const int*)(ws + WS_SEL);
    const float* p = a.in[I_P]; bf16* pb = (bf16*)(ws + WS_PB);
    for (int m = gw; m < T; m += NGW) {
        const int b = m >> 11;
        f32x4 v[4];
#pragma unroll
        for (int j = 0; j < 4; ++j) v[j] = *((const f32x4*)(xo + (size_t)m * DM) + l + 64 * j) * ALPHA;
        const int sv = (l < NE) ? sel[(size_t)m * NE + l] : -1;
#pragma unroll 1
        for (int e = 0; e < NE; ++e) { const int c = __shfl(sv, e); if (c >= 0) { const bf16* yr = yexp + ((size_t)e * (NB * CAP) + b * CAP + c) * DM;
#pragma unroll
            for (int j = 0; j < 4; ++j) { const v2u w = *((const v2u*)yr + l + 64 * j); v[j].x += bf2f(w.x & 0xffffu); v[j].y += bf2f(w.x >> 16); v[j].z += bf2f(w.y & 0xffffu); v[j].w += bf2f(w.y >> 16); } } }
        ln_row(v, a.in[I_LNFG], a.in[I_LNFB], l);
#pragma unroll
        for (int j = 0; j < 4; ++j) { *((f32x4*)(xo + (size_t)m * DM) + l + 64 * j) = v[j]; *((v2u*)(x2b + (size_t)m * DM) + l + 64 * j) = (v2u){pk2(v[j].x, v[j].y), pk2(v[j].z, v[j].w)}; }
        { const f32x4 pv = *((const f32x4*)(p + (size_t)m * PLE) + l); *((v2u*)(pb + (size_t)m * PLE) + l) = (v2u){pk2(pv.x, pv.y), pk2(pv.z, pv.w)}; }
    }
}
__device__ __forceinline__ void p13_ln3(const Frame& F, const Args& a) {
    const int gw = F.vcu * NWAVES + F.wave, NGW = F.G * NWAVES, l = F.lane;
    float* xo = a.out;
    for (int m = gw; m < T; m += NGW) {
        f32x4 v[4];
#pragma unroll
        for (int j = 0; j < 4; ++j) v[j] = *((const f32x4*)(xo + (size_t)m * DM) + l + 64 * j);
        ln_row(v, a.in[I_LNPG], a.in[I_LNPB], l);
#pragma unroll
        for (int j = 0; j < 4; ++j) *((f32x4*)(xo + (size_t)m * DM) + l + 64 * j) = v[j];
    }
}

__global__ void __launch_bounds__(NWAVES * 64, 2) fwd(Args args) {
    extern __shared__ __attribute__((aligned(16))) unsigned char lds[];
    Frame F;
    F.lds = (LAS unsigned char*)lds; F.wave = __builtin_amdgcn_readfirstlane(threadIdx.x >> 6); F.lane = fresh_lane(); F.tid = F.wave * 64 + F.lane;
    F.G = gridDim.x; { const int bx = blockIdx.x; F.vcu = (F.G % 8 == 0) ? (bx % 8) * (F.G / 8) + bx / 8 : bx; }
    unsigned char* ws = args.ws;
    const int lo = args.ph_lo, hi = args.ph_hi;
#define IN(k) (lo <= (k) && (k) < hi)
    volatile LAS unsigned* MISC = (volatile LAS unsigned*)(F.lds + 131072 + 320);
    for (int u = F.tid; u < 256; u += NWAVES * 64) ((LAS unsigned*)(F.lds + 131072))[u] = 0u;
    for (int u = F.tid; u < 1024 + 512; u += NWAVES * 64) {
        const bool big = u < 1024; const int v = big ? u : u - 1024, pos = big ? (v >> 4) : (v >> 3), i = big ? (v & 15) : (v & 7);
        float rev = (float)pos * exp2f(-(float)i * (big ? pg8::kLog2Base / 16.0f : pg8::kLog2Base / 8.0f)) * pg8::kInv2Pi; rev = rev - floorf(rev);
        *(LAS float*)(F.lds + (big ? pg8::TAB_COS64 : pg8::TAB_COS32) + v * 4) = __builtin_amdgcn_cosf(rev);
        *(LAS float*)(F.lds + (big ? pg8::TAB_SIN64 : pg8::TAB_SIN32) + v * 4) = __builtin_amdgcn_sinf(rev); }
    __syncthreads();
    XcdBarrier bar; bar.bar = (unsigned*)(ws + WS_CTL) + 4096; bar.x = 0; bar.st = nullptr; bar.w = F.wave;
    if (hi - lo > 1) bar = xcd_barrier_post((unsigned*)(ws + WS_CTL) + 4096, MISC + 8, F.wave);
#ifndef PROBE_MASK
#define PROBE_MASK 0
#endif
#if PROBE_MASK
#define PHASE(k) for (int rep_ = 0; rep_ < (IN(k) ? ((((PROBE_MASK) >> (k)) & 1) ? 2 : 1) : 0); ++rep_, (((PROBE_MASK >> (k)) & 1) ? xcd_barrier(bar) : (void)0))
#else
#define PHASE(k) if (IN(k) && (F.lane = fresh_lane(), F.tid = F.wave * 64 + F.lane, true))
#endif
#define SEAM(k) do { if (IN(k) && IN((k) + 1)) xcd_barrier(bar); } while (0)
    PHASE(0) p0_convert(F, args);
    SEAM(0);
    PHASE(1) { pg8::Gemm g{(const bf16*)(ws + WS_XB), (const bf16*)(ws + WS_WIN), T, INWP, DM}; pg8::StaticOrder S; S.init(T, INWP, F.G, (int)blockIdx.x);
        pg8::EpiProj E{(bf16*)(ws + WS_QG), (bf16*)(ws + WS_KG), (bf16*)(ws + WS_VG), (bf16*)(ws + WS_CQ), (bf16*)(ws + WS_CKV), (bf16*)(ws + WS_KPE), (float*)(ws + WS_SSQ), (float*)(ws + WS_SSKV), args.in[I_QN], args.in[I_KN], F.lds};
        pg8::gemm_phase<pg8::EpiProj, pg8::StaticOrder, true>(F.lds, g, S, E, F.wave); }
    SEAM(1);
    PHASE(2) {
        { pg8::Gemm g{(const bf16*)(ws + WS_CQ), (const bf16*)(ws + WS_WUQ), T, UQW, 256}; pg8::StaticOrder S; S.init(T, UQW, F.G, (int)blockIdx.x);
          pg8::EpiMlaQ E{(bf16*)(ws + WS_QMLA), (const float*)(ws + WS_SSQ), F.lds}; pg8::gemm_phase<pg8::EpiMlaQ, pg8::StaticOrder, true>(F.lds, g, S, E, F.wave); }
        { pg8::Gemm g{(const bf16*)(ws + WS_CKV), (const bf16*)(ws + WS_WUKV), T, UKVW, 256}; pg8::StaticOrder S; S.init(T, UKVW, F.G, (int)blockIdx.x);
          pg8::EpiMlaKV E{(bf16*)(ws + WS_KN), (bf16*)(ws + WS_VMLA), (const float*)(ws + WS_SSKV)}; pg8::gemm_phase<pg8::EpiMlaKV, pg8::StaticOrder, true>(F.lds, g, S, E, F.wave); }
    }
    SEAM(2);
    PHASE(3) p_attention(F, args);
    SEAM(3);
    PHASE(4) { pg8::Gemm g{(const bf16*)(ws + WS_O), (const bf16*)(ws + WS_WOUT), T, DM, DM}; pg8::StaticOrder S; S.init(T, DM, F.G, (int)blockIdx.x);
        pg8::EpiResid E{args.out, args.in[I_X], DM}; pg8::gemm_phase<pg8::EpiResid, pg8::StaticOrder, true>(F.lds, g, S, E, F.wave); }
    SEAM(4);
    PHASE(5) p7_ln1_router(F, args);
    SEAM(5);
    PHASE(6) p8_topk(F, args);
    SEAM(6);
    PHASE(7) { pg8::Gemm g{(const bf16*)(ws + WS_X1B), (const bf16*)(ws + WS_WGU), NE * NB * CAP, 2 * FF, DM}; pg8::GatherOrder S; S.init(NE * NB * CAP, 2 * FF, F.G, (int)blockIdx.x, NB * CAP / 256); S.rowmap = (const int*)(ws + WS_ROWMAP);
        pg8::EpiSwiGLU E{(bf16*)(ws + WS_H), FF}; pg8::gemm_phase<pg8::EpiSwiGLU, pg8::GatherOrder, true>(F.lds, g, S, E, F.wave); }
    SEAM(7);
    PHASE(8) { pg8::Gemm g{(const bf16*)(ws + WS_H), (const bf16*)(ws + WS_WDN), NE * NB * CAP, DM, FF}; pg8::StaticOrder S; S.init(NE * NB * CAP, DM, F.G, (int)blockIdx.x, NB * CAP / 256);
        pg8::EpiRowScaleBf16 E{(bf16*)(ws + WS_YEXP), DM, (const float*)(ws + WS_GVAL)}; pg8::gemm_phase<pg8::EpiRowScaleBf16, pg8::StaticOrder, true>(F.lds, g, S, E, F.wave); }
    SEAM(8);
    PHASE(9) p11_ln2(F, args);
    SEAM(9);
    PHASE(10) {
        { pg8::Gemm g{(const bf16*)(ws + WS_PB), (const bf16*)(ws + WS_WPP), T, DM, PLE}; pg8::StaticOrder S; S.init(T, DM, F.G, (int)blockIdx.x);
          pg8::EpiF32 E{(float*)(ws + WS_E), DM}; pg8::gemm_phase<pg8::EpiF32, pg8::StaticOrder, true>(F.lds, g, S, E, F.wave); }
        { pg8::Gemm g{(const bf16*)(ws + WS_X1B), (const bf16*)(ws + WS_WPG), T, DM, DM}; pg8::StaticOrder S; S.init(T, DM, F.G, (int)blockIdx.x);
          pg8::EpiPle E{args.out, (const float*)(ws + WS_E), DM}; pg8::gemm_phase<pg8::EpiPle, pg8::StaticOrder, true>(F.lds, g, S, E, F.wave); }
    }
    SEAM(10);
    PHASE(11) p13_ln3(F, args);
#undef IN
#undef SEAM
}

constexpr int NPHASES = 12;
extern "C" void kernel_launch(void* const* d_in, const int* in_sizes, int n_in, void* d_out, int out_size, void* d_ws, size_t ws_size, hipStream_t stream) {
    static int grid = 0;
    if (grid == 0) {
        if (n_in != 22 || in_sizes[0] != T * DM || out_size != T * DM || ws_size < WS_END) { fprintf(stderr, "kernel_launch: unexpected shapes (n_in %d, in0 %d, out %d, ws %zu < %zu?)\n", n_in, n_in > 0 ? in_sizes[0] : -1, out_size, ws_size, (size_t)WS_END); grid = -1; return; }
        if (hipFuncSetAttribute((const void*)fwd, hipFuncAttributeMaxDynamicSharedMemorySize, LDS_BYTES) != hipSuccess) { fprintf(stderr, "kernel_launch: hipFuncSetAttribute failed\n"); grid = -1; return; }
        int dev = 0, cus = 0, per_cu = 0;
        if (hipGetDevice(&dev) != hipSuccess || hipDeviceGetAttribute(&cus, hipDeviceAttributeMultiprocessorCount, dev) != hipSuccess) { fprintf(stderr, "kernel_launch: device query failed\n"); grid = -1; return; }
        if (hipOccupancyMaxActiveBlocksPerMultiprocessor(&per_cu, (const void*)fwd, NWAVES * 64, LDS_BYTES) != hipSuccess || per_cu < 1) { fprintf(stderr, "kernel_launch: occupancy query says %d blocks per CU\n", per_cu); (void)hipGetLastError(); grid = -1; return; }
        grid = cus;
    }
    if (grid < 0) return;
    Args a{};
    for (int i = 0; i < 22; ++i) a.in[i] = (const float*)d_in[i];
    a.out = (float*)d_out; a.ws = (unsigned char*)d_ws;
#if MK_ONE_LAUNCH
    hipMemsetAsync((char*)d_ws + WS_CTL, 0, 65536, stream);
    a.ph_lo = 0; a.ph_hi = NPHASES;
    hipLaunchKernelGGL(fwd, dim3(grid), dim3(NWAVES * 64), LDS_BYTES, stream, a);
#else
    for (int ph = 0; ph < NPHASES; ++ph) {
        a.ph_lo = ph; a.ph_hi = ph + 1;
        hipLaunchKernelGGL(fwd, dim3(grid), dim3(NWAVES * 64), LDS_BYTES, stream, a);
    }
#endif
}
```

```cpp
#include <hip/hip_runtime.h>
#include <cstdio>
#include <cstdint>

#ifndef MK_ONE_LAUNCH
#define MK_ONE_LAUNCH 1
#endif

__device__ __forceinline__ int fresh_lane() { int l = (int)__builtin_amdgcn_mbcnt_hi(~0u, __builtin_amdgcn_mbcnt_lo(~0u, 0u)); asm volatile("" : "+v"(l)); return l; }
namespace pg8 {
#define PG8_LAS __attribute__((address_space(3)))
typedef unsigned short bf16_t;
typedef short bf16x8 __attribute__((ext_vector_type(8)));
typedef float f32x4 __attribute__((ext_vector_type(4)));
typedef unsigned u32x4 __attribute__((ext_vector_type(4)));
typedef unsigned u32x2 __attribute__((ext_vector_type(2)));
constexpr int BM = 256, BK = 64, HALF = 128, HTB = HALF * BK * 2  , STAGE_BYTES = 8 * HTB, NXCD = 8, WGM = 8;

__host__ __device__ __forceinline__ int lds_byte(int r, int c) { const int st = (r >> 4) * 2 + (c >> 5), rr = r & 15, cc = c & 31, ob = rr * 64 + cc * 2; return st * 1024 + (ob ^ (((ob >> 9) & 1) << 5)); }
__host__ __device__ __forceinline__ void stage_rc(int b, int& R, int& C) { const int st = b / 1024, sb = b % 1024, swz = sb ^ (((sb >> 9) & 1) << 5); R = (st >> 1) * 16 + swz / 64; C = (st & 1) * 32 + (swz % 64) / 2; }
__host__ __device__ __forceinline__ int perm32(int rho) { const int n = rho >> 4, i = rho & 15; return 8 * (i >> 2) + 4 * n + (i & 3); }

struct Unit { int pm, pn; };
struct Gemm { const bf16_t* A; const bf16_t* Bt; int M, N, K; };

struct StaticOrder {
    static constexpr bool GATHER = false;
    int nM, nN, nwg, G, c, mpe;
    __host__ __device__ void init(int M, int N, int G_, int c_, int mpe_ = 0) { nM = M / BM; nN = N / BM; nwg = nM * nN; G = G_; c = c_; mpe = mpe_; }
    __host__ __device__ bool next(int i, Unit& u) const {
        const long L = (long)i * G + c; if (L >= nwg) return false;
        int wgid = (int)L; { const int q = nwg / NXCD, r = nwg % NXCD, xcd = wgid % NXCD, off = wgid / NXCD; wgid = (xcd < r ? xcd * (q + 1) : r * (q + 1) + (xcd - r) * q) + off; }
        const int nig = WGM * nN, gid = wgid / nig, fm = gid * WGM, gsz = (nM - fm) < WGM ? (nM - fm) : WGM;
        u.pm = fm + ((wgid % nig) % gsz); u.pn = (wgid % nig) / gsz; return true;
    }
    __host__ __device__ __forceinline__ int btile(const Unit& u) const { return mpe ? (u.pm / mpe) * nN + u.pn : u.pn; }
    __device__ __forceinline__ unsigned arow(const Unit&, int) const { return 0u; }
};
struct GatherOrder : StaticOrder {
    static constexpr bool GATHER = true;
    const int* rowmap;
    __device__ __forceinline__ unsigned arow(const Unit& u, int r) const { return (unsigned)rowmap[u.pm * BM + r]; }
};

__device__ __forceinline__ unsigned cvt_pk_bf16(float lo, float hi) { unsigned r; asm volatile("v_cvt_pk_bf16_f32 %0, %1, %2" : "=v"(r) : "v"(lo), "v"(hi)); return r; }

struct EpiF32 {
    static constexpr bool PERM = false;
    float* O; int ldc;
    __device__ __forceinline__ void operator()(const f32x4 (&acc)[2][2][4][2], const Unit& u, int wr, int wc, int fr, int fq) const {
        { const int l_ = fresh_lane(); fr = l_ & 15; fq = l_ >> 4; }
        const int row0 = u.pm * BM + wr * 64 + fr, col0 = u.pn * BM + wc * 32 + 4 * fq;
#pragma unroll
        for (int ai = 0; ai < 2; ++ai)
#pragma unroll
            for (int m = 0; m < 4; ++m) { float* rowp = O + (size_t)(row0 + ai * HALF + m * 16) * ldc + col0;
#pragma unroll
                for (int bj = 0; bj < 2; ++bj)
#pragma unroll
                    for (int n = 0; n < 2; ++n) *(f32x4*)(rowp + bj * HALF + n * 16) = acc[ai][bj][m][n]; }
    }
};
struct EpiSwiGLU {
    static constexpr bool PERM = false;
    bf16_t* H; int ldh;
    __device__ __forceinline__ void operator()(const f32x4 (&acc)[2][2][4][2], const Unit& u, int wr, int wc, int fr, int fq) const {
        { const int l_ = fresh_lane(); fr = l_ & 15; fq = l_ >> 4; }
        const int row0 = u.pm * BM + wr * 64 + fr, col0 = u.pn * HALF + wc * 32 + 4 * fq;
#pragma unroll
        for (int ai = 0; ai < 2; ++ai)
#pragma unroll
            for (int m = 0; m < 4; ++m) { bf16_t* rowp = H + (size_t)(row0 + ai * HALF + m * 16) * ldh + col0;
#pragma unroll
                for (int n = 0; n < 2; ++n) { const f32x4 g = acc[ai][0][m][n], up = acc[ai][1][m][n]; float h[4];
#pragma unroll
                    for (int j = 0; j < 4; ++j) { const float s = __builtin_amdgcn_rcpf(1.0f + __builtin_amdgcn_exp2f(-1.4426950408889634f * g[j])); h[j] = g[j] * s * up[j]; }
                    u32x2 w; w.x = cvt_pk_bf16(h[0], h[1]); w.y = cvt_pk_bf16(h[2], h[3]); *(u32x2*)(rowp + n * 16) = w; } }
    }
};
__device__ __forceinline__ unsigned pk4_fp8(float a, float b, float c, float d) { int w = __builtin_amdgcn_cvt_pk_fp8_f32(a, b, 0, false); w = __builtin_amdgcn_cvt_pk_fp8_f32(c, d, w, true); return (unsigned)w; }
struct EpiSwiGLU8 {
    static constexpr bool PERM = true;
    unsigned char* H; int ldh;
    __device__ __forceinline__ void operator()(const f32x4 (&acc)[2][2][4][2], const Unit& u, int wr, int wc, int fr, int fq) const {
        { const int l_ = fresh_lane(); fr = l_ & 15; fq = l_ >> 4; }
        const int row0 = u.pm * BM + wr * 64 + fr, col0 = u.pn * HALF + wc * 32 + 8 * fq;
#pragma unroll
        for (int ai = 0; ai < 2; ++ai)
#pragma unroll
            for (int m = 0; m < 4; ++m) { unsigned char* rowp = H + (size_t)(row0 + ai * HALF + m * 16) * ldh + col0; float h[2][4];
#pragma unroll
                for (int n = 0; n < 2; ++n) { const f32x4 g = acc[ai][0][m][n], up = acc[ai][1][m][n];
#pragma unroll
                    for (int j = 0; j < 4; ++j) { const float gg = g[j] * 0.03125f; const float s = __builtin_amdgcn_rcpf(1.0f + __builtin_amdgcn_exp2f(-1.4426950408889634f * gg)); h[n][j] = gg * s * up[j] * 0.25f; } }
                u32x2 w; w.x = pk4_fp8(h[0][0], h[0][1], h[0][2], h[0][3]); w.y = pk4_fp8(h[1][0], h[1][1], h[1][2], h[1][3]); *(u32x2*)rowp = w; }
    }
};
struct EpiRowScaleBf16 {
    static constexpr bool PERM = false;
    bf16_t* O; int ldc; const float* rs; float mul;
    __device__ __forceinline__ void operator()(const f32x4 (&acc)[2][2][4][2], const Unit& u, int wr, int wc, int fr, int fq) const {
        { const int l_ = fresh_lane(); fr = l_ & 15; fq = l_ >> 4; }
        const int row0 = u.pm * BM + wr * 64 + fr, col0 = u.pn * BM + wc * 32 + 4 * fq;
#pragma unroll
        for (int ai = 0; ai < 2; ++ai)
#pragma unroll
            for (int m = 0; m < 4; ++m) { int row = row0 + ai * HALF + m * 16; asm volatile("" : "+v"(row) :: "memory"); const float s = rs[row] * mul; bf16_t* rowp = O + (size_t)row * ldc + col0;
#pragma unroll
                for (int bj = 0; bj < 2; ++bj)
#pragma unroll
                    for (int n = 0; n < 2; ++n) { const f32x4 v = acc[ai][bj][m][n] * s; u32x2 w; w.x = cvt_pk_bf16(v[0], v[1]); w.y = cvt_pk_bf16(v[2], v[3]); *(u32x2*)(rowp + bj * HALF + n * 16) = w; } }
    }
};

constexpr int TAB_OFF = 131072 + 1024, TAB_COS64 = TAB_OFF, TAB_SIN64 = TAB_OFF + 4096, TAB_COS32 = TAB_OFF + 8192, TAB_SIN32 = TAB_OFF + 10240;
constexpr float kRmsEps = 1e-6f, kAlpha = 1.189207115002721f, kInv2Pi = 0.15915494309189535f, kLog2Base = 13.287712379549449f;
__device__ __forceinline__ void sincos_rev(float pos, float ivr, float& s, float& c) { float rev = pos * ivr; rev = rev - floorf(rev); s = __builtin_amdgcn_sinf(rev); c = __builtin_amdgcn_cosf(rev); }
__device__ __forceinline__ void st_bf16x4(bf16_t* p, const f32x4 v) { u32x2 w; w.x = cvt_pk_bf16(v[0], v[1]); w.y = cvt_pk_bf16(v[2], v[3]); *(u32x2*)p = w; }
__device__ __forceinline__ float sumsq4(const f32x4 x) { return (x[0] * x[0] + x[1] * x[1]) + (x[2] * x[2] + x[3] * x[3]); }
struct EpiProj {
    static constexpr bool PERM = false;
    bf16_t *QG, *KG, *VG, *CQ, *CKV, *KPE; float *SSQ, *SSKV; const float *qn, *kn; PG8_LAS const unsigned char* lds;
    __device__ __forceinline__ void operator()(const f32x4 (&acc)[2][2][4][2], const Unit& u, int wr, int wc, int fr, int fq) const {
        { const int l_ = fresh_lane(); fr = l_ & 15; fq = l_ >> 4; }
        const int pn = u.pn, row0 = u.pm * BM + wr * 64 + fr;
        if (pn <= 2) {
            if (pn == 2 && wc >= 2) {
#pragma unroll
                for (int ai = 0; ai < 2; ++ai)
#pragma unroll
                    for (int m = 0; m < 4; ++m) { bf16_t* rowp = VG + (size_t)(row0 + ai * HALF + m * 16) * 128 + (wc - 2) * 64 + 4 * fq;
#pragma unroll
                        for (int bj = 0; bj < 2; ++bj)
#pragma unroll
                            for (int n = 0; n < 2; ++n) st_bf16x4(rowp + 32 * bj + 16 * n, acc[ai][bj][m][n]); }
            } else {
                const float* gn = (pn < 2) ? qn : kn;
                bf16_t* dst = (pn < 2) ? QG + (pn * 4 + wc) * 64 : KG + wc * 64; const int ldd = (pn < 2) ? 512 : 128;
                const int prow = 4 * (u.pm & 7) + wr;
#pragma unroll
                for (int m = 0; m < 4; ++m)
#pragma unroll
                    for (int ai = 0; ai < 2; ++ai) {
                        float ss = (sumsq4(acc[ai][0][m][0]) + sumsq4(acc[ai][0][m][1])) + (sumsq4(acc[ai][1][m][0]) + sumsq4(acc[ai][1][m][1]));
                        ss += __shfl_xor(ss, 16); ss += __shfl_xor(ss, 32);
                        const float rs = 1.0f / sqrtf(ss * (1.0f / 64.0f) + kRmsEps);
                        int row = row0 + ai * HALF + m * 16; asm volatile("" : "+v"(row) :: "memory");
                        bf16_t* rowp = dst + (size_t)row * ldd + 4 * fq;
#pragma unroll
                        for (int bj = 0; bj < 2; ++bj) { const int pos = bj ? (16 * m + fr) : (prow + 2 * ai);
                            const f32x4 c = *(const PG8_LAS f32x4*)(lds + TAB_COS64 + pos * 64 + fq * 16), s = *(const PG8_LAS f32x4*)(lds + TAB_SIN64 + pos * 64 + fq * 16);
                            const f32x4 g0 = *(const f32x4*)(gn + 32 * bj + 4 * fq), g1 = *(const f32x4*)(gn + 32 * bj + 16 + 4 * fq);
                            const f32x4 x1 = acc[ai][bj][m][0] * rs * g0, x2 = acc[ai][bj][m][1] * rs * g1;
                            st_bf16x4(rowp + 32 * bj, x1 * c - x2 * s); st_bf16x4(rowp + 32 * bj + 16, x2 * c + x1 * s); }
                        asm volatile("" ::: "memory"); }
            }
        } else if (pn <= 4) {
            bf16_t* dst = (pn == 3) ? CQ : CKV; float* sd = (pn == 3) ? SSQ : SSKV;
#pragma unroll
            for (int ai = 0; ai < 2; ++ai)
#pragma unroll
                for (int m = 0; m < 4; ++m) { int row = row0 + ai * HALF + m * 16; asm volatile("" : "+v"(row) :: "memory");
                    float ss = (sumsq4(acc[ai][0][m][0]) + sumsq4(acc[ai][0][m][1])) + (sumsq4(acc[ai][1][m][0]) + sumsq4(acc[ai][1][m][1]));
                    ss += __shfl_xor(ss, 16); ss += __shfl_xor(ss, 32);
                    if (fq == 0) sd[(size_t)row * 4 + wc] = ss;
                    bf16_t* rowp = dst + (size_t)row * 256 + wc * 32 + 4 * fq;
#pragma unroll
                    for (int bj = 0; bj < 2; ++bj)
#pragma unroll
                        for (int n = 0; n < 2; ++n) st_bf16x4(rowp + 128 * bj + 16 * n, acc[ai][bj][m][n]); }
        } else if (wc == 0) {
            const int prow = 4 * (u.pm & 7) + wr;
#pragma unroll
            for (int ai = 0; ai < 2; ++ai)
#pragma unroll
                for (int m = 0; m < 4; ++m) { const int pos = (fq >> 1) ? (16 * m + fr) : (prow + 2 * ai);
                    const f32x4 c = *(const PG8_LAS f32x4*)(lds + TAB_COS32 + pos * 32 + (fq & 1) * 16), s = *(const PG8_LAS f32x4*)(lds + TAB_SIN32 + pos * 32 + (fq & 1) * 16);
                    const f32x4 x1 = acc[ai][0][m][0], x2 = acc[ai][0][m][1];
                    bf16_t* rowp = KPE + (size_t)(row0 + ai * HALF + m * 16) * 32 + 16 * (fq >> 1) + 4 * (fq & 1);
                    st_bf16x4(rowp, x1 * c - x2 * s); st_bf16x4(rowp + 8, x2 * c + x1 * s); }
        }
    }
};
struct EpiMlaQ {
    static constexpr bool PERM = false;
    bf16_t* QM; const float* SSQ; PG8_LAS const unsigned char* lds;
    __device__ __forceinline__ void operator()(const f32x4 (&acc)[2][2][4][2], const Unit& u, int wr, int wc, int fr, int fq) const {
        { const int l_ = fresh_lane(); fr = l_ & 15; fq = l_ >> 4; }
        const int pn = u.pn, row0 = u.pm * BM + wr * 64 + fr, prow = 4 * (u.pm & 7) + wr;
#pragma unroll
        for (int ai = 0; ai < 2; ++ai)
#pragma unroll
            for (int m = 0; m < 4; ++m) { int row = row0 + ai * HALF + m * 16; asm volatile("" : "+v"(row) :: "memory"); const f32x4 p = *(const f32x4*)(SSQ + (size_t)row * 4);
                const float rs = 1.0f / sqrtf(((p[0] + p[1]) + (p[2] + p[3])) * (1.0f / 256.0f) + kRmsEps); bf16_t* rowp = QM + (size_t)row * 768;
                if (pn < 2) {
#pragma unroll
                    for (int bj = 0; bj < 2; ++bj)
#pragma unroll
                        for (int n = 0; n < 2; ++n) st_bf16x4(rowp + (4 * pn + 2 * bj + (wc >> 1)) * 96 + 32 * (wc & 1) + 16 * n + 4 * fq, acc[ai][bj][m][n] * rs);
                } else {
                    const int pos = (fq >> 1) ? (16 * m + fr) : (prow + 2 * ai);
                    const f32x4 c = *(const PG8_LAS f32x4*)(lds + TAB_COS32 + pos * 32 + (fq & 1) * 16), s = *(const PG8_LAS f32x4*)(lds + TAB_SIN32 + pos * 32 + (fq & 1) * 16);
#pragma unroll
                    for (int bj = 0; bj < 2; ++bj) { const f32x4 x1 = acc[ai][bj][m][0] * rs, x2 = acc[ai][bj][m][1] * rs;
                        bf16_t* hp = rowp + (4 * bj + wc) * 96 + 64 + 16 * (fq >> 1) + 4 * (fq & 1); st_bf16x4(hp, x1 * c - x2 * s); st_bf16x4(hp + 8, x2 * c + x1 * s); }
                }
                asm volatile("" ::: "memory"); }
    }
};
struct EpiMlaKV {
    static constexpr bool PERM = false;
    bf16_t *KN, *VM; const float* SSKV;
    __device__ __forceinline__ void operator()(const f32x4 (&acc)[2][2][4][2], const Unit& u, int wr, int wc, int fr, int fq) const {
        { const int l_ = fresh_lane(); fr = l_ & 15; fq = l_ >> 4; }
        const int row0 = u.pm * BM + wr * 64 + fr;
#pragma unroll
        for (int ai = 0; ai < 2; ++ai)
#pragma unroll
            for (int m = 0; m < 4; ++m) { int row = row0 + ai * HALF + m * 16; asm volatile("" : "+v"(row) :: "memory"); const f32x4 p = *(const f32x4*)(SSKV + (size_t)row * 4);
                const float rs = 1.0f / sqrtf(((p[0] + p[1]) + (p[2] + p[3])) * (1.0f / 256.0f) + kRmsEps);
                bf16_t* rowp = ((wc < 2) ? KN : VM) + (size_t)row * 512 + (wc & 1) * 32 + 4 * fq;
#pragma unroll
                for (int bj = 0; bj < 2; ++bj)
#pragma unroll
                    for (int n = 0; n < 2; ++n) st_bf16x4(rowp + (2 * u.pn + bj) * 64 + 16 * n, acc[ai][bj][m][n] * rs); }
    }
};
struct EpiResid {
    static constexpr bool PERM = false;
    float* O; const float* X; int ldc;
    __device__ __forceinline__ void operator()(const f32x4 (&acc)[2][2][4][2], const Unit& u, int wr, int wc, int fr, int fq) const {
        { const int l_ = fresh_lane(); fr = l_ & 15; fq = l_ >> 4; }
        const int row0 = u.pm * BM + wr * 64 + fr, col0 = u.pn * BM + wc * 32 + 4 * fq;
#pragma unroll
        for (int ai = 0; ai < 2; ++ai)
#pragma unroll
            for (int m = 0; m < 4; ++m) { int row = row0 + ai * HALF + m * 16; asm volatile("" : "+v"(row) :: "memory"); const size_t off = (size_t)row * ldc + col0;
#pragma unroll
                for (int bj = 0; bj < 2; ++bj)
#pragma unroll
                    for (int n = 0; n < 2; ++n) { const f32x4 xv = *(const f32x4*)(X + off + bj * HALF + n * 16); *(f32x4*)(O + off + bj * HALF + n * 16) = xv * kAlpha + acc[ai][bj][m][n]; } }
    }
};
struct EpiPle {
    static constexpr bool PERM = false;
    float* O; const float* E; int ldc;
    __device__ __forceinline__ void operator()(const f32x4 (&acc)[2][2][4][2], const Unit& u, int wr, int wc, int fr, int fq) const {
        { const int l_ = fresh_lane(); fr = l_ & 15; fq = l_ >> 4; }
        const int row0 = u.pm * BM + wr * 64 + fr, col0 = u.pn * BM + wc * 32 + 4 * fq;
#pragma unroll
        for (int ai = 0; ai < 2; ++ai)
#pragma unroll
            for (int m = 0; m < 4; ++m) { int row = row0 + ai * HALF + m * 16; asm volatile("" : "+v"(row) :: "memory"); const size_t off = (size_t)row * ldc + col0;
#pragma unroll
                for (int bj = 0; bj < 2; ++bj)
#pragma unroll
                    for (int n = 0; n < 2; ++n) { const f32x4 xv = *(const f32x4*)(O + off + bj * HALF + n * 16), ev = *(const f32x4*)(E + off + bj * HALF + n * 16), a = acc[ai][bj][m][n]; f32x4 o;
#pragma unroll
                        for (int j = 0; j < 4; ++j) o[j] = xv[j] * kAlpha + ev[j] * __builtin_amdgcn_rcpf(1.0f + __builtin_amdgcn_exp2f(-1.4426950408889634f * a[j]));
                        *(f32x4*)(O + off + bj * HALF + n * 16) = o; } }
    }
};

typedef int i32x8 __attribute__((ext_vector_type(8)));
typedef int i32x4 __attribute__((ext_vector_type(4)));
__device__ __forceinline__ i32x8 cat8(bf16x8 a, bf16x8 b) { return __builtin_shufflevector(__builtin_bit_cast(i32x4, a), __builtin_bit_cast(i32x4, b), 0, 1, 2, 3, 4, 5, 6, 7); }
template <class Epi, class Sched, bool ALIGN_EPI, bool FP8 = false>
__device__ __forceinline__ void gemm_phase(PG8_LAS unsigned char* lds, const Gemm g, const Sched& S, const Epi& E, int wid) {
    constexpr bool GATHER = Sched::GATHER;
    const int lane = fresh_lane(), tid = wid * 64 + lane, wr = wid >> 2, wc = wid & 3, fr = lane & 15, fq = lane >> 4;
    const int K = g.K, nt = K / BK;
    unsigned voffB[2], vC0[2], vC1[2], vN0[2], vN1[2]; int RA[2]; unsigned cofA[2];
#pragma unroll
    for (int i = 0; i < 2; ++i) { int R, C; stage_rc(tid * 16 + i * 8192, R, C); const int Rb = Epi::PERM ? ((R & ~31) + perm32(R & 31)) : R;
        vC0[i] = (unsigned)(R * K + C) * 2u; vC1[i] = vC0[i]; vN0[i] = vC0[i]; vN1[i] = vC0[i]; voffB[i] = (unsigned)(Rb * K + C) * 2u; RA[i] = R; cofA[i] = (unsigned)C * 2u; }
    const size_t kstep = (size_t)(BK * 2);
    const size_t hstep = (size_t)HALF * K * 2;
    const size_t hstepA = GATHER ? (size_t)0 : hstep;
    const size_t tstep = 2 * hstep;
    const unsigned ldsw = (unsigned)wid * 1024u;
    const unsigned ldsbase = (unsigned)(uintptr_t)lds + ldsw;
    const int aoff = lds_byte(wr * 64 + fr, fq * 8), boff = lds_byte(wc * 32 + fr, fq * 8);
#define PG8_SA(b, h) (((b) * 2 + (h)) * HTB)
#define PG8_SB(b, h) ((4 + (b) * 2 + (h)) * HTB)
#define PG8_STAGE(bufoff, gbase, voff) do { _Pragma("unroll") for (int _i = 0; _i < 2; ++_i) { unsigned _keep; \
        asm volatile("s_mov_b32 %0, m0\n\ts_mov_b32 m0, %3\n\ts_nop 0\n\tglobal_load_lds_dwordx4 %1, %2\n\ts_mov_b32 m0, %0" \
            : "=&s"(_keep) : "v"((voff)[_i]), "s"((const char*)(gbase)), "s"(ldsbase + (unsigned)((bufoff) + _i * 8192)) : "memory"); } } while (0)
#define PG8_LDA(dst, b, h) do { _Pragma("unroll") for (int m = 0; m < 4; ++m) _Pragma("unroll") for (int k = 0; k < 2; ++k) dst[m][k] = *(const PG8_LAS bf16x8*)(lds + PG8_SA(b, h) + aoff + m * 2048 + k * 1024); } while (0)
#define PG8_LDB(dst, b, h) do { _Pragma("unroll") for (int n = 0; n < 2; ++n) _Pragma("unroll") for (int k = 0; k < 2; ++k) dst[n][k] = *(const PG8_LAS bf16x8*)(lds + PG8_SB(b, h) + boff + n * 2048 + k * 1024); } while (0)
#define PG8_MMA(ai, bj, At, Bt) do { __builtin_amdgcn_s_setprio(1); _Pragma("unroll") for (int m = 0; m < 4; ++m) _Pragma("unroll") for (int n = 0; n < 2; ++n) { \
        if constexpr (FP8) acc[ai][bj][m][n] = __builtin_amdgcn_mfma_scale_f32_16x16x128_f8f6f4(cat8(Bt[n][0], Bt[n][1]), cat8(At[m][0], At[m][1]), acc[ai][bj][m][n], 0, 0, 0, 0x7f7f7f7f, 0, 0x7f7f7f7f); \
        else { _Pragma("unroll") for (int k = 0; k < 2; ++k) acc[ai][bj][m][n] = __builtin_amdgcn_mfma_f32_16x16x32_bf16(Bt[n][k], At[m][k], acc[ai][bj][m][n], 0, 0, 0); } } __builtin_amdgcn_s_setprio(0); } while (0)
#define PG8_WAIT_V(n) asm volatile("s_waitcnt vmcnt(" #n ")" ::: "memory")
#define PG8_WAIT_L(n) asm volatile("s_waitcnt lgkmcnt(" #n ")" ::: "memory")
#define PG8_BAR __builtin_amdgcn_s_barrier()
#define PG8_SCHED __builtin_amdgcn_sched_barrier(0)
#define PG8_AROWS(u, d0, d1) do { if constexpr (GATHER) { _Pragma("unroll") for (int _i = 0; _i < 2; ++_i) { \
        d0[_i] = S.arow(u, RA[_i]) * (unsigned)(K * 2) + cofA[_i]; d1[_i] = S.arow(u, HALF + RA[_i]) * (unsigned)(K * 2) + cofA[_i]; } } } while (0)
    Unit cur, nxt; int ui = 0;
    if (!S.next(0, cur)) return;
    f32x4 acc[2][2][4][2];
#pragma unroll
    for (int a = 0; a < 2; ++a)
#pragma unroll
        for (int b = 0; b < 2; ++b)
#pragma unroll
            for (int m = 0; m < 4; ++m)
#pragma unroll
                for (int n = 0; n < 2; ++n) acc[a][b][m][n] = (f32x4){0.f, 0.f, 0.f, 0.f};
    bf16x8 At[4][2], B0[2][2], B1[2][2];
    const char* cA = GATHER ? (const char*)g.A : (const char*)g.A + (size_t)cur.pm * tstep; const char* cB = (const char*)g.Bt + (size_t)S.btile(cur) * tstep;
    PG8_AROWS(cur, vC0, vC1);
    PG8_STAGE(PG8_SB(0, 0), cB, voffB); PG8_STAGE(PG8_SB(0, 1), cB + hstep, voffB); PG8_STAGE(PG8_SA(0, 0), cA, vC0); PG8_STAGE(PG8_SA(0, 1), cA + hstepA, vC1);
    if (wr == 1) PG8_BAR;
    PG8_WAIT_V(2); PG8_BAR;
    PG8_STAGE(PG8_SB(1, 0), cB + kstep, voffB); PG8_STAGE(PG8_SA(1, 0), cA + kstep, vC0); PG8_STAGE(PG8_SB(1, 1), cB + hstep + kstep, voffB);
    PG8_WAIT_V(6); PG8_BAR;
    for (;;) {
        const bool has_next = S.next(ui + 1, nxt);
        const char* nA = GATHER ? (const char*)g.A : (has_next ? (const char*)g.A + (size_t)nxt.pm * tstep : cA); const char* nB = has_next ? (const char*)g.Bt + (size_t)S.btile(nxt) * tstep : cB;
        if constexpr (GATHER) { if (has_next) { PG8_AROWS(nxt, vN0, vN1); } else { vN0[0] = vC0[0]; vN0[1] = vC0[1]; vN1[0] = vC1[0]; vN1[1] = vC1[1]; } }
#pragma unroll 1
        for (int t = 0; t < nt; t += 2) {
            const bool last = (t == nt - 2);
            const char* a1 = cA + (size_t)(t + 1) * kstep;
            const char* a2 = last ? nA : cA + (size_t)(t + 2) * kstep; const char* b2 = last ? nB : cB + (size_t)(t + 2) * kstep;
            const char* a3 = a2 + kstep; const char* b3 = b2 + kstep;
            PG8_LDB(B0, 0, 0); PG8_LDB(B1, 0, 1); PG8_SCHED; PG8_LDA(At, 0, 0); PG8_STAGE(PG8_SA(1, 1), a1 + hstepA, vC1);
            if constexpr (GATHER) { if (last) { vC0[0] = vN0[0]; vC0[1] = vN0[1]; vC1[0] = vN1[0]; vC1[1] = vN1[1]; } }
            PG8_WAIT_V(8); PG8_WAIT_L(0); PG8_BAR; PG8_MMA(0, 0, At, B0); PG8_MMA(0, 1, At, B1); PG8_BAR; PG8_SCHED;
            PG8_LDA(At, 0, 1); PG8_STAGE(PG8_SB(0, 0), b2, voffB); PG8_STAGE(PG8_SB(0, 1), b2 + hstep, voffB); PG8_STAGE(PG8_SA(0, 0), a2, vC0);
            PG8_WAIT_V(8); PG8_WAIT_L(0); PG8_BAR; PG8_MMA(1, 0, At, B0); PG8_MMA(1, 1, At, B1); PG8_BAR; PG8_SCHED;
            PG8_LDB(B0, 1, 0); PG8_LDB(B1, 1, 1); PG8_SCHED; PG8_LDA(At, 1, 0); PG8_STAGE(PG8_SA(0, 1), a2 + hstepA, vC1);
            PG8_WAIT_V(8); PG8_WAIT_L(0); PG8_BAR; PG8_MMA(0, 0, At, B0); PG8_MMA(0, 1, At, B1); PG8_BAR; PG8_SCHED;
            PG8_LDA(At, 1, 1); PG8_STAGE(PG8_SB(1, 0), b3, voffB); PG8_STAGE(PG8_SB(1, 1), b3 + hstep, voffB); PG8_STAGE(PG8_SA(1, 0), a3, vC0);
            PG8_WAIT_V(8); PG8_WAIT_L(0); PG8_BAR; PG8_MMA(1, 0, At, B0); PG8_MMA(1, 1, At, B1); PG8_BAR; PG8_SCHED;
        }
        if constexpr (ALIGN_EPI) { if (wr == 0) PG8_BAR; }
        E(acc, cur, wr, wc, fr, fq);
        if (!has_next) break;
#pragma unroll
        for (int a = 0; a < 2; ++a)
#pragma unroll
            for (int b = 0; b < 2; ++b)
#pragma unroll
                for (int m = 0; m < 4; ++m)
#pragma unroll
                    for (int n = 0; n < 2; ++n) acc[a][b][m][n] = (f32x4){0.f, 0.f, 0.f, 0.f};
        cur = nxt; cA = nA; cB = nB; ++ui;
        if constexpr (ALIGN_EPI) { if (wr == 1) PG8_BAR; }
    }
    PG8_WAIT_V(0);
    if constexpr (!ALIGN_EPI) { if (wr == 0) PG8_BAR; }
    PG8_BAR;
#undef PG8_SA
#undef PG8_SB
#undef PG8_STAGE
#undef PG8_LDA
#undef PG8_LDB
#undef PG8_MMA
#undef PG8_WAIT_V
#undef PG8_WAIT_L
#undef PG8_BAR
#undef PG8_SCHED
#undef PG8_AROWS
}
}

namespace att {
using bf16_t = unsigned short;
using bf16x8 = __attribute__((ext_vector_type(8))) short;
using s16x4  = __attribute__((ext_vector_type(4))) short;
using f32x16 = __attribute__((ext_vector_type(16))) float;
using u32x4  = __attribute__((ext_vector_type(4))) unsigned;
#define SBAR() __builtin_amdgcn_sched_barrier(0)
constexpr float THR = 8.f;
__device__ __forceinline__ int crow(int r, int hi) { return (r & 3) + 8 * (r >> 2) + 4 * hi; }
__device__ __forceinline__ unsigned cvtpk(float lo, float hi) { unsigned r; asm volatile("v_cvt_pk_bf16_f32 %0, %1, %2" : "=v"(r) : "v"(lo), "v"(hi)); return r; }
template <int DK> struct KCfg;
template <> struct KCfg<64> { static constexpr float SCALE = 0.125f;
    static __device__ __forceinline__ int swz(int row, int cb) { return row * 128 + (cb ^ (((row >> 1) & 7) << 4)); } };
template <> struct KCfg<96> { static constexpr float SCALE = 0.10206207261596577f;
    static __device__ __forceinline__ int swz(int row, int cb) { return row * 192 + (cb ^ (((row >> 2) & 3) << 4)); } };

template <int DK> __device__ __forceinline__ void partialSM(f32x16& p0, f32x16& p1, float& m_reg, float& mn, float& alpha) {
  constexpr float SCALE = KCfg<DK>::SCALE, C = SCALE * 1.4426950408889634f;
  float pmax = p0[0];
#pragma unroll
  for (int r = 1; r < 16; ++r) pmax = fmaxf(pmax, p0[r]);
#pragma unroll
  for (int r = 0; r < 16; ++r) pmax = fmaxf(pmax, p1[r]);
  { auto rr = __builtin_amdgcn_permlane32_swap(__float_as_uint(pmax), __float_as_uint(pmax), false, false);
    pmax = fmaxf(__uint_as_float(rr[0]), __uint_as_float(rr[1])); }
  if (__builtin_expect(__all(pmax - m_reg <= THR / SCALE), 1)) { mn = m_reg; alpha = 1.f; }
  else { mn = fmaxf(m_reg, pmax); alpha = __builtin_amdgcn_exp2f((m_reg - mn) * C); m_reg = mn; }
  float mnC = -mn * C;
#pragma unroll
  for (int r = 0; r < 16; ++r) p0[r] = fmaf(p0[r], C, mnC);
#pragma unroll
  for (int r = 0; r < 16; ++r) p1[r] = fmaf(p1[r], C, mnC);
#pragma unroll
  for (int r = 0; r < 16; ++r) p0[r] = __builtin_amdgcn_exp2f(p0[r]);
}
__device__ __forceinline__ void finishSM(f32x16& p0, f32x16& p1, float alpha, float& l_reg, bf16x8& pa0, bf16x8& pa1, bf16x8& pa2, bf16x8& pa3) {
#pragma unroll
  for (int r = 0; r < 16; ++r) p1[r] = __builtin_amdgcn_exp2f(p1[r]);
  float ps = 0;
#pragma unroll
  for (int r = 0; r < 16; ++r) ps += p0[r];
#pragma unroll
  for (int r = 0; r < 16; ++r) ps += p1[r];
  { auto rr = __builtin_amdgcn_permlane32_swap(__float_as_uint(ps), __float_as_uint(ps), false, false);
    ps = __uint_as_float(rr[0]) + __uint_as_float(rr[1]); }
  l_reg = l_reg * alpha + ps;
#define PK4(P, BASE, OUT) do { unsigned a0 = cvtpk(P[BASE + 0], P[BASE + 1]), a1 = cvtpk(P[BASE + 2], P[BASE + 3]);   \
    unsigned b0 = cvtpk(P[BASE + 4], P[BASE + 5]), b1 = cvtpk(P[BASE + 6], P[BASE + 7]);                              \
    auto r0 = __builtin_amdgcn_permlane32_swap(a0, b0, false, false); auto r1 = __builtin_amdgcn_permlane32_swap(a1, b1, false, false); \
    u32x4 w = {r0[0], r1[0], r0[1], r1[1]}; OUT = *reinterpret_cast<bf16x8*>(&w); } while (0)
  PK4(p0, 0, pa0); PK4(p0, 8, pa1); PK4(p1, 0, pa2); PK4(p1, 8, pa3);
#undef PK4
}
template <int DK> __device__ __forceinline__ void qkt(f32x16& p0, f32x16& p1, const char* Ks, const bf16x8* qr, int r32, int hi) {
  p0 = f32x16{}; p1 = f32x16{};
#pragma unroll
  for (int d0 = 0; d0 < DK / 16; ++d0) { const int cb = (d0 * 16 + hi * 8) * 2;
    bf16x8 b0 = *reinterpret_cast<const bf16x8*>(Ks + KCfg<DK>::swz(r32, cb));
    bf16x8 b1 = *reinterpret_cast<const bf16x8*>(Ks + KCfg<DK>::swz(32 + r32, cb));
    p0 = __builtin_amdgcn_mfma_f32_32x32x16_bf16(b0, qr[d0], p0, 0, 0, 0);
    p1 = __builtin_amdgcn_mfma_f32_32x32x16_bf16(b1, qr[d0], p1, 0, 0, 0); }
}
__device__ __forceinline__ int v_st(int k, int c) { const int kk = (k & ~0xC) | ((k & 4) << 1) | ((k & 8) >> 1); return ((kk >> 3) * 2 + (c >> 5)) * 512 + ((kk & 7) * 32 + (c & 31)) * 2; }
__device__ __forceinline__ int v_rd_base(int lane) { return ((lane & 3) << 3) | (((lane >> 2) & 3) << 6) | (((lane >> 4) & 1) << 5) | (((lane >> 5) & 1) << 8); }
constexpr int v_rd_off(int d0, int ks, int half) { return d0 * 512 + ks * 2048 + half * 1024; }
template <int OFF> __device__ __forceinline__ s16x4 tr_read(int vb) {
  s16x4 r; asm volatile("ds_read_b64_tr_b16 %0, %1 offset:%2" : "=&v"(r) : "v"(vb), "i"(OFF) : "memory"); return r;
}
template <int D0> __device__ __forceinline__ void pv_one(f32x16& od, int vb, bf16x8 pa0, bf16x8 pa1, bf16x8 pa2, bf16x8 pa3) {
  const s16x4 l0 = tr_read<v_rd_off(D0, 0, 0)>(vb), h0 = tr_read<v_rd_off(D0, 0, 1)>(vb), l1 = tr_read<v_rd_off(D0, 1, 0)>(vb), h1 = tr_read<v_rd_off(D0, 1, 1)>(vb);
  const s16x4 l2 = tr_read<v_rd_off(D0, 2, 0)>(vb), h2 = tr_read<v_rd_off(D0, 2, 1)>(vb), l3 = tr_read<v_rd_off(D0, 3, 0)>(vb), h3 = tr_read<v_rd_off(D0, 3, 1)>(vb);
  asm volatile("s_waitcnt lgkmcnt(0)" ::: "memory"); SBAR();
#define PK(L, H) (bf16x8){L[0], L[1], L[2], L[3], H[0], H[1], H[2], H[3]}
  od = __builtin_amdgcn_mfma_f32_32x32x16_bf16(pa0, PK(l0, h0), od, 0, 0, 0);
  od = __builtin_amdgcn_mfma_f32_32x32x16_bf16(pa1, PK(l1, h1), od, 0, 0, 0);
  od = __builtin_amdgcn_mfma_f32_32x32x16_bf16(pa2, PK(l2, h2), od, 0, 0, 0);
  od = __builtin_amdgcn_mfma_f32_32x32x16_bf16(pa3, PK(l3, h3), od, 0, 0, 0);
#undef PK
}
__device__ __forceinline__ void pv_d0(f32x16* o, int vb, bf16x8 pa0, bf16x8 pa1, bf16x8 pa2, bf16x8 pa3) {
  pv_one<0>(o[0], vb, pa0, pa1, pa2, pa3); pv_one<1>(o[1], vb, pa0, pa1, pa2, pa3);
}
constexpr int SEQK = 2048, KVBLK = 64, NT = SEQK / KVBLK, SHM_V = 64 * 64 * 2;
constexpr int LDS_BYTES = 2 * SHM_V + 2 * (64 * 96 * 2) + 2048 + 8 * 4096;
template <int DK>
__device__ __forceinline__ void attn_unit(const bf16_t* __restrict__ Qb, int ldq, const bf16_t* __restrict__ Kh, int ldk, const bf16_t* __restrict__ Kp, int ldp, const bf16_t* __restrict__ Vh, int ldv, bf16_t* __restrict__ Ob, int ldo, char* lds, int wid) {
  constexpr int KCH = DK / 8, SHM_K = 64 * DK * 2; constexpr bool K2 = (64 * KCH > 512);
  const int lane = fresh_lane(), tid = wid * 64 + lane, r32 = lane & 31, hi = lane >> 5;
  char* V_lds = lds; char* K_lds = lds + 2 * SHM_V;
  float* ws = (float*)(lds + 2 * SHM_V + 2 * SHM_K) + wid * 64; float* li_l = ws; float* al_l = ws + 32;
  bf16_t* stg = (bf16_t*)(lds + 2 * SHM_V + 2 * SHM_K + 2048) + wid * 2048;
  float m_reg = -1e30f, l_reg = 0; f32x16 o[2] = {}; bf16x8 qr[DK / 16];
  const bf16_t* Qw = Qb + (long)(wid * 32 + r32) * ldq + hi * 8;
#pragma unroll
  for (int d0 = 0; d0 < DK / 16; ++d0) qr[d0] = *reinterpret_cast<const bf16x8*>(Qw + d0 * 16);
  const int kr0 = tid / KCH, kc0 = (tid % KCH) * 8, kr1 = (tid + 512) / KCH, kc1 = ((tid + 512) % KCH) * 8; const bool has2 = K2 && (tid < 64 * KCH - 512);
  const bf16_t* kp0 = (kc0 < 64) ? Kh + (long)kr0 * ldk + kc0 : Kp + (long)kr0 * ldp + (kc0 - 64); const long ks0 = (kc0 < 64) ? ldk : ldp;
  const bf16_t* kp1 = (kc1 < 64) ? Kh + (long)kr1 * ldk + kc1 : Kp + (long)kr1 * ldp + (kc1 - 64); const long ks1 = (kc1 < 64) ? ldk : ldp;
  const int vr = tid >> 3, vc = (tid & 7) * 8, vst0 = v_st(vr, vc);
  const int vb0 = (int)(uintptr_t)V_lds + v_rd_base(lane);
  bf16x8 sk0, sk1, sv0;
#define SLOAD(k0) do { sk0 = *reinterpret_cast<const bf16x8*>(kp0 + (long)(k0) * ks0); if (has2) sk1 = *reinterpret_cast<const bf16x8*>(kp1 + (long)(k0) * ks1); \
    sv0 = *reinterpret_cast<const bf16x8*>(&Vh[(long)((k0) + vr) * ldv + vc]); } while (0)
#define SWRITE(b) do { *(bf16x8*)(K_lds + (b) * SHM_K + KCfg<DK>::swz(kr0, kc0 * 2)) = sk0; if (has2) *(bf16x8*)(K_lds + (b) * SHM_K + KCfg<DK>::swz(kr1, kc1 * 2)) = sk1; \
    *(bf16x8*)(V_lds + (b) * SHM_V + vst0) = sv0; } while (0)
#define SWAIT() asm volatile("s_waitcnt vmcnt(0)" ::: "memory")
#define RESC(a) do { if (__any((a) < 1.f)) { if (hi == 0) al_l[r32] = (a); asm volatile("s_waitcnt lgkmcnt(0)" ::: "memory"); \
    _Pragma("unroll") for (int d = 0; d < 2; ++d) _Pragma("unroll") for (int r = 0; r < 16; ++r) o[d][r] *= al_l[crow(r, hi)]; } } while (0)
  f32x16 pA0, pA1, pB0, pB1; float mnA, mnB, alA, alB; bf16x8 pa0, pa1, pa2, pa3;
  SLOAD(0); SWAIT(); SWRITE(0); __syncthreads();
  qkt<DK>(pA0, pA1, K_lds, qr, r32, hi); partialSM<DK>(pA0, pA1, m_reg, mnA, alA);
  SLOAD(KVBLK);
  SWAIT(); SWRITE(1); __syncthreads();
  for (int j = 1; j + 1 < NT; j += 2) {
    SBAR(); qkt<DK>(pB0, pB1, K_lds + SHM_K, qr, r32, hi);
    finishSM(pA0, pA1, alA, l_reg, pa0, pa1, pa2, pa3); SBAR();
    SLOAD((j + 1) * KVBLK); SBAR();
    pv_d0(o, vb0, pa0, pa1, pa2, pa3); partialSM<DK>(pB0, pB1, m_reg, mnB, alB);
    __syncthreads(); SWAIT(); SWRITE(0);
    RESC(alB); __syncthreads();
    SBAR(); qkt<DK>(pA0, pA1, K_lds, qr, r32, hi);
    finishSM(pB0, pB1, alB, l_reg, pa0, pa1, pa2, pa3); SBAR();
    SLOAD((j + 2) * KVBLK); SBAR();
    pv_d0(o, vb0 + SHM_V, pa0, pa1, pa2, pa3); partialSM<DK>(pA0, pA1, m_reg, mnA, alA);
    __syncthreads(); SWAIT(); SWRITE(1);
    RESC(alA); __syncthreads();
  }
  SBAR(); qkt<DK>(pB0, pB1, K_lds + SHM_K, qr, r32, hi);
  finishSM(pA0, pA1, alA, l_reg, pa0, pa1, pa2, pa3); SBAR();
  pv_d0(o, vb0, pa0, pa1, pa2, pa3); partialSM<DK>(pB0, pB1, m_reg, mnB, alB);
  __syncthreads(); RESC(alB);
  finishSM(pB0, pB1, alB, l_reg, pa0, pa1, pa2, pa3); SBAR();
  pv_d0(o, vb0 + SHM_V, pa0, pa1, pa2, pa3);
  if (hi == 0) li_l[r32] = l_reg; asm volatile("s_waitcnt lgkmcnt(0)" ::: "memory");
  float rli[16];
#pragma unroll
  for (int r = 0; r < 16; ++r) rli[r] = __builtin_amdgcn_rcpf(li_l[crow(r, hi)]);
#pragma unroll
  for (int r = 0; r < 16; ++r) { const int orow = crow(r, hi);
#pragma unroll
    for (int d0 = 0; d0 < 2; ++d0) { const unsigned w = cvtpk(o[d0][r] * rli[r], 0.f); stg[orow * 64 + d0 * 32 + r32] = (bf16_t)(w & 0xffffu); } }
  asm volatile("s_waitcnt lgkmcnt(0)" ::: "memory");
  bf16_t* Ow = Ob + (long)(wid * 32) * ldo;
#pragma unroll
  for (int i = 0; i < 4; ++i) { const int row = i * 8 + (lane >> 3), ch = lane & 7; const u32x4 v = *(const u32x4*)(stg + row * 64 + ch * 8); *(u32x4*)(Ow + (long)row * ldo + ch * 8) = v; }
  __syncthreads();
#undef SLOAD
#undef SWRITE
#undef SWAIT
#undef RESC
}
#undef SBAR
}

constexpr int NWAVES = 8;
constexpr int NB = 16, SEQ = 2048, DM = 1024, T = NB * SEQ;
constexpr int INW = 1312, INWP = 1536;
constexpr int NE = 16, CAP = 256, FF = 2816, PLE = 256;
constexpr int UQW = 768, UKVW = 1024;
constexpr float ALPHA = 1.189207115002721f;
constexpr float LN_EPS = 1e-5f, RMS_EPS = 1e-6f;

constexpr size_t MiB = 1u << 20;
constexpr size_t WS_CTL = 0;
constexpr size_t WS_WIN = 1 * MiB;
constexpr size_t WS_WUQ = 4 * MiB;
constexpr size_t WS_WUKV = 4 * MiB + 512 * 1024;
constexpr size_t WS_WOUT = 5 * MiB;
constexpr size_t WS_WPG = 7 * MiB;
constexpr size_t WS_WPP = 9 * MiB;
constexpr size_t WS_WRT = 9 * MiB + 512 * 1024;
constexpr size_t WS_AFF = 10 * MiB;
constexpr size_t WS_ROWMAP = 12 * MiB;
constexpr size_t WS_GVAL = 12 * MiB + 256 * 1024;
constexpr size_t WS_SEL = 12 * MiB + 512 * 1024;
constexpr size_t WS_SSQ = 14 * MiB + 512 * 1024, WS_SSKV = 15 * MiB;
constexpr size_t WS_WGU = 16 * MiB;
constexpr size_t WS_YEXP = 16 * MiB, WS_PB = 144 * MiB;
constexpr size_t WS_WDN = 192 * MiB;
constexpr size_t WS_X1B = 280 * MiB;
constexpr size_t WS_QMLA = 280 * MiB;
constexpr size_t WS_R1 = 344 * MiB;
constexpr size_t WS_XB = WS_R1;
constexpr size_t WS_PROJ = WS_R1 + 64 * MiB;
constexpr size_t WS_QG = WS_R1 + 256 * MiB, WS_KG = WS_QG + 32 * MiB, WS_VG = WS_KG + 8 * MiB, WS_CQ = WS_VG + 8 * MiB, WS_CKV = WS_CQ + 16 * MiB, WS_KPE = WS_CKV + 16 * MiB;
constexpr size_t WS_QM = WS_R1;
constexpr size_t WS_KV = WS_R1 + 96 * MiB;
constexpr size_t WS_VMLA = WS_R1 + 224 * MiB;
constexpr size_t WS_KN = WS_R1 + 96 * MiB;
constexpr size_t WS_O = WS_R1;
constexpr size_t WS_H = WS_R1;
constexpr size_t WS_E = WS_R1, WS_G = WS_R1 + 128 * MiB;
constexpr size_t WS_END = 704 * MiB;
static_assert(WS_KPE + 2 * MiB <= WS_END && WS_H + (size_t)65536 * FF * 2 <= WS_END && WS_VMLA + 32 * MiB <= WS_QG, "d_ws map");

constexpr int LDS_BYTES = 147456;
static_assert(att::LDS_BYTES <= 131072, "attention LDS");

#define LAS __attribute__((address_space(3)))
typedef unsigned short bf16;
typedef unsigned v4u __attribute__((ext_vector_type(4)));
typedef unsigned v2u __attribute__((ext_vector_type(2)));
typedef float f32x4 __attribute__((ext_vector_type(4)));
__device__ __forceinline__ unsigned f2bf(float f) { unsigned u = __builtin_bit_cast(unsigned, f); return (u + 0x7fffu + ((u >> 16) & 1u)) >> 16; }
__device__ __forceinline__ unsigned pk2(float lo, float hi) { return f2bf(lo) | (f2bf(hi) << 16); }
__device__ __forceinline__ float bf2f(unsigned h) { return __builtin_bit_cast(float, h << 16); }
__device__ __forceinline__ float wave_sum(float v) {
#pragma unroll
    for (int o = 1; o < 64; o <<= 1) v += __shfl_xor(v, o);
    return v;
}
__device__ __forceinline__ float wave_max(float v) {
#pragma unroll
    for (int o = 1; o < 64; o <<= 1) v = fmaxf(v, __shfl_xor(v, o));
    return v;
}


#define GAS __attribute__((address_space(1)))
typedef GAS unsigned gu32;
#define RLX_AGENT __ATOMIC_RELAXED, __HIP_MEMORY_SCOPE_AGENT
#define XB_TMO      128
#define XB_XCNT(j)  (256  + 64 * (j))
#define XB_XSUB(j)  (1280 + 64 * (j))
#define XB_XGEN(j)  (2304 + 64 * (j))
#define XB_TOP      3328
#define XB_TOPGEN   3392
#define XCD_BAR_WORDS 3456
#define XB_SPIN_CAP (1u << 18)

__device__ __forceinline__ unsigned xb_ld(unsigned* p)              { return __hip_atomic_load(p, __ATOMIC_RELAXED, __HIP_MEMORY_SCOPE_AGENT); }
__device__ __forceinline__ unsigned xb_add(unsigned* p, unsigned v) { return __hip_atomic_fetch_add(p, v, __ATOMIC_RELAXED, __HIP_MEMORY_SCOPE_AGENT); }
__device__ __forceinline__ unsigned xb_xcc_id() { return (unsigned)__builtin_amdgcn_s_getreg((3 << 11) | 20) & 0xFu; }
#define XB_SPIN(cond, bar) do { unsigned _sp = 0; while (cond) { __builtin_amdgcn_s_sleep(1); \
    if ((++_sp & 255u) == 0u) { if (xb_ld(&(bar)[XB_TMO])) break; if (_sp > XB_SPIN_CAP) { atomicAdd(&(bar)[XB_TMO], 1u); break; } } } } while (0)

struct XcdBarrier {
    unsigned* bar; unsigned x; int w;
    volatile LAS unsigned* st;
};

__device__ __forceinline__ XcdBarrier xcd_barrier_post(unsigned* bar, volatile LAS unsigned* st, int w) {
    XcdBarrier b; b.bar = bar; b.x = xb_xcc_id(); b.st = st; b.w = w;
    if (w == 0 && fresh_lane() == 0) (void)xb_add(&bar[XB_XCNT(b.x)], 1u);
    return b;
}
__device__ __forceinline__ void xcd_barrier_complete(unsigned* bar, unsigned x, unsigned& nloc, unsigned& nx) {
    const unsigned G = gridDim.x * gridDim.y * gridDim.z;
    unsigned sum, cnt, mine, sp = 0u;
    for (;;) {
        sum = 0u; cnt = 0u; mine = 0u;
#pragma unroll
        for (unsigned j = 0; j < 16; ++j) { const unsigned c = xb_ld(&bar[XB_XCNT(j)]); sum += c; cnt += (c > 0u) ? 1u : 0u; mine = (j == x) ? c : mine; }
        if (sum == G) break;
        __builtin_amdgcn_s_sleep(1);
        if ((++sp & 255u) == 0u) { if (xb_ld(&bar[XB_TMO])) break; if (sp > XB_SPIN_CAP) { atomicAdd(&bar[XB_TMO], 1u); break; } }
    }
    nloc = mine > 0u ? mine : 1u; nx = cnt > 0u ? cnt : 1u;
}

__device__ __forceinline__ void xcd_barrier(const XcdBarrier& b) {
    asm volatile("s_waitcnt vmcnt(0)" ::: "memory");
    __syncthreads();
    if (b.w == 0 && fresh_lane() == 0) {
        unsigned* bar = b.bar;
        __builtin_amdgcn_s_waitcnt(0);
        unsigned nloc = b.st[0], nx = b.st[1];
        if (nloc == 0u) { xcd_barrier_complete(bar, b.x, nloc, nx); b.st[0] = nloc; b.st[1] = nx; }
        const unsigned old = xb_add(&bar[XB_XSUB(b.x)], 1u);
        const unsigned gen = old / nloc;
        if (old + 1u == (gen + 1u) * nloc) {
            __builtin_amdgcn_fence(__ATOMIC_RELEASE, "agent");
            asm volatile("s_waitcnt vmcnt(0)" ::: "memory");
            const unsigned og = xb_add(&bar[XB_TOP], 1u);
            const unsigned tg = og / nx;
            if (og + 1u == (tg + 1u) * nx) xb_add(&bar[XB_TOPGEN], 1u);
            else XB_SPIN(xb_ld(&bar[XB_TOPGEN]) == tg, bar);
            __builtin_amdgcn_fence(__ATOMIC_ACQUIRE, "agent");
            xb_add(&bar[XB_XGEN(b.x)], 1u);
            asm volatile("s_waitcnt vmcnt(0)" ::: "memory");
        } else {
            XB_SPIN(xb_ld(&bar[XB_XGEN(b.x)]) == gen, bar);
            __builtin_amdgcn_fence(__ATOMIC_ACQUIRE, "agent");
            asm volatile("s_waitcnt vmcnt(0)" ::: "memory");
        }
    }
    __syncthreads();
}
struct Args { const float* in[22]; float* out; unsigned char* ws; int ph_lo, ph_hi; };
enum { I_X = 0, I_P, I_WIN, I_QN, I_KN, I_CQN, I_CKVN, I_WUQ, I_WUKV, I_WOUT, I_LNAG, I_LNAB, I_WR, I_WG, I_WU, I_WD, I_LNFG, I_LNFB, I_WPP, I_WPG, I_LNPG, I_LNPB };

struct Frame { LAS unsigned char* lds; int tid, lane, wave, vcu, G; };

__device__ __forceinline__ void tr_item(const float* W, int N, int k0, int n0, bf16* WT, int K, long dst_row0, LAS float* scr, int lane, const float* kscale = nullptr, int nmode = 0) {
#pragma unroll 8
    for (int i = 0; i < 32; ++i) { const int kk = 2 * i + (lane >> 5); float v = W[(size_t)(k0 + kk) * N + n0 + (lane & 31)]; if (kscale) v *= kscale[k0 + kk]; scr[kk * 33 + (lane & 31)] = v; }
    asm volatile("s_waitcnt lgkmcnt(0)" ::: "memory");
    const int c = lane & 7;
#pragma unroll
    for (int j = 0; j < 4; ++j) { const int n = (lane >> 3) + 8 * j; const LAS float* s = scr + (8 * c) * 33 + n;
        v4u o; o.x = pk2(s[0 * 33], s[1 * 33]); o.y = pk2(s[2 * 33], s[3 * 33]); o.z = pk2(s[4 * 33], s[5 * 33]); o.w = pk2(s[6 * 33], s[7 * 33]);
        const int nd = nmode ? (16 * ((n >> 3) & 1) + 8 * (n >> 4) + (n & 7)) : n;
        *(v4u*)(WT + (size_t)(dst_row0 + nd) * K + k0 + 8 * c) = o; }
    asm volatile("s_waitcnt lgkmcnt(0)" ::: "memory");
}
__device__ __forceinline__ unsigned q4(float a, float b, float c, float d) { int w = __builtin_amdgcn_cvt_pk_fp8_f32(a * 32.0f, b * 32.0f, 0, false); w = __builtin_amdgcn_cvt_pk_fp8_f32(c * 32.0f, d * 32.0f, w, true); return (unsigned)w; }
__device__ __forceinline__ void tr_item8(const float* W, int N, int k0, int n0, unsigned char* WT, int K, long dst_row0, LAS float* scr, int lane) {
#pragma unroll 8
    for (int i = 0; i < 32; ++i) { const int kk = 2 * i + (lane >> 5); scr[kk * 33 + (lane & 31)] = W[(size_t)(k0 + kk) * N + n0 + (lane & 31)]; }
    asm volatile("s_waitcnt lgkmcnt(0)" ::: "memory");
    const int c = lane & 7;
#pragma unroll
    for (int j = 0; j < 4; ++j) { const int n = (lane >> 3) + 8 * j; const LAS float* s = scr + (8 * c) * 33 + n;
        v2u o; o.x = q4(s[0 * 33], s[1 * 33], s[2 * 33], s[3 * 33]); o.y = q4(s[4 * 33], s[5 * 33], s[6 * 33], s[7 * 33]);
        *(v2u*)(WT + (size_t)(dst_row0 + n) * K + k0 + 8 * c) = o; }
    asm volatile("s_waitcnt lgkmcnt(0)" ::: "memory");
}
__device__ __forceinline__ void tr_dense(const float* W, int K, int N, bf16* WT, int r, LAS float* scr, int lane, const float* kscale = nullptr) {
    const int nblk = N / 32, kb = r / nblk, nb = r % nblk; tr_item(W, N, 64 * kb, 32 * nb, WT, K, 32 * nb, scr, lane, kscale);
}
__device__ __forceinline__ void p0_convert(const Frame& F, const Args& a) {
    LAS float* scr = (LAS float*)(F.lds + F.wave * 16384);
    const int gw = F.vcu * NWAVES + F.wave, NGW = F.G * NWAVES;
    unsigned char* ws = a.ws;
    constexpr int I_IN = (DM / 64) * (INW / 32), I_UQ = (256 / 64) * (UQW / 32), I_UKV = (256 / 64) * (UKVW / 32), I_OUT = (DM / 64) * (DM / 32), I_PG = I_OUT, I_PP = (PLE / 64) * (DM / 32);
    constexpr int I_GE = (DM / 64) * (FF / 32), I_DE = (FF / 64) * (DM / 32);
    constexpr int NITEMS = I_IN + I_UQ + I_UKV + I_OUT + I_PG + I_PP + 2 * NE * I_GE + NE * I_DE;
    for (int it = gw; it < NITEMS; it += NGW) {
        int r = it;
        if (r < I_IN) {
            const int nblk = INW / 32, kb = r / nblk, nb = r % nblk, n0 = 32 * nb, pn = n0 >> 8, cw = n0 & 255;
            const int d0 = (pn <= 2) ? 256 * pn + ((cw >> 5) & 1) * 128 + (cw >> 6) * 32 : n0;
            tr_item(a.in[I_WIN], INW, 64 * kb, n0, (bf16*)(ws + WS_WIN), DM, d0, scr, F.lane, nullptr, pn == 5 ? 1 : 0); continue; } r -= I_IN;
        if (r < I_UQ) {
            const int nblk = UQW / 32, kb = r / nblk, nb = r % nblk, n0 = 32 * nb, head = n0 / 96, off = n0 % 96;
            const int d0 = (off < 64) ? (head >> 2) * 256 + (head & 3) * 64 + off : 512 + head * 32;
            tr_item(a.in[I_WUQ], UQW, 64 * kb, n0, (bf16*)(ws + WS_WUQ), 256, d0, scr, F.lane, a.in[I_CQN], off < 64 ? 0 : 1); continue; } r -= I_UQ;
        if (r < I_UKV) { tr_dense(a.in[I_WUKV], 256, UKVW, (bf16*)(ws + WS_WUKV), r, scr, F.lane, a.in[I_CKVN]); continue; } r -= I_UKV;
        if (r < I_OUT) { tr_dense(a.in[I_WOUT], DM, DM, (bf16*)(ws + WS_WOUT), r, scr, F.lane); continue; } r -= I_OUT;
        if (r < I_PG) { tr_dense(a.in[I_WPG], DM, DM, (bf16*)(ws + WS_WPG), r, scr, F.lane); continue; } r -= I_PG;
        if (r < I_PP) { tr_dense(a.in[I_WPP], PLE, DM, (bf16*)(ws + WS_WPP), r, scr, F.lane); continue; } r -= I_PP;
        if (r < 2 * NE * I_GE) {
            const int which = r / (NE * I_GE); r -= which * NE * I_GE; const int e = r / I_GE; r -= e * I_GE;
            const int nblk = FF / 32, kb = r / nblk, nb = r % nblk, n0 = 32 * nb;
            const float* W = a.in[which ? I_WU : I_WG] + (size_t)e * DM * FF;
            tr_item8(W, FF, 64 * kb, n0, ws + WS_WGU, DM, (long)e * (2 * FF) + (n0 / 128) * 256 + (n0 % 128) + (which ? 128 : 0), scr, F.lane); continue; }
        r -= 2 * NE * I_GE;
        { const int e = r / I_DE; r -= e * I_DE; const int nblk = DM / 32, kb = r / nblk, nb = r % nblk;
          tr_item8(a.in[I_WD] + (size_t)e * FF * DM, DM, 64 * kb, 32 * nb, ws + WS_WDN, FF, (long)e * DM + 32 * nb, scr, F.lane); }
    }
    { v4u* z = (v4u*)(ws + WS_WIN + (size_t)INW * DM * 2); const int n16 = (INWP - INW) * DM * 2 / 16;
      for (int i = (F.vcu * NWAVES + F.wave) * 64 + F.lane; i < n16; i += NGW * 64) z[i] = (v4u){0u, 0u, 0u, 0u}; }
    { float* wrt = (float*)(ws + WS_WRT); const float* wr = a.in[I_WR];
      for (int i = (F.vcu * NWAVES + F.wave) * 64 + F.lane; i < NE * DM; i += NGW * 64) { const int e = i / DM, k = i % DM; wrt[i] = wr[k * NE + e]; } }
    { const float* x = a.in[I_X]; bf16* xb = (bf16*)(ws + WS_XB);
      for (int m = gw; m < T; m += NGW) { const f32x4* xr = (const f32x4*)(x + (size_t)m * DM) + F.lane; v2u* o = (v2u*)(xb + (size_t)m * DM) + F.lane;
#pragma unroll
          for (int j = 0; j < 4; ++j) { const f32x4 v = xr[64 * j]; o[64 * j] = (v2u){pk2(v.x, v.y), pk2(v.z, v.w)}; } } }
}

__device__ __forceinline__ void p_attention(const Frame& F, const Args& a) {
    unsigned char* ws = a.ws; char* lds = (char*)F.lds;
    const bf16* QG = (const bf16*)(ws + WS_QG); const bf16* KG = (const bf16*)(ws + WS_KG); const bf16* VG = (const bf16*)(ws + WS_VG);
    const bf16* QMLA = (const bf16*)(ws + WS_QMLA); const bf16* KN = (const bf16*)(ws + WS_KN); const bf16* KPE = (const bf16*)(ws + WS_KPE); const bf16* VMLA = (const bf16*)(ws + WS_VMLA);
    bf16* O = (bf16*)(ws + WS_O);
    for (int U = F.vcu; U < 2048; U += F.G) {
        if (U < 1024) { const int qb = U & 7, hq = (U >> 3) & 7, kvh = hq >> 2, b = U >> 6; const size_t r0 = (size_t)b * SEQ + qb * 256;
            att::attn_unit<64>(QG + r0 * 512 + hq * 64, 512, KG + (size_t)b * SEQ * 128 + kvh * 64, 128, KG, 128, VG + (size_t)b * SEQ * 128 + kvh * 64, 128, O + r0 * 1024 + hq * 64, 1024, lds, F.wave); }
        else { const int V = U - 1024, qb = V & 7, h = (V >> 3) & 7, b = V >> 6; const size_t r0 = (size_t)b * SEQ + qb * 256;
            att::attn_unit<96>(QMLA + r0 * 768 + h * 96, 768, KN + (size_t)b * SEQ * 512 + h * 64, 512, KPE + (size_t)b * SEQ * 32, 32, VMLA + (size_t)b * SEQ * 512 + h * 64, 512, O + r0 * 1024 + 512 + h * 64, 1024, lds, F.wave); }
    }
}
__device__ __forceinline__ void ln_row(f32x4 (&v)[4], const float* g, const float* bta, int lane) {
    float s = 0.f;
#pragma unroll
    for (int j = 0; j < 4; ++j) s += (v[j].x + v[j].y) + (v[j].z + v[j].w);
    const float mean = wave_sum(s) * (1.f / DM); float s2 = 0.f;
#pragma unroll
    for (int j = 0; j < 4; ++j) { v[j] = v[j] - mean; s2 += (v[j].x * v[j].x + v[j].y * v[j].y) + (v[j].z * v[j].z + v[j].w * v[j].w); }
    const float rstd = 1.f / sqrtf(wave_sum(s2) * (1.f / DM) + LN_EPS);
#pragma unroll
    for (int j = 0; j < 4; ++j) { const f32x4 gg = *((const f32x4*)g + lane + 64 * j), bb = *((const f32x4*)bta + lane + 64 * j); v[j] = v[j] * rstd * gg + bb; }
}
__device__ __forceinline__ void p7_ln1_router(const Frame& F, const Args& a) {
    const int gw = F.vcu * NWAVES + F.wave, NGW = F.G * NWAVES, l = F.lane;
    unsigned char* ws = a.ws; float* xo = a.out; unsigned char* x1q = ws + WS_X1B; float* aff = (float*)(ws + WS_AFF);
    { const f32x4* wg = (const f32x4*)(ws + WS_WRT); LAS f32x4* wl = (LAS f32x4*)F.lds;
      for (int i = F.tid; i < NE * DM / 4; i += NWAVES * 64) wl[i] = wg[i];
      __syncthreads(); }
    const LAS f32x4* wrt = (const LAS f32x4*)F.lds;
    for (int m = gw; m < T; m += NGW) {
        f32x4 v[4];
#pragma unroll
        for (int j = 0; j < 4; ++j) v[j] = *((const f32x4*)(xo + (size_t)m * DM) + l + 64 * j);
        ln_row(v, a.in[I_LNAG], a.in[I_LNAB], l);
#pragma unroll
        for (int j = 0; j < 4; ++j) { *((f32x4*)(xo + (size_t)m * DM) + l + 64 * j) = v[j]; *((unsigned*)(x1q + (size_t)m * DM) + l + 64 * j) = pg8::pk4_fp8(v[j].x, v[j].y, v[j].z, v[j].w); }
        float lg[NE]; float mx = -1e30f;
#pragma unroll
        for (int e = 0; e < NE; ++e) { float s = 0.f;
#pragma unroll
            for (int j = 0; j < 4; ++j) { const f32x4 w = wrt[e * (DM / 4) + l + 64 * j]; s += (v[j].x * w.x + v[j].y * w.y) + (v[j].z * w.z + v[j].w * w.w); }
            lg[e] = wave_sum(s); mx = fmaxf(mx, lg[e]); if ((e & 3) == 3) asm volatile("" ::: "memory"); }
        float den = 0.f;
#pragma unroll
        for (int e = 0; e < NE; ++e) { lg[e] = expf(lg[e] - mx); den += lg[e]; }
        const float inv = 1.0f / den; float mine = 0.f;
#pragma unroll
        for (int e = 0; e < NE; ++e) mine = (l == e) ? lg[e] * inv : mine;
        const int b = m >> 11, s_ = m & (SEQ - 1);
        if (l < NE) aff[((size_t)b * NE + l) * SEQ + s_] = mine;
    }
}
__device__ __forceinline__ unsigned block_excl_scan(const Frame& F, unsigned cnt, LAS unsigned* wsum, unsigned& total) {
    unsigned inc = cnt;
#pragma unroll
    for (int o = 1; o < 64; o <<= 1) { const unsigned t = __shfl_up(inc, o); if (F.lane >= o) inc += t; }
    __syncthreads();
    if (F.lane == 63) wsum[F.wave] = inc;
    __syncthreads();
    unsigned base = 0, tot = 0;
#pragma unroll
    for (int w = 0; w < NWAVES; ++w) { const unsigned s = wsum[w]; if (w < F.wave) base += s; tot += s; }
    total = tot; return base + inc - cnt;
}
__device__ __forceinline__ void p8_topk(const Frame& F, const Args& a) {
    unsigned char* ws = a.ws; const float* aff = (const float*)(ws + WS_AFF);
    int* rowmap = (int*)(ws + WS_ROWMAP); float* gval = (float*)(ws + WS_GVAL); int* sel = (int*)(ws + WS_SEL);
    LAS unsigned* hist = (LAS unsigned*)F.lds; LAS unsigned* wsum = hist + 256; LAS unsigned* bc = hist + 272;
    for (int task = F.vcu; task < NB * NE; task += F.G) {
        const int b = task / NE, e = task % NE;
        const f32x4 vv = *((const f32x4*)(aff + (size_t)task * SEQ) + F.tid);
        const float vf[4] = {vv.x, vv.y, vv.z, vv.w}; unsigned u[4];
#pragma unroll
        for (int i = 0; i < 4; ++i) u[i] = __builtin_bit_cast(unsigned, vf[i]);
        unsigned prefix = 0, kneed = CAP;
#pragma unroll 1
        for (int pass = 0; pass < 4; ++pass) {
            const int shift = 24 - 8 * pass;
            __syncthreads();
            if (F.tid < 256) hist[F.tid] = 0u;
            __syncthreads();
#pragma unroll
            for (int i = 0; i < 4; ++i) { const bool in = (pass == 0) || ((u[i] >> (shift + 8)) == prefix); if (in) atomicAdd((unsigned*)&hist[(u[i] >> shift) & 255u], 1u); }
            __syncthreads();
            if (F.wave == 0) {
                unsigned h0 = hist[4 * F.lane], h1 = hist[4 * F.lane + 1], h2 = hist[4 * F.lane + 2], h3 = hist[4 * F.lane + 3];
                const unsigned tl = h0 + h1 + h2 + h3; unsigned suf = tl;
#pragma unroll
                for (int o = 1; o < 64; o <<= 1) { const unsigned t = __shfl_down(suf, o); if (F.lane + o < 64) suf += t; }
                const unsigned above = suf - tl;
                const unsigned a3 = above, a2 = above + h3, a1 = a2 + h2, a0 = a1 + h1;
                int found = -1; unsigned nk = 0;
                if (a3 < kneed && kneed <= a3 + h3) { found = 4 * F.lane + 3; nk = kneed - a3; }
                else if (a2 < kneed && kneed <= a2 + h2) { found = 4 * F.lane + 2; nk = kneed - a2; }
                else if (a1 < kneed && kneed <= a1 + h1) { found = 4 * F.lane + 1; nk = kneed - a1; }
                else if (a0 < kneed && kneed <= a0 + h0) { found = 4 * F.lane; nk = kneed - a0; }
                if (found >= 0) { bc[0] = (unsigned)found; bc[1] = nk; }
            }
            __syncthreads();
            prefix = (prefix << 8) | bc[0]; kneed = bc[1];
        }
        unsigned ceq = 0;
#pragma unroll
        for (int i = 0; i < 4; ++i) ceq += (u[i] == prefix) ? 1u : 0u;
        unsigned tot; unsigned eqbase = block_excl_scan(F, ceq, wsum, tot);
        bool take[4]; unsigned csel = 0;
#pragma unroll
        for (int i = 0; i < 4; ++i) { const bool eq = (u[i] == prefix); take[i] = (u[i] > prefix) || (eq && eqbase < kneed); if (eq) ++eqbase; csel += take[i] ? 1u : 0u; }
        unsigned slot = block_excl_scan(F, csel, wsum, tot);
#pragma unroll
        for (int i = 0; i < 4; ++i) { const int tkn = F.tid * 4 + i; int sv = -1;
            if (take[i]) { sv = (int)slot; const size_t r = (size_t)e * (NB * CAP) + b * CAP + slot; rowmap[r] = b * SEQ + tkn; gval[r] = vf[i]; ++slot; }
            sel[((size_t)b * SEQ + tkn) * NE + e] = sv; }
    }
}
__device__ __forceinline__ void p11_ln2(const Frame& F, const Args& a) {
    const int gw = F.vcu * NWAVES + F.wave, NGW = F.G * NWAVES, l = F.lane;
    unsigned char* ws = a.ws; float* xo = a.out; bf16* x2b = (bf16*)(ws + WS_X1B); const bf16* yexp = (const bf16*)(ws + WS_YEXP); const int* sel = (const int*)(ws + WS_SEL);
    const float* p = a.in[I_P]; bf16* pb = (bf16*)(ws + WS_PB);
    for (int m = gw; m < T; m += NGW) {
        const int b = m >> 11;
        f32x4 v[4];
#pragma unroll
        for (int j = 0; j < 4; ++j) v[j] = *((const f32x4*)(xo + (size_t)m * DM) + l + 64 * j) * ALPHA;
        const int sv = (l < NE) ? sel[(size_t)m * NE + l] : -1;
#pragma unroll 1
        for (int e = 0; e < NE; ++e) { const int c = __shfl(sv, e); if (c >= 0) { const bf16* yr = yexp + ((size_t)e * (NB * CAP) + b * CAP + c) * DM;
#pragma unroll
            for (int j = 0; j < 4; ++j) { const v2u w = *((const v2u*)yr + l + 64 * j); v[j].x += bf2f(w.x & 0xffffu); v[j].y += bf2f(w.x >> 16); v[j].z += bf2f(w.y & 0xffffu); v[j].w += bf2f(w.y >> 16); } } }
        ln_row(v, a.in[I_LNFG], a.in[I_LNFB], l);
#pragma unroll
        for (int j = 0; j < 4; ++j) { *((f32x4*)(xo + (size_t)m * DM) + l + 64 * j) = v[j]; *((v2u*)(x2b + (size_t)m * DM) + l + 64 * j) = (v2u){pk2(v[j].x, v[j].y), pk2(v[j].z, v[j].w)}; }
        { const f32x4 pv = *((const f32x4*)(p + (size_t)m * PLE) + l); *((v2u*)(pb + (size_t)m * PLE) + l) = (v2u){pk2(pv.x, pv.y), pk2(pv.z, pv.w)}; }
    }
}
__device__ __forceinline__ void p13_ln3(const Frame& F, const Args& a) {
    const int gw = F.vcu * NWAVES + F.wave, NGW = F.G * NWAVES, l = F.lane;
    float* xo = a.out;
    for (int m = gw; m < T; m += NGW) {
        f32x4 v[4];
#pragma unroll
        for (int j = 0; j < 4; ++j) v[j] = *((const f32x4*)(xo + (size_t)m * DM) + l + 64 * j);
        ln_row(v, a.in[I_LNPG], a.in[I_LNPB], l);
#pragma unroll
        for (int j = 0; j < 4; ++j) *((f32x4*)(xo + (size_t)m * DM) + l + 64 * j) = v[j];
    }
}

__global__ void __launch_bounds__(NWAVES * 64, 2) fwd(Args args) {
    extern __shared__ __attribute__((aligned(16))) unsigned char lds[];
    Frame F;
    F.lds = (LAS unsigned char*)lds; F.wave = __builtin_amdgcn_readfirstlane(threadIdx.x >> 6); F.lane = fresh_lane(); F.tid = F.wave * 64 + F.lane;
    F.G = gridDim.x; { const int bx = blockIdx.x; F.vcu = (F.G % 8 == 0) ? (bx % 8) * (F.G / 8) + bx / 8 : bx; }
    unsigned char* ws = args.ws;
    const int lo = args.ph_lo, hi = args.ph_hi;
#define IN(k) (lo <= (k) && (k) < hi)
    volatile LAS unsigned* MISC = (volatile LAS unsigned*)(F.lds + 131072 + 320);
    for (int u = F.tid; u < 256; u += NWAVES * 64) ((LAS unsigned*)(F.lds + 131072))[u] = 0u;
    for (int u = F.tid; u < 1024 + 512; u += NWAVES * 64) {
        const bool big = u < 1024; const int v = big ? u : u - 1024, pos = big ? (v >> 4) : (v >> 3), i = big ? (v & 15) : (v & 7);
        float rev = (float)pos * exp2f(-(float)i * (big ? pg8::kLog2Base / 16.0f : pg8::kLog2Base / 8.0f)) * pg8::kInv2Pi; rev = rev - floorf(rev);
        *(LAS float*)(F.lds + (big ? pg8::TAB_COS64 : pg8::TAB_COS32) + v * 4) = __builtin_amdgcn_cosf(rev);
        *(LAS float*)(F.lds + (big ? pg8::TAB_SIN64 : pg8::TAB_SIN32) + v * 4) = __builtin_amdgcn_sinf(rev); }
    __syncthreads();
    XcdBarrier bar; bar.bar = (unsigned*)(ws + WS_CTL) + 4096; bar.x = 0; bar.st = nullptr; bar.w = F.wave;
    if (hi - lo > 1) bar = xcd_barrier_post((unsigned*)(ws + WS_CTL) + 4096, MISC + 8, F.wave);
#ifndef PROBE_MASK
#define PROBE_MASK 0
#endif
#if PROBE_MASK
#define PHASE(k) for (int rep_ = 0; rep_ < (IN(k) ? ((((PROBE_MASK) >> (k)) & 1) ? 2 : 1) : 0); ++rep_, (((PROBE_MASK >> (k)) & 1) ? xcd_barrier(bar) : (void)0))
#else
#define PHASE(k) if (IN(k) && (F.lane = fresh_lane(), F.tid = F.wave * 64 + F.lane, true))
#endif
#define SEAM(k) do { if (IN(k) && IN((k) + 1)) xcd_barrier(bar); } while (0)
    PHASE(0) p0_convert(F, args);
    SEAM(0);
    PHASE(1) { pg8::Gemm g{(const bf16*)(ws + WS_XB), (const bf16*)(ws + WS_WIN), T, INWP, DM}; pg8::StaticOrder S; S.init(T, INWP, F.G, (int)blockIdx.x);
        pg8::EpiProj E{(bf16*)(ws + WS_QG), (bf16*)(ws + WS_KG), (bf16*)(ws + WS_VG), (bf16*)(ws + WS_CQ), (bf16*)(ws + WS_CKV), (bf16*)(ws + WS_KPE), (float*)(ws + WS_SSQ), (float*)(ws + WS_SSKV), args.in[I_QN], args.in[I_KN], F.lds};
        pg8::gemm_phase<pg8::EpiProj, pg8::StaticOrder, true>(F.lds, g, S, E, F.wave); }
    SEAM(1);
    PHASE(2) {
        { pg8::Gemm g{(const bf16*)(ws + WS_CQ), (const bf16*)(ws + WS_WUQ), T, UQW, 256}; pg8::StaticOrder S; S.init(T, UQW, F.G, (int)blockIdx.x);
          pg8::EpiMlaQ E{(bf16*)(ws + WS_QMLA), (const float*)(ws + WS_SSQ), F.lds}; pg8::gemm_phase<pg8::EpiMlaQ, pg8::StaticOrder, true>(F.lds, g, S, E, F.wave); }
        { pg8::Gemm g{(const bf16*)(ws + WS_CKV), (const bf16*)(ws + WS_WUKV), T, UKVW, 256}; pg8::StaticOrder S; S.init(T, UKVW, F.G, (int)blockIdx.x);
          pg8::EpiMlaKV E{(bf16*)(ws + WS_KN), (bf16*)(ws + WS_VMLA), (const float*)(ws + WS_SSKV)}; pg8::gemm_phase<pg8::EpiMlaKV, pg8::StaticOrder, true>(F.lds, g, S, E, F.wave); }
    }
    SEAM(2);
    PHASE(3) p_attention(F, args);
    SEAM(3);
    PHASE(4) { pg8::Gemm g{(const bf16*)(ws + WS_O), (const bf16*)(ws + WS_WOUT), T, DM, DM}; pg8::StaticOrder S; S.init(T, DM, F.G, (int)blockIdx.x);
        pg8::EpiResid E{args.out, args.in[I_X], DM}; pg8::gemm_phase<pg8::EpiResid, pg8::StaticOrder, true>(F.lds, g, S, E, F.wave); }
    SEAM(4);
    PHASE(5) p7_ln1_router(F, args);
    SEAM(5);
    PHASE(6) p8_topk(F, args);
    SEAM(6);
    PHASE(7) { pg8::Gemm g{(const bf16*)(ws + WS_X1B), (const bf16*)(ws + WS_WGU), NE * NB * CAP, 2 * FF, DM / 2}; pg8::GatherOrder S; S.init(NE * NB * CAP, 2 * FF, F.G, (int)blockIdx.x, NB * CAP / 256); S.rowmap = (const int*)(ws + WS_ROWMAP);
        pg8::EpiSwiGLU8 E{ws + WS_H, FF}; pg8::gemm_phase<pg8::EpiSwiGLU8, pg8::GatherOrder, true, true>(F.lds, g, S, E, F.wave); }
    SEAM(7);
    PHASE(8) { pg8::Gemm g{(const bf16*)(ws + WS_H), (const bf16*)(ws + WS_WDN), NE * NB * CAP, DM, FF / 2}; pg8::StaticOrder S; S.init(NE * NB * CAP, DM, F.G, (int)blockIdx.x, NB * CAP / 256);
        pg8::EpiRowScaleBf16 E{(bf16*)(ws + WS_YEXP), DM, (const float*)(ws + WS_GVAL), 1.0f / 256.0f}; pg8::gemm_phase<pg8::EpiRowScaleBf16, pg8::StaticOrder, true, true>(F.lds, g, S, E, F.wave); }
    SEAM(8);
    PHASE(9) p11_ln2(F, args);
    SEAM(9);
    PHASE(10) {
        { pg8::Gemm g{(const bf16*)(ws + WS_PB), (const bf16*)(ws + WS_WPP), T, DM, PLE}; pg8::StaticOrder S; S.init(T, DM, F.G, (int)blockIdx.x);
          pg8::EpiF32 E{(float*)(ws + WS_E), DM}; pg8::gemm_phase<pg8::EpiF32, pg8::StaticOrder, true>(F.lds, g, S, E, F.wave); }
        { pg8::Gemm g{(const bf16*)(ws + WS_X1B), (const bf16*)(ws + WS_WPG), T, DM, DM}; pg8::StaticOrder S; S.init(T, DM, F.G, (int)blockIdx.x);
          pg8::EpiPle E{args.out, (const float*)(ws + WS_E), DM}; pg8::gemm_phase<pg8::EpiPle, pg8::StaticOrder, true>(F.lds, g, S, E, F.wave); }
    }
    SEAM(10);
    PHASE(11) p13_ln3(F, args);
#undef IN
#undef SEAM
}

constexpr int NPHASES = 12;
extern "C" void kernel_launch(void* const* d_in, const int* in_sizes, int n_in, void* d_out, int out_size, void* d_ws, size_t ws_size, hipStream_t stream) {
    static int grid = 0;
    if (grid == 0) {
        if (n_in != 22 || in_sizes[0] != T * DM || out_size != T * DM || ws_size < WS_END) { fprintf(stderr, "kernel_launch: unexpected shapes (n_in %d, in0 %d, out %d, ws %zu < %zu?)\n", n_in, n_in > 0 ? in_sizes[0] : -1, out_size, ws_size, (size_t)WS_END); grid = -1; return; }
        if (hipFuncSetAttribute((const void*)fwd, hipFuncAttributeMaxDynamicSharedMemorySize, LDS_BYTES) != hipSuccess) { fprintf(stderr, "kernel_launch: hipFuncSetAttribute failed\n"); grid = -1; return; }
        int dev = 0, cus = 0, per_cu = 0;
        if (hipGetDevice(&dev) != hipSuccess || hipDeviceGetAttribute(&cus, hipDeviceAttributeMultiprocessorCount, dev) != hipSuccess) { fprintf(stderr, "kernel_launch: device query failed\n"); grid = -1; return; }
        if (hipOccupancyMaxActiveBlocksPerMultiprocessor(&per_cu, (const void*)fwd, NWAVES * 64, LDS_BYTES) != hipSuccess || per_cu < 1) { fprintf(stderr, "kernel_launch: occupancy query says %d blocks per CU\n", per_cu); (void)hipGetLastError(); grid = -1; return; }
        grid = cus;
    }
    if (grid < 0) return;
    Args a{};
    for (int i = 0; i < 22; ++i) a.in[i] = (const float*)d_in[i];
    a.out = (float*)d_out; a.ws = (unsigned char*)d_ws;
#if MK_ONE_LAUNCH
    hipMemsetAsync((char*)d_ws + WS_CTL, 0, 65536, stream);
    a.ph_lo = 0; a.ph_hi = NPHASES;
    hipLaunchKernelGGL(fwd, dim3(grid), dim3(NWAVES * 64), LDS_BYTES, stream, a);
#else
    for (int ph = 0; ph < NPHASES; ++ph) {
        a.ph_lo = ph; a.ph_hi = ph + 1;
        hipLaunchKernelGGL(fwd, dim3(grid), dim3(NWAVES * 64), LDS_BYTES, stream, a);
    }
#endif
}
```

```cpp
#include <hip/hip_runtime.h>
#include <cstdio>
#include <cstdint>

#ifndef MK_ONE_LAUNCH
#define MK_ONE_LAUNCH 1
#endif

__device__ __forceinline__ int fresh_lane() { int l = (int)__builtin_amdgcn_mbcnt_hi(~0u, __builtin_amdgcn_mbcnt_lo(~0u, 0u)); asm volatile("" : "+v"(l)); return l; }
namespace pg8 {
#define PG8_LAS __attribute__((address_space(3)))
typedef unsigned short bf16_t;
typedef short bf16x8 __attribute__((ext_vector_type(8)));
typedef float f32x4 __attribute__((ext_vector_type(4)));
typedef unsigned u32x4 __attribute__((ext_vector_type(4)));
typedef unsigned u32x2 __attribute__((ext_vector_type(2)));
constexpr int BM = 256, BK = 64, HALF = 128, HTB = HALF * BK * 2  , STAGE_BYTES = 8 * HTB, NXCD = 8, WGM = 8;

__host__ __device__ __forceinline__ int lds_byte(int r, int c) { const int st = (r >> 4) * 2 + (c >> 5), rr = r & 15, cc = c & 31, ob = rr * 64 + cc * 2; return st * 1024 + (ob ^ (((ob >> 9) & 1) << 5)); }
__host__ __device__ __forceinline__ void stage_rc(int b, int& R, int& C) { const int st = b / 1024, sb = b % 1024, swz = sb ^ (((sb >> 9) & 1) << 5); R = (st >> 1) * 16 + swz / 64; C = (st & 1) * 32 + (swz % 64) / 2; }
__host__ __device__ __forceinline__ int perm32(int rho) { const int n = rho >> 4, i = rho & 15; return 8 * (i >> 2) + 4 * n + (i & 3); }

struct Unit { int pm, pn; };
struct Gemm { const bf16_t* A; const bf16_t* Bt; int M, N, K; };

struct StaticOrder {
    static constexpr bool GATHER = false;
    int nM, nN, nwg, G, c, mpe;
    __host__ __device__ void init(int M, int N, int G_, int c_, int mpe_ = 0) { nM = M / BM; nN = N / BM; nwg = nM * nN; G = G_; c = c_; mpe = mpe_; }
    __host__ __device__ bool next(int i, Unit& u) const {
        const long L = (long)i * G + c; if (L >= nwg) return false;
        int wgid = (int)L; { const int q = nwg / NXCD, r = nwg % NXCD, xcd = wgid % NXCD, off = wgid / NXCD; wgid = (xcd < r ? xcd * (q + 1) : r * (q + 1) + (xcd - r) * q) + off; }
        const int nig = WGM * nN, gid = wgid / nig, fm = gid * WGM, gsz = (nM - fm) < WGM ? (nM - fm) : WGM;
        u.pm = fm + ((wgid % nig) % gsz); u.pn = (wgid % nig) / gsz; return true;
    }
    __host__ __device__ __forceinline__ int btile(const Unit& u) const { return mpe ? (u.pm / mpe) * nN + u.pn : u.pn; }
    __device__ __forceinline__ unsigned arow(const Unit&, int) const { return 0u; }
};
struct GatherOrder : StaticOrder {
    static constexpr bool GATHER = true;
    const int* rowmap;
    __device__ __forceinline__ unsigned arow(const Unit& u, int r) const { return (unsigned)rowmap[u.pm * BM + r]; }
};

__device__ __forceinline__ unsigned cvt_pk_bf16(float lo, float hi) { unsigned r; asm volatile("v_cvt_pk_bf16_f32 %0, %1, %2" : "=v"(r) : "v"(lo), "v"(hi)); return r; }

struct EpiF32 {
    static constexpr bool PERM = false;
    float* O; int ldc;
    __device__ __forceinline__ void operator()(const f32x4 (&acc)[2][2][4][2], const Unit& u, int wr, int wc, int fr, int fq) const {
        { const int l_ = fresh_lane(); fr = l_ & 15; fq = l_ >> 4; }
        const int row0 = u.pm * BM + wr * 64 + fr, col0 = u.pn * BM + wc * 32 + 4 * fq;
#pragma unroll
        for (int ai = 0; ai < 2; ++ai)
#pragma unroll
            for (int m = 0; m < 4; ++m) { float* rowp = O + (size_t)(row0 + ai * HALF + m * 16) * ldc + col0;
#pragma unroll
                for (int bj = 0; bj < 2; ++bj)
#pragma unroll
                    for (int n = 0; n < 2; ++n) *(f32x4*)(rowp + bj * HALF + n * 16) = acc[ai][bj][m][n]; }
    }
};
struct EpiSwiGLU {
    static constexpr bool PERM = false;
    bf16_t* H; int ldh;
    __device__ __forceinline__ void operator()(const f32x4 (&acc)[2][2][4][2], const Unit& u, int wr, int wc, int fr, int fq) const {
        { const int l_ = fresh_lane(); fr = l_ & 15; fq = l_ >> 4; }
        const int row0 = u.pm * BM + wr * 64 + fr, col0 = u.pn * HALF + wc * 32 + 4 * fq;
#pragma unroll
        for (int ai = 0; ai < 2; ++ai)
#pragma unroll
            for (int m = 0; m < 4; ++m) { bf16_t* rowp = H + (size_t)(row0 + ai * HALF + m * 16) * ldh + col0;
#pragma unroll
                for (int n = 0; n < 2; ++n) { const f32x4 g = acc[ai][0][m][n], up = acc[ai][1][m][n]; float h[4];
#pragma unroll
                    for (int j = 0; j < 4; ++j) { const float s = __builtin_amdgcn_rcpf(1.0f + __builtin_amdgcn_exp2f(-1.4426950408889634f * g[j])); h[j] = g[j] * s * up[j]; }
                    u32x2 w; w.x = cvt_pk_bf16(h[0], h[1]); w.y = cvt_pk_bf16(h[2], h[3]); *(u32x2*)(rowp + n * 16) = w; } }
    }
};
__device__ __forceinline__ unsigned pk4_fp8(float a, float b, float c, float d) { int w = __builtin_amdgcn_cvt_pk_fp8_f32(a, b, 0, false); w = __builtin_amdgcn_cvt_pk_fp8_f32(c, d, w, true); return (unsigned)w; }
struct EpiSwiGLU8 {
    static constexpr bool PERM = true;
    unsigned char* H; int ldh;
    __device__ __forceinline__ void operator()(const f32x4 (&acc)[2][2][4][2], const Unit& u, int wr, int wc, int fr, int fq) const {
        { const int l_ = fresh_lane(); fr = l_ & 15; fq = l_ >> 4; }
        const int row0 = u.pm * BM + wr * 64 + fr, col0 = u.pn * HALF + wc * 32 + 8 * fq;
#pragma unroll
        for (int ai = 0; ai < 2; ++ai)
#pragma unroll
            for (int m = 0; m < 4; ++m) { unsigned char* rowp = H + (size_t)(row0 + ai * HALF + m * 16) * ldh + col0; float h[2][4];
#pragma unroll
                for (int n = 0; n < 2; ++n) { const f32x4 g = acc[ai][0][m][n], up = acc[ai][1][m][n];
#pragma unroll
                    for (int j = 0; j < 4; ++j) { const float gg = g[j] * 0.03125f; const float s = __builtin_amdgcn_rcpf(1.0f + __builtin_amdgcn_exp2f(-1.4426950408889634f * gg)); h[n][j] = gg * s * up[j] * 0.25f; } }
                u32x2 w; w.x = pk4_fp8(h[0][0], h[0][1], h[0][2], h[0][3]); w.y = pk4_fp8(h[1][0], h[1][1], h[1][2], h[1][3]); *(u32x2*)rowp = w; }
    }
};
struct EpiRowScaleBf16 {
    static constexpr bool PERM = false;
    bf16_t* O; int ldc; const float* rs; float mul;
    __device__ __forceinline__ void operator()(const f32x4 (&acc)[2][2][4][2], const Unit& u, int wr, int wc, int fr, int fq) const {
        { const int l_ = fresh_lane(); fr = l_ & 15; fq = l_ >> 4; }
        const int row0 = u.pm * BM + wr * 64 + fr, col0 = u.pn * BM + wc * 32 + 4 * fq;
#pragma unroll
        for (int ai = 0; ai < 2; ++ai)
#pragma unroll
            for (int m = 0; m < 4; ++m) { int row = row0 + ai * HALF + m * 16; asm volatile("" : "+v"(row) :: "memory"); const float s = rs[row] * mul; bf16_t* rowp = O + (size_t)row * ldc + col0;
#pragma unroll
                for (int bj = 0; bj < 2; ++bj)
#pragma unroll
                    for (int n = 0; n < 2; ++n) { const f32x4 v = acc[ai][bj][m][n] * s; u32x2 w; w.x = cvt_pk_bf16(v[0], v[1]); w.y = cvt_pk_bf16(v[2], v[3]); *(u32x2*)(rowp + bj * HALF + n * 16) = w; } }
    }
};

constexpr int LDS_CTL_OFF = 133120  , TAB_OFF = LDS_CTL_OFF + 1024, TAB_COS64 = TAB_OFF, TAB_SIN64 = TAB_OFF + 4096, TAB_COS32 = TAB_OFF + 8192, TAB_SIN32 = TAB_OFF + 10240;
constexpr float kRmsEps = 1e-6f, kAlpha = 1.189207115002721f, kInv2Pi = 0.15915494309189535f, kLog2Base = 13.287712379549449f;
__device__ __forceinline__ void sincos_rev(float pos, float ivr, float& s, float& c) { float rev = pos * ivr; rev = rev - floorf(rev); s = __builtin_amdgcn_sinf(rev); c = __builtin_amdgcn_cosf(rev); }
__device__ __forceinline__ void st_bf16x4(bf16_t* p, const f32x4 v) { u32x2 w; w.x = cvt_pk_bf16(v[0], v[1]); w.y = cvt_pk_bf16(v[2], v[3]); *(u32x2*)p = w; }
__device__ __forceinline__ float sumsq4(const f32x4 x) { return (x[0] * x[0] + x[1] * x[1]) + (x[2] * x[2] + x[3] * x[3]); }
struct EpiProj {
    static constexpr bool PERM = false;
    bf16_t *QG, *KG, *VG, *CQ, *CKV, *KPE; float *SSQ, *SSKV; const float *qn, *kn; PG8_LAS const unsigned char* lds;
    __device__ __forceinline__ void operator()(const f32x4 (&acc)[2][2][4][2], const Unit& u, int wr, int wc, int fr, int fq) const {
        { const int l_ = fresh_lane(); fr = l_ & 15; fq = l_ >> 4; }
        const int pn = u.pn, row0 = u.pm * BM + wr * 64 + fr;
        if (pn <= 2) {
            if (pn == 2 && wc >= 2) {
#pragma unroll
                for (int ai = 0; ai < 2; ++ai)
#pragma unroll
                    for (int m = 0; m < 4; ++m) { bf16_t* rowp = VG + (size_t)(row0 + ai * HALF + m * 16) * 128 + (wc - 2) * 64 + 4 * fq;
#pragma unroll
                        for (int bj = 0; bj < 2; ++bj)
#pragma unroll
                            for (int n = 0; n < 2; ++n) st_bf16x4(rowp + 32 * bj + 16 * n, acc[ai][bj][m][n]); }
            } else {
                const float* gn = (pn < 2) ? qn : kn;
                bf16_t* dst = (pn < 2) ? QG + (pn * 4 + wc) * 64 : KG + wc * 64; const int ldd = (pn < 2) ? 512 : 128;
                const int prow = 4 * (u.pm & 7) + wr;
#pragma unroll
                for (int m = 0; m < 4; ++m)
#pragma unroll
                    for (int ai = 0; ai < 2; ++ai) {
                        float ss = (sumsq4(acc[ai][0][m][0]) + sumsq4(acc[ai][0][m][1])) + (sumsq4(acc[ai][1][m][0]) + sumsq4(acc[ai][1][m][1]));
                        ss += __shfl_xor(ss, 16); ss += __shfl_xor(ss, 32);
                        const float rs = 1.0f / sqrtf(ss * (1.0f / 64.0f) + kRmsEps);
                        int row = row0 + ai * HALF + m * 16; asm volatile("" : "+v"(row) :: "memory");
                        bf16_t* rowp = dst + (size_t)row * ldd + 4 * fq;
#pragma unroll
                        for (int bj = 0; bj < 2; ++bj) { const int pos = bj ? (16 * m + fr) : (prow + 2 * ai);
                            const f32x4 c = *(const PG8_LAS f32x4*)(lds + TAB_COS64 + pos * 64 + fq * 16), s = *(const PG8_LAS f32x4*)(lds + TAB_SIN64 + pos * 64 + fq * 16);
                            const f32x4 g0 = *(const f32x4*)(gn + 32 * bj + 4 * fq), g1 = *(const f32x4*)(gn + 32 * bj + 16 + 4 * fq);
                            const f32x4 x1 = acc[ai][bj][m][0] * rs * g0, x2 = acc[ai][bj][m][1] * rs * g1;
                            st_bf16x4(rowp + 32 * bj, x1 * c - x2 * s); st_bf16x4(rowp + 32 * bj + 16, x2 * c + x1 * s); }
                        asm volatile("" ::: "memory"); }
            }
        } else if (pn <= 4) {
            bf16_t* dst = (pn == 3) ? CQ : CKV; float* sd = (pn == 3) ? SSQ : SSKV;
#pragma unroll
            for (int ai = 0; ai < 2; ++ai)
#pragma unroll
                for (int m = 0; m < 4; ++m) { int row = row0 + ai * HALF + m * 16; asm volatile("" : "+v"(row) :: "memory");
                    float ss = (sumsq4(acc[ai][0][m][0]) + sumsq4(acc[ai][0][m][1])) + (sumsq4(acc[ai][1][m][0]) + sumsq4(acc[ai][1][m][1]));
                    ss += __shfl_xor(ss, 16); ss += __shfl_xor(ss, 32);
                    if (fq == 0) sd[(size_t)row * 4 + wc] = ss;
                    bf16_t* rowp = dst + (size_t)row * 256 + wc * 32 + 4 * fq;
#pragma unroll
                    for (int bj = 0; bj < 2; ++bj)
#pragma unroll
                        for (int n = 0; n < 2; ++n) st_bf16x4(rowp + 128 * bj + 16 * n, acc[ai][bj][m][n]); }
        } else if (wc == 0) {
            const int prow = 4 * (u.pm & 7) + wr;
#pragma unroll
            for (int ai = 0; ai < 2; ++ai)
#pragma unroll
                for (int m = 0; m < 4; ++m) { const int pos = (fq >> 1) ? (16 * m + fr) : (prow + 2 * ai);
                    const f32x4 c = *(const PG8_LAS f32x4*)(lds + TAB_COS32 + pos * 32 + (fq & 1) * 16), s = *(const PG8_LAS f32x4*)(lds + TAB_SIN32 + pos * 32 + (fq & 1) * 16);
                    const f32x4 x1 = acc[ai][0][m][0], x2 = acc[ai][0][m][1];
                    bf16_t* rowp = KPE + (size_t)(row0 + ai * HALF + m * 16) * 32 + 16 * (fq >> 1) + 4 * (fq & 1);
                    st_bf16x4(rowp, x1 * c - x2 * s); st_bf16x4(rowp + 8, x2 * c + x1 * s); }
        }
    }
};
struct EpiMlaQ {
    static constexpr bool PERM = false;
    bf16_t* QM; const float* SSQ; PG8_LAS const unsigned char* lds;
    __device__ __forceinline__ void operator()(const f32x4 (&acc)[2][2][4][2], const Unit& u, int wr, int wc, int fr, int fq) const {
        { const int l_ = fresh_lane(); fr = l_ & 15; fq = l_ >> 4; }
        const int pn = u.pn, row0 = u.pm * BM + wr * 64 + fr, prow = 4 * (u.pm & 7) + wr;
#pragma unroll
        for (int ai = 0; ai < 2; ++ai)
#pragma unroll
            for (int m = 0; m < 4; ++m) { int row = row0 + ai * HALF + m * 16; asm volatile("" : "+v"(row) :: "memory"); const f32x4 p = *(const f32x4*)(SSQ + (size_t)row * 4);
                const float rs = 1.0f / sqrtf(((p[0] + p[1]) + (p[2] + p[3])) * (1.0f / 256.0f) + kRmsEps); bf16_t* rowp = QM + (size_t)row * 768;
                if (pn < 2) {
#pragma unroll
                    for (int bj = 0; bj < 2; ++bj)
#pragma unroll
                        for (int n = 0; n < 2; ++n) st_bf16x4(rowp + (4 * pn + 2 * bj + (wc >> 1)) * 96 + 32 * (wc & 1) + 16 * n + 4 * fq, acc[ai][bj][m][n] * rs);
                } else {
                    const int pos = (fq >> 1) ? (16 * m + fr) : (prow + 2 * ai);
                    const f32x4 c = *(const PG8_LAS f32x4*)(lds + TAB_COS32 + pos * 32 + (fq & 1) * 16), s = *(const PG8_LAS f32x4*)(lds + TAB_SIN32 + pos * 32 + (fq & 1) * 16);
#pragma unroll
                    for (int bj = 0; bj < 2; ++bj) { const f32x4 x1 = acc[ai][bj][m][0] * rs, x2 = acc[ai][bj][m][1] * rs;
                        bf16_t* hp = rowp + (4 * bj + wc) * 96 + 64 + 16 * (fq >> 1) + 4 * (fq & 1); st_bf16x4(hp, x1 * c - x2 * s); st_bf16x4(hp + 8, x2 * c + x1 * s); }
                }
                asm volatile("" ::: "memory"); }
    }
};
struct EpiMlaKV {
    static constexpr bool PERM = false;
    bf16_t *KN, *VM; const float* SSKV;
    __device__ __forceinline__ void operator()(const f32x4 (&acc)[2][2][4][2], const Unit& u, int wr, int wc, int fr, int fq) const {
        { const int l_ = fresh_lane(); fr = l_ & 15; fq = l_ >> 4; }
        const int row0 = u.pm * BM + wr * 64 + fr;
#pragma unroll
        for (int ai = 0; ai < 2; ++ai)
#pragma unroll
            for (int m = 0; m < 4; ++m) { int row = row0 + ai * HALF + m * 16; asm volatile("" : "+v"(row) :: "memory"); const f32x4 p = *(const f32x4*)(SSKV + (size_t)row * 4);
                const float rs = 1.0f / sqrtf(((p[0] + p[1]) + (p[2] + p[3])) * (1.0f / 256.0f) + kRmsEps);
                bf16_t* rowp = ((wc < 2) ? KN : VM) + (size_t)row * 512 + (wc & 1) * 32 + 4 * fq;
#pragma unroll
                for (int bj = 0; bj < 2; ++bj)
#pragma unroll
                    for (int n = 0; n < 2; ++n) st_bf16x4(rowp + (2 * u.pn + bj) * 64 + 16 * n, acc[ai][bj][m][n] * rs); }
    }
};
struct EpiResid {
    static constexpr bool PERM = false;
    float* O; const float* X; int ldc;
    __device__ __forceinline__ void operator()(const f32x4 (&acc)[2][2][4][2], const Unit& u, int wr, int wc, int fr, int fq) const {
        { const int l_ = fresh_lane(); fr = l_ & 15; fq = l_ >> 4; }
        const int row0 = u.pm * BM + wr * 64 + fr, col0 = u.pn * BM + wc * 32 + 4 * fq;
#pragma unroll
        for (int ai = 0; ai < 2; ++ai)
#pragma unroll
            for (int m = 0; m < 4; ++m) { int row = row0 + ai * HALF + m * 16; asm volatile("" : "+v"(row) :: "memory"); const size_t off = (size_t)row * ldc + col0;
#pragma unroll
                for (int bj = 0; bj < 2; ++bj)
#pragma unroll
                    for (int n = 0; n < 2; ++n) { const f32x4 xv = *(const f32x4*)(X + off + bj * HALF + n * 16); *(f32x4*)(O + off + bj * HALF + n * 16) = xv * kAlpha + acc[ai][bj][m][n]; } }
    }
};
struct EpiPle {
    static constexpr bool PERM = false;
    float* O; const float* E; const bf16_t* X2; int ldc;
    __device__ __forceinline__ void operator()(const f32x4 (&acc)[2][2][4][2], const Unit& u, int wr, int wc, int fr, int fq) const {
        { const int l_ = fresh_lane(); fr = l_ & 15; fq = l_ >> 4; }
        const int row0 = u.pm * BM + wr * 64 + fr, col0 = u.pn * BM + wc * 32 + 4 * fq;
#pragma unroll
        for (int ai = 0; ai < 2; ++ai)
#pragma unroll
            for (int m = 0; m < 4; ++m) { int row = row0 + ai * HALF + m * 16; asm volatile("" : "+v"(row) :: "memory"); const size_t off = (size_t)row * ldc + col0;
#pragma unroll
                for (int bj = 0; bj < 2; ++bj)
#pragma unroll
                    for (int n = 0; n < 2; ++n) { const u32x2 xw = *(const u32x2*)(X2 + off + bj * HALF + n * 16); const f32x4 ev = *(const f32x4*)(E + off + bj * HALF + n * 16), a = acc[ai][bj][m][n];
                        const f32x4 xv = {__builtin_bit_cast(float, xw.x << 16), __builtin_bit_cast(float, xw.x & 0xffff0000u), __builtin_bit_cast(float, xw.y << 16), __builtin_bit_cast(float, xw.y & 0xffff0000u)}; f32x4 o;
#pragma unroll
                        for (int j = 0; j < 4; ++j) o[j] = xv[j] * kAlpha + ev[j] * __builtin_amdgcn_rcpf(1.0f + __builtin_amdgcn_exp2f(-1.4426950408889634f * a[j]));
                        *(f32x4*)(O + off + bj * HALF + n * 16) = o; } }
    }
};

typedef int i32x8 __attribute__((ext_vector_type(8)));
typedef int i32x4 __attribute__((ext_vector_type(4)));
__device__ __forceinline__ i32x8 cat8(bf16x8 a, bf16x8 b) { return __builtin_shufflevector(__builtin_bit_cast(i32x4, a), __builtin_bit_cast(i32x4, b), 0, 1, 2, 3, 4, 5, 6, 7); }
template <class Epi, class Sched, bool ALIGN_EPI, bool FP8 = false>
__device__ __forceinline__ void gemm_phase(PG8_LAS unsigned char* lds, const Gemm g, const Sched& S, const Epi& E, int wid) {
    constexpr bool GATHER = Sched::GATHER;
    const int lane = fresh_lane(), tid = wid * 64 + lane, wr = wid >> 2, wc = wid & 3, fr = lane & 15, fq = lane >> 4;
    const int K = g.K, nt = K / BK;
    unsigned voffB[2], vC0[2], vC1[2], vN0[2], vN1[2]; int RA[2]; unsigned cofA[2];
#pragma unroll
    for (int i = 0; i < 2; ++i) { int R, C; stage_rc(tid * 16 + i * 8192, R, C); const int Rb = Epi::PERM ? ((R & ~31) + perm32(R & 31)) : R;
        vC0[i] = (unsigned)(R * K + C) * 2u; vC1[i] = vC0[i]; vN0[i] = vC0[i]; vN1[i] = vC0[i]; voffB[i] = (unsigned)(Rb * K + C) * 2u; RA[i] = R; cofA[i] = (unsigned)C * 2u; }
    const size_t kstep = (size_t)(BK * 2);
    const size_t hstep = (size_t)HALF * K * 2;
    const size_t hstepA = GATHER ? (size_t)0 : hstep;
    const size_t tstep = 2 * hstep;
    const unsigned ldsw = (unsigned)wid * 1024u;
    const unsigned ldsbase = (unsigned)(uintptr_t)lds + ldsw;
    const int aoff = lds_byte(wr * 64 + fr, fq * 8), boff = lds_byte(wc * 32 + fr, fq * 8);
#define PG8_SA(b, h) (((b) * 2 + (h)) * HTB)
#define PG8_SB(b, h) ((4 + (b) * 2 + (h)) * HTB)
#define PG8_STAGE(bufoff, gbase, voff) do { _Pragma("unroll") for (int _i = 0; _i < 2; ++_i) { unsigned _keep; \
        asm volatile("s_mov_b32 %0, m0\n\ts_mov_b32 m0, %3\n\ts_nop 0\n\tglobal_load_lds_dwordx4 %1, %2\n\ts_mov_b32 m0, %0" \
            : "=&s"(_keep) : "v"((voff)[_i]), "s"((const char*)(gbase)), "s"(ldsbase + (unsigned)((bufoff) + _i * 8192)) : "memory"); } } while (0)
#define PG8_LDA(dst, b, h) do { _Pragma("unroll") for (int m = 0; m < 4; ++m) _Pragma("unroll") for (int k = 0; k < 2; ++k) dst[m][k] = *(const PG8_LAS bf16x8*)(lds + PG8_SA(b, h) + aoff + m * 2048 + k * 1024); } while (0)
#define PG8_LDB(dst, b, h) do { _Pragma("unroll") for (int n = 0; n < 2; ++n) _Pragma("unroll") for (int k = 0; k < 2; ++k) dst[n][k] = *(const PG8_LAS bf16x8*)(lds + PG8_SB(b, h) + boff + n * 2048 + k * 1024); } while (0)
#define PG8_MMA(ai, bj, At, Bt) do { __builtin_amdgcn_s_setprio(1); _Pragma("unroll") for (int m = 0; m < 4; ++m) _Pragma("unroll") for (int n = 0; n < 2; ++n) { \
        if constexpr (FP8) acc[ai][bj][m][n] = __builtin_amdgcn_mfma_scale_f32_16x16x128_f8f6f4(cat8(Bt[n][0], Bt[n][1]), cat8(At[m][0], At[m][1]), acc[ai][bj][m][n], 0, 0, 0, 0x7f7f7f7f, 0, 0x7f7f7f7f); \
        else { _Pragma("unroll") for (int k = 0; k < 2; ++k) acc[ai][bj][m][n] = __builtin_amdgcn_mfma_f32_16x16x32_bf16(Bt[n][k], At[m][k], acc[ai][bj][m][n], 0, 0, 0); } } __builtin_amdgcn_s_setprio(0); } while (0)
#define PG8_WAIT_V(n) asm volatile("s_waitcnt vmcnt(" #n ")" ::: "memory")
#define PG8_WAIT_L(n) asm volatile("s_waitcnt lgkmcnt(" #n ")" ::: "memory")
#define PG8_BAR __builtin_amdgcn_s_barrier()
#define PG8_SCHED __builtin_amdgcn_sched_barrier(0)
#define PG8_AROWS(u, d0, d1) do { if constexpr (GATHER) { _Pragma("unroll") for (int _i = 0; _i < 2; ++_i) { \
        d0[_i] = S.arow(u, RA[_i]) * (unsigned)(K * 2) + cofA[_i]; d1[_i] = S.arow(u, HALF + RA[_i]) * (unsigned)(K * 2) + cofA[_i]; } } } while (0)
    Unit cur, nxt; int ui = 0;
    if (!S.next(0, cur)) return;
    f32x4 acc[2][2][4][2];
#pragma unroll
    for (int a = 0; a < 2; ++a)
#pragma unroll
        for (int b = 0; b < 2; ++b)
#pragma unroll
            for (int m = 0; m < 4; ++m)
#pragma unroll
                for (int n = 0; n < 2; ++n) acc[a][b][m][n] = (f32x4){0.f, 0.f, 0.f, 0.f};
    bf16x8 At[4][2], B0[2][2], B1[2][2];
    const char* cA = GATHER ? (const char*)g.A : (const char*)g.A + (size_t)cur.pm * tstep; const char* cB = (const char*)g.Bt + (size_t)S.btile(cur) * tstep;
    PG8_AROWS(cur, vC0, vC1);
    PG8_STAGE(PG8_SB(0, 0), cB, voffB); PG8_STAGE(PG8_SB(0, 1), cB + hstep, voffB); PG8_STAGE(PG8_SA(0, 0), cA, vC0); PG8_STAGE(PG8_SA(0, 1), cA + hstepA, vC1);
    if (wr == 1) PG8_BAR;
    PG8_WAIT_V(2); PG8_BAR;
    PG8_STAGE(PG8_SB(1, 0), cB + kstep, voffB); PG8_STAGE(PG8_SA(1, 0), cA + kstep, vC0); PG8_STAGE(PG8_SB(1, 1), cB + hstep + kstep, voffB);
    PG8_WAIT_V(6); PG8_BAR;
    for (;;) {
        const bool has_next = S.next(ui + 1, nxt);
        const char* nA = GATHER ? (const char*)g.A : (has_next ? (const char*)g.A + (size_t)nxt.pm * tstep : cA); const char* nB = has_next ? (const char*)g.Bt + (size_t)S.btile(nxt) * tstep : cB;
        if constexpr (GATHER) { if (has_next) { PG8_AROWS(nxt, vN0, vN1); } else { vN0[0] = vC0[0]; vN0[1] = vC0[1]; vN1[0] = vC1[0]; vN1[1] = vC1[1]; } }
#pragma unroll 1
        for (int t = 0; t < nt; t += 2) {
            const bool last = (t == nt - 2);
            const char* a1 = cA + (size_t)(t + 1) * kstep;
            const char* a2 = last ? nA : cA + (size_t)(t + 2) * kstep; const char* b2 = last ? nB : cB + (size_t)(t + 2) * kstep;
            const char* a3 = a2 + kstep; const char* b3 = b2 + kstep;
            PG8_LDB(B0, 0, 0); PG8_LDB(B1, 0, 1); PG8_SCHED; PG8_LDA(At, 0, 0); PG8_STAGE(PG8_SA(1, 1), a1 + hstepA, vC1);
            if constexpr (GATHER) { if (last) { vC0[0] = vN0[0]; vC0[1] = vN0[1]; vC1[0] = vN1[0]; vC1[1] = vN1[1]; } }
            PG8_WAIT_V(8); PG8_WAIT_L(0); PG8_BAR; PG8_MMA(0, 0, At, B0); PG8_MMA(0, 1, At, B1); PG8_BAR; PG8_SCHED;
            PG8_LDA(At, 0, 1); PG8_STAGE(PG8_SB(0, 0), b2, voffB); PG8_STAGE(PG8_SB(0, 1), b2 + hstep, voffB); PG8_STAGE(PG8_SA(0, 0), a2, vC0);
            PG8_WAIT_V(8); PG8_WAIT_L(0); PG8_BAR; PG8_MMA(1, 0, At, B0); PG8_MMA(1, 1, At, B1); PG8_BAR; PG8_SCHED;
            PG8_LDB(B0, 1, 0); PG8_LDB(B1, 1, 1); PG8_SCHED; PG8_LDA(At, 1, 0); PG8_STAGE(PG8_SA(0, 1), a2 + hstepA, vC1);
            PG8_WAIT_V(8); PG8_WAIT_L(0); PG8_BAR; PG8_MMA(0, 0, At, B0); PG8_MMA(0, 1, At, B1); PG8_BAR; PG8_SCHED;
            PG8_LDA(At, 1, 1); PG8_STAGE(PG8_SB(1, 0), b3, voffB); PG8_STAGE(PG8_SB(1, 1), b3 + hstep, voffB); PG8_STAGE(PG8_SA(1, 0), a3, vC0);
            PG8_WAIT_V(8); PG8_WAIT_L(0); PG8_BAR; PG8_MMA(1, 0, At, B0); PG8_MMA(1, 1, At, B1); PG8_BAR; PG8_SCHED;
        }
        if constexpr (ALIGN_EPI) { if (wr == 0) PG8_BAR; }
        E(acc, cur, wr, wc, fr, fq);
        if (!has_next) break;
#pragma unroll
        for (int a = 0; a < 2; ++a)
#pragma unroll
            for (int b = 0; b < 2; ++b)
#pragma unroll
                for (int m = 0; m < 4; ++m)
#pragma unroll
                    for (int n = 0; n < 2; ++n) acc[a][b][m][n] = (f32x4){0.f, 0.f, 0.f, 0.f};
        cur = nxt; cA = nA; cB = nB; ++ui;
        if constexpr (ALIGN_EPI) { if (wr == 1) PG8_BAR; }
    }
    PG8_WAIT_V(0);
    if constexpr (!ALIGN_EPI) { if (wr == 0) PG8_BAR; }
    PG8_BAR;
#undef PG8_SA
#undef PG8_SB
#undef PG8_STAGE
#undef PG8_LDA
#undef PG8_LDB
#undef PG8_MMA
#undef PG8_WAIT_V
#undef PG8_WAIT_L
#undef PG8_BAR
#undef PG8_SCHED
#undef PG8_AROWS
}
}

namespace att {
using bf16_t = unsigned short;
using bf16x8 = __attribute__((ext_vector_type(8))) short;
using s16x4  = __attribute__((ext_vector_type(4))) short;
using f32x16 = __attribute__((ext_vector_type(16))) float;
using u32x4  = __attribute__((ext_vector_type(4))) unsigned;
#define SBAR() __builtin_amdgcn_sched_barrier(0)
constexpr float THR = 8.f;
__device__ __forceinline__ int crow(int r, int hi) { return (r & 3) + 8 * (r >> 2) + 4 * hi; }
__device__ __forceinline__ unsigned cvtpk(float lo, float hi) { unsigned r; asm volatile("v_cvt_pk_bf16_f32 %0, %1, %2" : "=v"(r) : "v"(lo), "v"(hi)); return r; }
template <int DK> struct KCfg;
template <> struct KCfg<64> { static constexpr float SCALE = 0.125f;
    static __device__ __forceinline__ int swz(int row, int cb) { return row * 128 + (cb ^ (((row >> 1) & 7) << 4)); } };
template <> struct KCfg<96> { static constexpr float SCALE = 0.10206207261596577f;
    static __device__ __forceinline__ int swz(int row, int cb) { return row * 192 + (cb ^ (((row >> 2) & 3) << 4)); } };

template <int DK> __device__ __forceinline__ void partialSM(f32x16& p0, f32x16& p1, float& m_reg, float& mn, float& alpha) {
  constexpr float SCALE = KCfg<DK>::SCALE, C = SCALE * 1.4426950408889634f;
  float pmax = p0[0];
#pragma unroll
  for (int r = 1; r < 16; ++r) pmax = fmaxf(pmax, p0[r]);
#pragma unroll
  for (int r = 0; r < 16; ++r) pmax = fmaxf(pmax, p1[r]);
  { auto rr = __builtin_amdgcn_permlane32_swap(__float_as_uint(pmax), __float_as_uint(pmax), false, false);
    pmax = fmaxf(__uint_as_float(rr[0]), __uint_as_float(rr[1])); }
  if (__builtin_expect(__all(pmax - m_reg <= THR / SCALE), 1)) { mn = m_reg; alpha = 1.f; }
  else { mn = fmaxf(m_reg, pmax); alpha = __builtin_amdgcn_exp2f((m_reg - mn) * C); m_reg = mn; }
  float mnC = -mn * C;
#pragma unroll
  for (int r = 0; r < 16; ++r) p0[r] = fmaf(p0[r], C, mnC);
#pragma unroll
  for (int r = 0; r < 16; ++r) p1[r] = fmaf(p1[r], C, mnC);
#pragma unroll
  for (int r = 0; r < 16; ++r) p0[r] = __builtin_amdgcn_exp2f(p0[r]);
}
__device__ __forceinline__ void finishSM(f32x16& p0, f32x16& p1, float alpha, float& l_reg, bf16x8& pa0, bf16x8& pa1, bf16x8& pa2, bf16x8& pa3) {
#pragma unroll
  for (int r = 0; r < 16; ++r) p1[r] = __builtin_amdgcn_exp2f(p1[r]);
  float ps = 0;
#pragma unroll
  for (int r = 0; r < 16; ++r) ps += p0[r];
#pragma unroll
  for (int r = 0; r < 16; ++r) ps += p1[r];
  { auto rr = __builtin_amdgcn_permlane32_swap(__float_as_uint(ps), __float_as_uint(ps), false, false);
    ps = __uint_as_float(rr[0]) + __uint_as_float(rr[1]); }
  l_reg = l_reg * alpha + ps;
#define PK4(P, BASE, OUT) do { unsigned a0 = cvtpk(P[BASE + 0], P[BASE + 1]), a1 = cvtpk(P[BASE + 2], P[BASE + 3]);   \
    unsigned b0 = cvtpk(P[BASE + 4], P[BASE + 5]), b1 = cvtpk(P[BASE + 6], P[BASE + 7]);                              \
    auto r0 = __builtin_amdgcn_permlane32_swap(a0, b0, false, false); auto r1 = __builtin_amdgcn_permlane32_swap(a1, b1, false, false); \
    u32x4 w = {r0[0], r1[0], r0[1], r1[1]}; OUT = *reinterpret_cast<bf16x8*>(&w); } while (0)
  PK4(p0, 0, pa0); PK4(p0, 8, pa1); PK4(p1, 0, pa2); PK4(p1, 8, pa3);
#undef PK4
}
template <int DK> __device__ __forceinline__ void qkt(f32x16& p0, f32x16& p1, const char* Ks, const bf16x8* qr, int r32, int hi) {
  p0 = f32x16{}; p1 = f32x16{};
#pragma unroll
  for (int d0 = 0; d0 < DK / 16; ++d0) { const int cb = (d0 * 16 + hi * 8) * 2;
    bf16x8 b0 = *reinterpret_cast<const bf16x8*>(Ks + KCfg<DK>::swz(r32, cb));
    bf16x8 b1 = *reinterpret_cast<const bf16x8*>(Ks + KCfg<DK>::swz(32 + r32, cb));
    p0 = __builtin_amdgcn_mfma_f32_32x32x16_bf16(b0, qr[d0], p0, 0, 0, 0);
    p1 = __builtin_amdgcn_mfma_f32_32x32x16_bf16(b1, qr[d0], p1, 0, 0, 0); }
}
__device__ __forceinline__ int v_st(int k, int c) { const int kk = (k & ~0xC) | ((k & 4) << 1) | ((k & 8) >> 1); return ((kk >> 3) * 2 + (c >> 5)) * 512 + ((kk & 7) * 32 + (c & 31)) * 2; }
__device__ __forceinline__ int v_rd_base(int lane) { return ((lane & 3) << 3) | (((lane >> 2) & 3) << 6) | (((lane >> 4) & 1) << 5) | (((lane >> 5) & 1) << 8); }
constexpr int v_rd_off(int d0, int ks, int half) { return d0 * 512 + ks * 2048 + half * 1024; }
template <int OFF> __device__ __forceinline__ s16x4 tr_read(int vb) {
  s16x4 r; asm volatile("ds_read_b64_tr_b16 %0, %1 offset:%2" : "=&v"(r) : "v"(vb), "i"(OFF) : "memory"); return r;
}
template <int D0> __device__ __forceinline__ void pv_one(f32x16& od, int vb, bf16x8 pa0, bf16x8 pa1, bf16x8 pa2, bf16x8 pa3) {
  const s16x4 l0 = tr_read<v_rd_off(D0, 0, 0)>(vb), h0 = tr_read<v_rd_off(D0, 0, 1)>(vb), l1 = tr_read<v_rd_off(D0, 1, 0)>(vb), h1 = tr_read<v_rd_off(D0, 1, 1)>(vb);
  const s16x4 l2 = tr_read<v_rd_off(D0, 2, 0)>(vb), h2 = tr_read<v_rd_off(D0, 2, 1)>(vb), l3 = tr_read<v_rd_off(D0, 3, 0)>(vb), h3 = tr_read<v_rd_off(D0, 3, 1)>(vb);
  asm volatile("s_waitcnt lgkmcnt(0)" ::: "memory"); SBAR();
#define PK(L, H) (bf16x8){L[0], L[1], L[2], L[3], H[0], H[1], H[2], H[3]}
  od = __builtin_amdgcn_mfma_f32_32x32x16_bf16(pa0, PK(l0, h0), od, 0, 0, 0);
  od = __builtin_amdgcn_mfma_f32_32x32x16_bf16(pa1, PK(l1, h1), od, 0, 0, 0);
  od = __builtin_amdgcn_mfma_f32_32x32x16_bf16(pa2, PK(l2, h2), od, 0, 0, 0);
  od = __builtin_amdgcn_mfma_f32_32x32x16_bf16(pa3, PK(l3, h3), od, 0, 0, 0);
#undef PK
}
__device__ __forceinline__ void pv_d0(f32x16* o, int vb, bf16x8 pa0, bf16x8 pa1, bf16x8 pa2, bf16x8 pa3) {
  pv_one<0>(o[0], vb, pa0, pa1, pa2, pa3); pv_one<1>(o[1], vb, pa0, pa1, pa2, pa3);
}
constexpr int SEQK = 2048, KVBLK = 64, NT = SEQK / KVBLK, SHM_V = 64 * 64 * 2;
constexpr int LDS_BYTES = 2 * SHM_V + 2 * (64 * 96 * 2) + 2048 + 8 * 4096;
template <int DK>
__device__ __forceinline__ void attn_unit(const bf16_t* __restrict__ Qb, int ldq, const bf16_t* __restrict__ Kh, int ldk, const bf16_t* __restrict__ Kp, int ldp, const bf16_t* __restrict__ Vh, int ldv, bf16_t* __restrict__ Ob, int ldo, char* lds, int wid) {
  constexpr int KCH = DK / 8, SHM_K = 64 * DK * 2; constexpr bool K2 = (64 * KCH > 512);
  const int lane = fresh_lane(), tid = wid * 64 + lane, r32 = lane & 31, hi = lane >> 5;
  char* V_lds = lds; char* K_lds = lds + 2 * SHM_V;
  float* ws = (float*)(lds + 2 * SHM_V + 2 * SHM_K) + wid * 64; float* li_l = ws; float* al_l = ws + 32;
  bf16_t* stg = (bf16_t*)(lds + 2 * SHM_V + 2 * SHM_K + 2048) + wid * 2048;
  float m_reg = -1e30f, l_reg = 0; f32x16 o[2] = {}; bf16x8 qr[DK / 16];
  const bf16_t* Qw = Qb + (long)(wid * 32 + r32) * ldq + hi * 8;
#pragma unroll
  for (int d0 = 0; d0 < DK / 16; ++d0) qr[d0] = *reinterpret_cast<const bf16x8*>(Qw + d0 * 16);
  const int kr0 = tid / KCH, kc0 = (tid % KCH) * 8, kr1 = (tid + 512) / KCH, kc1 = ((tid + 512) % KCH) * 8; const bool has2 = K2 && (tid < 64 * KCH - 512);
  const bf16_t* kp0 = (kc0 < 64) ? Kh + (long)kr0 * ldk + kc0 : Kp + (long)kr0 * ldp + (kc0 - 64); const long ks0 = (kc0 < 64) ? ldk : ldp;
  const bf16_t* kp1 = (kc1 < 64) ? Kh + (long)kr1 * ldk + kc1 : Kp + (long)kr1 * ldp + (kc1 - 64); const long ks1 = (kc1 < 64) ? ldk : ldp;
  const int vr = tid >> 3, vc = (tid & 7) * 8, vst0 = v_st(vr, vc);
  const int vb0 = (int)(uintptr_t)V_lds + v_rd_base(lane);
  bf16x8 skE0, skE1, svE, skO0, skO1, svO;
#define SLOAD(S, k0) do { sk##S##0 = *reinterpret_cast<const bf16x8*>(kp0 + (long)(k0) * ks0); if (has2) sk##S##1 = *reinterpret_cast<const bf16x8*>(kp1 + (long)(k0) * ks1); \
    sv##S = *reinterpret_cast<const bf16x8*>(&Vh[(long)((k0) + vr) * ldv + vc]); } while (0)
#define SWRITE(b, S) do { *(bf16x8*)(K_lds + (b) * SHM_K + KCfg<DK>::swz(kr0, kc0 * 2)) = sk##S##0; if (has2) *(bf16x8*)(K_lds + (b) * SHM_K + KCfg<DK>::swz(kr1, kc1 * 2)) = sk##S##1; \
    *(bf16x8*)(V_lds + (b) * SHM_V + vst0) = sv##S; } while (0)
#define RESC(a) do { if (__any((a) < 1.f)) { if (hi == 0) al_l[r32] = (a); asm volatile("s_waitcnt lgkmcnt(0)" ::: "memory"); \
    _Pragma("unroll") for (int d = 0; d < 2; ++d) _Pragma("unroll") for (int r = 0; r < 16; ++r) o[d][r] *= al_l[crow(r, hi)]; } } while (0)
  f32x16 pA0, pA1, pB0, pB1; float mnA, mnB, alA, alB; bf16x8 pa0, pa1, pa2, pa3;
  SLOAD(E, 0); SWRITE(0, E); __syncthreads();
  qkt<DK>(pA0, pA1, K_lds, qr, r32, hi); partialSM<DK>(pA0, pA1, m_reg, mnA, alA);
  SLOAD(O, KVBLK); SLOAD(E, 2 * KVBLK);
  SWRITE(1, O); __syncthreads();
  for (int j = 1; j + 1 < NT; j += 2) {
    SBAR(); qkt<DK>(pB0, pB1, K_lds + SHM_K, qr, r32, hi);
    finishSM(pA0, pA1, alA, l_reg, pa0, pa1, pa2, pa3); SBAR();
    SLOAD(O, (j + 2) * KVBLK); SBAR();
    pv_d0(o, vb0, pa0, pa1, pa2, pa3); partialSM<DK>(pB0, pB1, m_reg, mnB, alB);
    __syncthreads(); SWRITE(0, E);
    RESC(alB); __syncthreads();
    SBAR(); qkt<DK>(pA0, pA1, K_lds, qr, r32, hi);
    finishSM(pB0, pB1, alB, l_reg, pa0, pa1, pa2, pa3); SBAR();
    if (j + 3 < NT) SLOAD(E, (j + 3) * KVBLK); SBAR();
    pv_d0(o, vb0 + SHM_V, pa0, pa1, pa2, pa3); partialSM<DK>(pA0, pA1, m_reg, mnA, alA);
    __syncthreads(); SWRITE(1, O);
    RESC(alA); __syncthreads();
  }
  SBAR(); qkt<DK>(pB0, pB1, K_lds + SHM_K, qr, r32, hi);
  finishSM(pA0, pA1, alA, l_reg, pa0, pa1, pa2, pa3); SBAR();
  pv_d0(o, vb0, pa0, pa1, pa2, pa3); partialSM<DK>(pB0, pB1, m_reg, mnB, alB);
  __syncthreads(); RESC(alB);
  finishSM(pB0, pB1, alB, l_reg, pa0, pa1, pa2, pa3); SBAR();
  pv_d0(o, vb0 + SHM_V, pa0, pa1, pa2, pa3);
  if (hi == 0) li_l[r32] = l_reg; asm volatile("s_waitcnt lgkmcnt(0)" ::: "memory");
  float rli[16];
#pragma unroll
  for (int r = 0; r < 16; ++r) rli[r] = __builtin_amdgcn_rcpf(li_l[crow(r, hi)]);
#pragma unroll
  for (int r = 0; r < 16; ++r) { const int orow = crow(r, hi);
#pragma unroll
    for (int d0 = 0; d0 < 2; ++d0) { const unsigned w = cvtpk(o[d0][r] * rli[r], 0.f); stg[orow * 64 + d0 * 32 + r32] = (bf16_t)(w & 0xffffu); } }
  asm volatile("s_waitcnt lgkmcnt(0)" ::: "memory");
  bf16_t* Ow = Ob + (long)(wid * 32) * ldo;
#pragma unroll
  for (int i = 0; i < 4; ++i) { const int row = i * 8 + (lane >> 3), ch = lane & 7; const u32x4 v = *(const u32x4*)(stg + row * 64 + ch * 8); *(u32x4*)(Ow + (long)row * ldo + ch * 8) = v; }
  __syncthreads();
#undef SLOAD
#undef SWRITE
#undef RESC
}
#undef SBAR
}

constexpr int NWAVES = 8;
constexpr int NB = 16, SEQ = 2048, DM = 1024, T = NB * SEQ;
constexpr int INW = 1312, INWP = 1536;
constexpr int NE = 16, CAP = 256, FF = 2816, PLE = 256;
constexpr int UQW = 768, UKVW = 1024;
constexpr float ALPHA = 1.189207115002721f;
constexpr float LN_EPS = 1e-5f, RMS_EPS = 1e-6f;

constexpr size_t MiB = 1u << 20;
constexpr size_t WS_CTL = 0;
constexpr size_t WS_WIN = 1 * MiB;
constexpr size_t WS_WUQ = 4 * MiB;
constexpr size_t WS_WUKV = 4 * MiB + 512 * 1024;
constexpr size_t WS_WOUT = 5 * MiB;
constexpr size_t WS_WPG = 7 * MiB;
constexpr size_t WS_WPP = 9 * MiB;
constexpr size_t WS_WRT = 9 * MiB + 512 * 1024;
constexpr size_t WS_AFF = 10 * MiB;
constexpr size_t WS_ROWMAP = 12 * MiB;
constexpr size_t WS_GVAL = 12 * MiB + 256 * 1024;
constexpr size_t WS_SEL = 12 * MiB + 512 * 1024;
constexpr size_t WS_SSQ = 14 * MiB + 512 * 1024, WS_SSKV = 15 * MiB;
constexpr size_t WS_WGU = 16 * MiB;
constexpr size_t WS_YEXP = 16 * MiB, WS_PB = 144 * MiB;
constexpr size_t WS_X1Q = 104 * MiB;
constexpr size_t WS_WDN = 192 * MiB;
constexpr size_t WS_X1B = 280 * MiB;
constexpr size_t WS_QMLA = 280 * MiB;
constexpr size_t WS_R1 = 344 * MiB;
constexpr size_t WS_XB = WS_R1;
constexpr size_t WS_PROJ = WS_R1 + 64 * MiB;
constexpr size_t WS_QG = WS_R1 + 256 * MiB, WS_KG = WS_QG + 32 * MiB, WS_VG = WS_KG + 8 * MiB, WS_CQ = WS_VG + 8 * MiB, WS_CKV = WS_CQ + 16 * MiB, WS_KPE = WS_CKV + 16 * MiB;
constexpr size_t WS_QM = WS_R1;
constexpr size_t WS_KV = WS_R1 + 96 * MiB;
constexpr size_t WS_VMLA = WS_R1 + 224 * MiB;
constexpr size_t WS_KN = WS_R1 + 96 * MiB;
constexpr size_t WS_O = WS_R1;
constexpr size_t WS_H = WS_R1;
constexpr size_t WS_E = WS_R1, WS_G = WS_R1 + 128 * MiB;
constexpr size_t WS_END = 704 * MiB;
static_assert(WS_KPE + 2 * MiB <= WS_END && WS_H + (size_t)65536 * FF * 2 <= WS_END && WS_VMLA + 32 * MiB <= WS_QG, "d_ws map");

constexpr int LDS_BYTES = 147456;
static_assert(att::LDS_BYTES <= 131072 && pg8::TAB_OFF + 12288 <= LDS_BYTES, "LDS map");

#define LAS __attribute__((address_space(3)))
typedef unsigned short bf16;
typedef unsigned v4u __attribute__((ext_vector_type(4)));
typedef unsigned v2u __attribute__((ext_vector_type(2)));
typedef float f32x4 __attribute__((ext_vector_type(4)));
__device__ __forceinline__ unsigned f2bf(float f) { unsigned u = __builtin_bit_cast(unsigned, f); return (u + 0x7fffu + ((u >> 16) & 1u)) >> 16; }
__device__ __forceinline__ unsigned pk2(float lo, float hi) { return f2bf(lo) | (f2bf(hi) << 16); }
__device__ __forceinline__ float bf2f(unsigned h) { return __builtin_bit_cast(float, h << 16); }
__device__ __forceinline__ float wave_sum(float v) {
#pragma unroll
    for (int o = 1; o < 64; o <<= 1) v += __shfl_xor(v, o);
    return v;
}
__device__ __forceinline__ float wave_max(float v) {
#pragma unroll
    for (int o = 1; o < 64; o <<= 1) v = fmaxf(v, __shfl_xor(v, o));
    return v;
}


#define GAS __attribute__((address_space(1)))
typedef GAS unsigned gu32;
#define RLX_AGENT __ATOMIC_RELAXED, __HIP_MEMORY_SCOPE_AGENT
#define XB_TMO      128
#define XB_XCNT(j)  (256  + 64 * (j))
#define XB_XSUB(j)  (1280 + 64 * (j))
#define XB_XGEN(j)  (2304 + 64 * (j))
#define XB_TOP      3328
#define XB_TOPGEN   3392
#define XCD_BAR_WORDS 3456
#define XB_SPIN_CAP (1u << 18)

__device__ __forceinline__ unsigned xb_ld(unsigned* p)              { return __hip_atomic_load(p, __ATOMIC_RELAXED, __HIP_MEMORY_SCOPE_AGENT); }
__device__ __forceinline__ unsigned xb_add(unsigned* p, unsigned v) { return __hip_atomic_fetch_add(p, v, __ATOMIC_RELAXED, __HIP_MEMORY_SCOPE_AGENT); }
__device__ __forceinline__ unsigned xb_xcc_id() { return (unsigned)__builtin_amdgcn_s_getreg((3 << 11) | 20) & 0xFu; }
#define XB_SPIN(cond, bar) do { unsigned _sp = 0; while (cond) { __builtin_amdgcn_s_sleep(1); \
    if ((++_sp & 255u) == 0u) { if (xb_ld(&(bar)[XB_TMO])) break; if (_sp > XB_SPIN_CAP) { atomicAdd(&(bar)[XB_TMO], 1u); break; } } } } while (0)

struct XcdBarrier {
    unsigned* bar; unsigned x; int w;
    volatile LAS unsigned* st;
};

__device__ __forceinline__ XcdBarrier xcd_barrier_post(unsigned* bar, volatile LAS unsigned* st, int w) {
    XcdBarrier b; b.bar = bar; b.x = xb_xcc_id(); b.st = st; b.w = w;
    if (w == 0 && fresh_lane() == 0) (void)xb_add(&bar[XB_XCNT(b.x)], 1u);
    return b;
}
__device__ __forceinline__ void xcd_barrier_complete(unsigned* bar, unsigned x, unsigned& nloc, unsigned& nx) {
    const unsigned G = gridDim.x * gridDim.y * gridDim.z;
    unsigned sum, cnt, mine, sp = 0u;
    for (;;) {
        sum = 0u; cnt = 0u; mine = 0u;
#pragma unroll
        for (unsigned j = 0; j < 16; ++j) { const unsigned c = xb_ld(&bar[XB_XCNT(j)]); sum += c; cnt += (c > 0u) ? 1u : 0u; mine = (j == x) ? c : mine; }
        if (sum == G) break;
        __builtin_amdgcn_s_sleep(1);
        if ((++sp & 255u) == 0u) { if (xb_ld(&bar[XB_TMO])) break; if (sp > XB_SPIN_CAP) { atomicAdd(&bar[XB_TMO], 1u); break; } }
    }
    nloc = mine > 0u ? mine : 1u; nx = cnt > 0u ? cnt : 1u;
}

__device__ __forceinline__ void xcd_barrier(const XcdBarrier& b) {
    asm volatile("s_waitcnt vmcnt(0)" ::: "memory");
    __syncthreads();
    if (b.w == 0 && fresh_lane() == 0) {
        unsigned* bar = b.bar;
        __builtin_amdgcn_s_waitcnt(0);
        unsigned nloc = b.st[0], nx = b.st[1];
        if (nloc == 0u) { xcd_barrier_complete(bar, b.x, nloc, nx); b.st[0] = nloc; b.st[1] = nx; }
        const unsigned old = xb_add(&bar[XB_XSUB(b.x)], 1u);
        const unsigned gen = old / nloc;
        if (old + 1u == (gen + 1u) * nloc) {
            __builtin_amdgcn_fence(__ATOMIC_RELEASE, "agent");
            asm volatile("s_waitcnt vmcnt(0)" ::: "memory");
            const unsigned og = xb_add(&bar[XB_TOP], 1u);
            const unsigned tg = og / nx;
            if (og + 1u == (tg + 1u) * nx) xb_add(&bar[XB_TOPGEN], 1u);
            else XB_SPIN(xb_ld(&bar[XB_TOPGEN]) == tg, bar);
            __builtin_amdgcn_fence(__ATOMIC_ACQUIRE, "agent");
            xb_add(&bar[XB_XGEN(b.x)], 1u);
            asm volatile("s_waitcnt vmcnt(0)" ::: "memory");
        } else {
            XB_SPIN(xb_ld(&bar[XB_XGEN(b.x)]) == gen, bar);
            __builtin_amdgcn_fence(__ATOMIC_ACQUIRE, "agent");
            asm volatile("s_waitcnt vmcnt(0)" ::: "memory");
        }
    }
    __syncthreads();
}
struct Args { const float* in[22]; float* out; unsigned char* ws; int ph_lo, ph_hi, dummy, region; };
enum { I_X = 0, I_P, I_WIN, I_QN, I_KN, I_CQN, I_CKVN, I_WUQ, I_WUKV, I_WOUT, I_LNAG, I_LNAB, I_WR, I_WG, I_WU, I_WD, I_LNFG, I_LNFB, I_WPP, I_WPG, I_LNPG, I_LNPB };

struct Frame { LAS unsigned char* lds; int tid, lane, wave, vcu, G; };

__device__ __forceinline__ void tr_item(const float* W, int N, int k0, int n0, bf16* WT, int K, long dst_row0, LAS float* scr, int lane, const float* kscale = nullptr, int nmode = 0) {
#pragma unroll 8
    for (int i = 0; i < 32; ++i) { const int kk = 2 * i + (lane >> 5); float v = W[(size_t)(k0 + kk) * N + n0 + (lane & 31)]; if (kscale) v *= kscale[k0 + kk]; scr[kk * 33 + (lane & 31)] = v; }
    asm volatile("s_waitcnt lgkmcnt(0)" ::: "memory");
    const int c = lane & 7;
#pragma unroll
    for (int j = 0; j < 4; ++j) { const int n = (lane >> 3) + 8 * j; const LAS float* s = scr + (8 * c) * 33 + n;
        v4u o; o.x = pk2(s[0 * 33], s[1 * 33]); o.y = pk2(s[2 * 33], s[3 * 33]); o.z = pk2(s[4 * 33], s[5 * 33]); o.w = pk2(s[6 * 33], s[7 * 33]);
        const int nd = nmode ? (16 * ((n >> 3) & 1) + 8 * (n >> 4) + (n & 7)) : n;
        *(v4u*)(WT + (size_t)(dst_row0 + nd) * K + k0 + 8 * c) = o; }
    asm volatile("s_waitcnt lgkmcnt(0)" ::: "memory");
}
__device__ __forceinline__ unsigned q4(float a, float b, float c, float d) { int w = __builtin_amdgcn_cvt_pk_fp8_f32(a * 32.0f, b * 32.0f, 0, false); w = __builtin_amdgcn_cvt_pk_fp8_f32(c * 32.0f, d * 32.0f, w, true); return (unsigned)w; }
__device__ __forceinline__ void tr_item8(const float* W, int N, int k0, int n0, unsigned char* WT, int K, long dst_row0, LAS float* scr, int lane) {
#pragma unroll 8
    for (int i = 0; i < 32; ++i) { const int kk = 2 * i + (lane >> 5); scr[kk * 33 + (lane & 31)] = W[(size_t)(k0 + kk) * N + n0 + (lane & 31)]; }
    asm volatile("s_waitcnt lgkmcnt(0)" ::: "memory");
    const int c = lane & 7;
#pragma unroll
    for (int j = 0; j < 4; ++j) { const int n = (lane >> 3) + 8 * j; const LAS float* s = scr + (8 * c) * 33 + n;
        v2u o; o.x = q4(s[0 * 33], s[1 * 33], s[2 * 33], s[3 * 33]); o.y = q4(s[4 * 33], s[5 * 33], s[6 * 33], s[7 * 33]);
        *(v2u*)(WT + (size_t)(dst_row0 + n) * K + k0 + 8 * c) = o; }
    asm volatile("s_waitcnt lgkmcnt(0)" ::: "memory");
}
__device__ __forceinline__ void tr_dense(const float* W, int K, int N, bf16* WT, int r, LAS float* scr, int lane, const float* kscale = nullptr) {
    const int nblk = N / 32, kb = r / nblk, nb = r % nblk; tr_item(W, N, 64 * kb, 32 * nb, WT, K, 32 * nb, scr, lane, kscale);
}
__device__ __forceinline__ void p0_convert(const Frame& F, const Args& a) {
    LAS float* scr = (LAS float*)(F.lds + F.wave * 16640);
    const int gw = F.vcu * NWAVES + F.wave, NGW = F.G * NWAVES;
    unsigned char* ws = a.ws;
    constexpr int I_IN = (DM / 64) * (INW / 32), I_UQ = (256 / 64) * (UQW / 32), I_UKV = (256 / 64) * (UKVW / 32), I_OUT = (DM / 64) * (DM / 32), I_PG = I_OUT, I_PP = (PLE / 64) * (DM / 32);
    constexpr int NITEMS = I_IN + I_UQ + I_UKV + I_OUT + I_PG + I_PP;
    for (int it = gw; it < NITEMS; it += NGW) {
        int r = it;
        if (r < I_IN) {
            const int nblk = INW / 32, kb = r / nblk, nb = r % nblk, n0 = 32 * nb, pn = n0 >> 8, cw = n0 & 255;
            const int d0 = (pn <= 2) ? 256 * pn + ((cw >> 5) & 1) * 128 + (cw >> 6) * 32 : n0;
            tr_item(a.in[I_WIN], INW, 64 * kb, n0, (bf16*)(ws + WS_WIN), DM, d0, scr, F.lane, nullptr, pn == 5 ? 1 : 0); continue; } r -= I_IN;
        if (r < I_UQ) {
            const int nblk = UQW / 32, kb = r / nblk, nb = r % nblk, n0 = 32 * nb, head = n0 / 96, off = n0 % 96;
            const int d0 = (off < 64) ? (head >> 2) * 256 + (head & 3) * 64 + off : 512 + head * 32;
            tr_item(a.in[I_WUQ], UQW, 64 * kb, n0, (bf16*)(ws + WS_WUQ), 256, d0, scr, F.lane, a.in[I_CQN], off < 64 ? 0 : 1); continue; } r -= I_UQ;
        if (r < I_UKV) { tr_dense(a.in[I_WUKV], 256, UKVW, (bf16*)(ws + WS_WUKV), r, scr, F.lane, a.in[I_CKVN]); continue; } r -= I_UKV;
        if (r < I_OUT) { tr_dense(a.in[I_WOUT], DM, DM, (bf16*)(ws + WS_WOUT), r, scr, F.lane); continue; } r -= I_OUT;
        if (r < I_PG) { tr_dense(a.in[I_WPG], DM, DM, (bf16*)(ws + WS_WPG), r, scr, F.lane); continue; } r -= I_PG;
        tr_dense(a.in[I_WPP], PLE, DM, (bf16*)(ws + WS_WPP), r, scr, F.lane);
    }
    {
        constexpr int I_E = 16 * 44, MOE_ITEMS = 3 * NE * I_E;
        const int l = F.lane, kr = l >> 4, nq = l & 15, nl = l & 7, c = l >> 3;
#define MOE_DESC(it, src, N_, dst, K_) do { const int mat_ = (it) / (NE * I_E); int r_ = (it) % (NE * I_E); const int e_ = r_ / I_E; r_ %= I_E; \
        if (mat_ < 2) { const int kb_ = r_ / 44, nb_ = r_ % 44, n0_ = 64 * nb_; src = a.in[mat_ ? I_WU : I_WG] + (size_t)e_ * DM * FF + (size_t)(64 * kb_) * FF + n0_; N_ = FF; K_ = DM; \
            dst = ws + WS_WGU + ((size_t)e_ * (2 * FF) + (n0_ / 128) * 256 + (n0_ % 128) + (mat_ ? 128 : 0)) * DM + 64 * kb_; } \
        else { const int kb_ = r_ / 16, nb_ = r_ % 16; src = a.in[I_WD] + (size_t)e_ * FF * DM + (size_t)(64 * kb_) * DM + 64 * nb_; N_ = DM; K_ = FF; \
            dst = ws + WS_WDN + ((size_t)e_ * DM + 64 * nb_) * FF + 64 * kb_; } } while (0)
#define MOE_LOAD(v, src, N_) do { _Pragma("unroll") for (int i = 0; i < 16; ++i) v[i] = *(const f32x4*)(src + (size_t)(4 * i + kr) * N_ + 4 * nq); } while (0)
#define MOE_PROC(v, dst, K_) do { _Pragma("unroll") for (int i = 0; i < 16; ++i) { LAS float* s_ = scr + (4 * i + kr) * 65 + 4 * nq; s_[0] = v[i].x; s_[1] = v[i].y; s_[2] = v[i].z; s_[3] = v[i].w; } \
        asm volatile("s_waitcnt lgkmcnt(0)" ::: "memory"); \
        _Pragma("unroll") for (int j = 0; j < 8; ++j) { const int n_ = nl + 8 * j; const LAS float* s_ = scr + (8 * c) * 65 + n_; \
            v2u o_; o_.x = q4(s_[0], s_[65], s_[130], s_[195]); o_.y = q4(s_[260], s_[325], s_[390], s_[455]); *(v2u*)(dst + (size_t)n_ * K_ + 8 * c) = o_; } \
        asm volatile("s_waitcnt lgkmcnt(0)" ::: "memory"); } while (0)
        f32x4 va[16], vb[16]; const float *sa = nullptr, *sb = nullptr; unsigned char *da = nullptr, *db = nullptr; int Na = 0, Nb = 0, Ka = 0, Kb = 0;
        int it = gw;
        if (it < MOE_ITEMS) { MOE_DESC(it, sa, Na, da, Ka); MOE_LOAD(va, sa, Na); }
        while (it < MOE_ITEMS) {
            const int itb = it + NGW;
            if (itb < MOE_ITEMS) { MOE_DESC(itb, sb, Nb, db, Kb); MOE_LOAD(vb, sb, Nb); }
            MOE_PROC(va, da, Ka);
            it = itb + NGW;
            if (itb >= MOE_ITEMS) break;
            if (it < MOE_ITEMS) { MOE_DESC(it, sa, Na, da, Ka); MOE_LOAD(va, sa, Na); }
            MOE_PROC(vb, db, Kb);
        }
#undef MOE_DESC
#undef MOE_LOAD
#undef MOE_PROC
    }
    { v4u* z = (v4u*)(ws + WS_WIN + (size_t)INW * DM * 2); const int n16 = (INWP - INW) * DM * 2 / 16;
      for (int i = (F.vcu * NWAVES + F.wave) * 64 + F.lane; i < n16; i += NGW * 64) z[i] = (v4u){0u, 0u, 0u, 0u}; }
    { float* wrt = (float*)(ws + WS_WRT); const float* wr = a.in[I_WR];
      for (int i = (F.vcu * NWAVES + F.wave) * 64 + F.lane; i < NE * DM; i += NGW * 64) { const int e = i / DM, k = i % DM; wrt[i] = wr[k * NE + e]; } }
    { const float* x = a.in[I_X]; bf16* xb = (bf16*)(ws + WS_XB);
      for (int m = gw; m < T; m += NGW) { const f32x4* xr = (const f32x4*)(x + (size_t)m * DM) + F.lane; v2u* o = (v2u*)(xb + (size_t)m * DM) + F.lane;
#pragma unroll
          for (int j = 0; j < 4; ++j) { const f32x4 v = xr[64 * j]; o[64 * j] = (v2u){pk2(v.x, v.y), pk2(v.z, v.w)}; } } }
}

__device__ __forceinline__ void p_attention(const Frame& F, const Args& a) {
    unsigned char* ws = a.ws; char* lds = (char*)F.lds;
    const bf16* QG = (const bf16*)(ws + WS_QG); const bf16* KG = (const bf16*)(ws + WS_KG); const bf16* VG = (const bf16*)(ws + WS_VG);
    const bf16* QMLA = (const bf16*)(ws + WS_QMLA); const bf16* KN = (const bf16*)(ws + WS_KN); const bf16* KPE = (const bf16*)(ws + WS_KPE); const bf16* VMLA = (const bf16*)(ws + WS_VMLA);
    bf16* O = (bf16*)(ws + WS_O);
    for (int U = F.vcu; U < 2048; U += F.G) {
        if (U < 1024) { const int qb = U & 7, hq = (U >> 3) & 7, kvh = hq >> 2, b = U >> 6; const size_t r0 = (size_t)b * SEQ + qb * 256;
            att::attn_unit<64>(QG + r0 * 512 + hq * 64, 512, KG + (size_t)b * SEQ * 128 + kvh * 64, 128, KG, 128, VG + (size_t)b * SEQ * 128 + kvh * 64, 128, O + r0 * 1024 + hq * 64, 1024, lds, F.wave); }
        else { const int V = U - 1024, qb = V & 7, h = (V >> 3) & 7, b = V >> 6; const size_t r0 = (size_t)b * SEQ + qb * 256;
            att::attn_unit<96>(QMLA + r0 * 768 + h * 96, 768, KN + (size_t)b * SEQ * 512 + h * 64, 512, KPE + (size_t)b * SEQ * 32, 32, VMLA + (size_t)b * SEQ * 512 + h * 64, 512, O + r0 * 1024 + 512 + h * 64, 1024, lds, F.wave); }
    }
}
__device__ __forceinline__ void ln_row(f32x4 (&v)[4], const float* g, const float* bta, int lane) {
    float s = 0.f;
#pragma unroll
    for (int j = 0; j < 4; ++j) s += (v[j].x + v[j].y) + (v[j].z + v[j].w);
    const float mean = wave_sum(s) * (1.f / DM); float s2 = 0.f;
#pragma unroll
    for (int j = 0; j < 4; ++j) { v[j] = v[j] - mean; s2 += (v[j].x * v[j].x + v[j].y * v[j].y) + (v[j].z * v[j].z + v[j].w * v[j].w); }
    const float rstd = 1.f / sqrtf(wave_sum(s2) * (1.f / DM) + LN_EPS);
#pragma unroll
    for (int j = 0; j < 4; ++j) { const f32x4 gg = *((const f32x4*)g + lane + 64 * j), bb = *((const f32x4*)bta + lane + 64 * j); v[j] = v[j] * rstd * gg + bb; }
}
__device__ __forceinline__ void p7_ln1_router(const Frame& F, const Args& a, bf16* xdst) {
    const int gw = F.vcu * NWAVES + F.wave, NGW = F.G * NWAVES, l = F.lane;
    unsigned char* ws = a.ws; const float* xo = a.out; unsigned char* x1q = ws + WS_X1Q; float* aff = (float*)(ws + WS_AFF);
    { const f32x4* wg = (const f32x4*)(ws + WS_WRT); LAS f32x4* wl = (LAS f32x4*)F.lds;
      for (int i = F.tid; i < NE * DM / 4; i += NWAVES * 64) wl[i] = wg[i];
      __syncthreads(); }
    const LAS f32x4* wrt = (const LAS f32x4*)F.lds;
    const bool h5 = (l & 32) != 0, h4 = (l & 16) != 0, h3 = (l & 8) != 0, h2 = (l & 4) != 0;
    f32x4 nx[4];
    if (gw < T) {
#pragma unroll
        for (int j = 0; j < 4; ++j) nx[j] = *((const f32x4*)(xo + (size_t)gw * DM) + l + 64 * j); }
    for (int m = gw; m < T; m += NGW) {
        f32x4 v[4];
#pragma unroll
        for (int j = 0; j < 4; ++j) v[j] = nx[j];
        if (m + NGW < T) {
#pragma unroll
            for (int j = 0; j < 4; ++j) nx[j] = *((const f32x4*)(xo + (size_t)(m + NGW) * DM) + l + 64 * j); }
        ln_row(v, a.in[I_LNAG], a.in[I_LNAB], l);
#pragma unroll
        for (int j = 0; j < 4; ++j) { *((v2u*)(xdst + (size_t)m * DM) + l + 64 * j) = (v2u){pk2(v[j].x, v[j].y), pk2(v[j].z, v[j].w)}; *((unsigned*)(x1q + (size_t)m * DM) + l + 64 * j) = pg8::pk4_fp8(v[j].x, v[j].y, v[j].z, v[j].w); }
        float s16[NE];
#pragma unroll
        for (int e = 0; e < NE; ++e) { float s = 0.f;
#pragma unroll
            for (int j = 0; j < 4; ++j) { const f32x4 w = wrt[e * (DM / 4) + l + 64 * j]; s += (v[j].x * w.x + v[j].y * w.y) + (v[j].z * w.z + v[j].w * w.w); }
            s16[e] = s; if ((e & 3) == 3) asm volatile("" ::: "memory"); }
        float t8[8], t4[4], t2[2];
#pragma unroll
        for (int i = 0; i < 8; ++i) { const float mine = h5 ? s16[i + 8] : s16[i], oth = h5 ? s16[i] : s16[i + 8]; t8[i] = mine + __shfl_xor(oth, 32); }
#pragma unroll
        for (int i = 0; i < 4; ++i) { const float mine = h4 ? t8[i + 4] : t8[i], oth = h4 ? t8[i] : t8[i + 4]; t4[i] = mine + __shfl_xor(oth, 16); }
#pragma unroll
        for (int i = 0; i < 2; ++i) { const float mine = h3 ? t4[i + 2] : t4[i], oth = h3 ? t4[i] : t4[i + 2]; t2[i] = mine + __shfl_xor(oth, 8); }
        float lg = (h2 ? t2[1] : t2[0]) + __shfl_xor(h2 ? t2[0] : t2[1], 4);
        lg += __shfl_xor(lg, 2); lg += __shfl_xor(lg, 1);
        float mx = lg;
#pragma unroll
        for (int o = 4; o < 64; o <<= 1) mx = fmaxf(mx, __shfl_xor(mx, o));
        const float ex = expf(lg - mx); float den = ex;
#pragma unroll
        for (int o = 4; o < 64; o <<= 1) den += __shfl_xor(den, o);
        const int b = m >> 11, s_ = m & (SEQ - 1);
        if ((l & 3) == 0) aff[((size_t)b * NE + (l >> 2)) * SEQ + s_] = ex / den;
    }
}
__device__ __forceinline__ unsigned block_excl_scan(const Frame& F, unsigned cnt, LAS unsigned* wsum, unsigned& total) {
    unsigned inc = cnt;
#pragma unroll
    for (int o = 1; o < 64; o <<= 1) { const unsigned t = __shfl_up(inc, o); if (F.lane >= o) inc += t; }
    __syncthreads();
    if (F.lane == 63) wsum[F.wave] = inc;
    __syncthreads();
    unsigned base = 0, tot = 0;
#pragma unroll
    for (int w = 0; w < NWAVES; ++w) { const unsigned s = wsum[w]; if (w < F.wave) base += s; tot += s; }
    total = tot; return base + inc - cnt;
}
__device__ __forceinline__ void p8_topk(const Frame& F, const Args& a) {
    unsigned char* ws = a.ws; const float* aff = (const float*)(ws + WS_AFF);
    int* rowmap = (int*)(ws + WS_ROWMAP); float* gval = (float*)(ws + WS_GVAL); int* sel = (int*)(ws + WS_SEL);
    LAS unsigned* hist = (LAS unsigned*)F.lds; LAS unsigned* wsum = hist + 256; LAS unsigned* bc = hist + 272;
    for (int task = F.vcu; task < NB * NE; task += F.G) {
        const int b = task / NE, e = task % NE;
        const f32x4 vv = *((const f32x4*)(aff + (size_t)task * SEQ) + F.tid);
        const float vf[4] = {vv.x, vv.y, vv.z, vv.w}; unsigned u[4];
#pragma unroll
        for (int i = 0; i < 4; ++i) u[i] = __builtin_bit_cast(unsigned, vf[i]);
        unsigned prefix = 0, kneed = CAP;
#pragma unroll 1
        for (int pass = 0; pass < 4; ++pass) {
            const int shift = 24 - 8 * pass;
            __syncthreads();
            if (F.tid < 256) hist[F.tid] = 0u;
            __syncthreads();
#pragma unroll
            for (int i = 0; i < 4; ++i) { const bool in = (pass == 0) || ((u[i] >> (shift + 8)) == prefix); if (in) atomicAdd((unsigned*)&hist[(u[i] >> shift) & 255u], 1u); }
            __syncthreads();
            if (F.wave == 0) {
                unsigned h0 = hist[4 * F.lane], h1 = hist[4 * F.lane + 1], h2 = hist[4 * F.lane + 2], h3 = hist[4 * F.lane + 3];
                const unsigned tl = h0 + h1 + h2 + h3; unsigned suf = tl;
#pragma unroll
                for (int o = 1; o < 64; o <<= 1) { const unsigned t = __shfl_down(suf, o); if (F.lane + o < 64) suf += t; }
                const unsigned above = suf - tl;
                const unsigned a3 = above, a2 = above + h3, a1 = a2 + h2, a0 = a1 + h1;
                int found = -1; unsigned nk = 0;
                if (a3 < kneed && kneed <= a3 + h3) { found = 4 * F.lane + 3; nk = kneed - a3; }
                else if (a2 < kneed && kneed <= a2 + h2) { found = 4 * F.lane + 2; nk = kneed - a2; }
                else if (a1 < kneed && kneed <= a1 + h1) { found = 4 * F.lane + 1; nk = kneed - a1; }
                else if (a0 < kneed && kneed <= a0 + h0) { found = 4 * F.lane; nk = kneed - a0; }
                if (found >= 0) { bc[0] = (unsigned)found; bc[1] = nk; }
            }
            __syncthreads();
            prefix = (prefix << 8) | bc[0]; kneed = bc[1];
        }
        unsigned ceq = 0;
#pragma unroll
        for (int i = 0; i < 4; ++i) ceq += (u[i] == prefix) ? 1u : 0u;
        unsigned tot; unsigned eqbase = block_excl_scan(F, ceq, wsum, tot);
        bool take[4]; unsigned csel = 0;
#pragma unroll
        for (int i = 0; i < 4; ++i) { const bool eq = (u[i] == prefix); take[i] = (u[i] > prefix) || (eq && eqbase < kneed); if (eq) ++eqbase; csel += take[i] ? 1u : 0u; }
        unsigned slot = block_excl_scan(F, csel, wsum, tot);
#pragma unroll
        for (int i = 0; i < 4; ++i) { const int tkn = F.tid * 4 + i; int sv = -1;
            if (take[i]) { sv = (int)slot; const size_t r = (size_t)e * (NB * CAP) + b * CAP + slot; rowmap[r] = b * SEQ + tkn; gval[r] = vf[i]; ++slot; }
            sel[((size_t)b * SEQ + tkn) * NE + e] = sv; }
    }
}
__device__ __forceinline__ void acc_bf16x4(f32x4& v, const v2u w, const float f) {
    v.x += f * bf2f(w.x & 0xffffu); v.y += f * bf2f(w.x >> 16); v.z += f * bf2f(w.y & 0xffffu); v.w += f * bf2f(w.y >> 16);
}
__device__ __forceinline__ void p11_ln2(const Frame& F, const Args& a, bf16* xdst) {
    const int gw = F.vcu * NWAVES + F.wave, NGW = F.G * NWAVES, l = F.lane;
    unsigned char* ws = a.ws; const bf16* x1b = (const bf16*)(ws + WS_X1B); const bf16* yexp = (const bf16*)(ws + WS_YEXP); const int* sel = (const int*)(ws + WS_SEL);
    const float* p = a.in[I_P]; bf16* pb = (bf16*)(ws + WS_PB);
    v2u nx[4]; f32x4 npv; int nsv = -1;
    if (gw < T) {
#pragma unroll
        for (int j = 0; j < 4; ++j) nx[j] = *((const v2u*)(x1b + (size_t)gw * DM) + l + 64 * j);
        nsv = (l < NE) ? sel[(size_t)gw * NE + l] : -1; npv = *((const f32x4*)(p + (size_t)gw * PLE) + l); }
    for (int m = gw; m < T; m += NGW) {
        const int b = m >> 11;
        f32x4 v[4]; const int sv = nsv; const f32x4 pv = npv;
#pragma unroll
        for (int j = 0; j < 4; ++j) { v[j] = (f32x4){0.f, 0.f, 0.f, 0.f}; acc_bf16x4(v[j], nx[j], ALPHA); }
        if (m + NGW < T) { const int m1 = m + NGW;
#pragma unroll
            for (int j = 0; j < 4; ++j) nx[j] = *((const v2u*)(x1b + (size_t)m1 * DM) + l + 64 * j);
            nsv = (l < NE) ? sel[(size_t)m1 * NE + l] : -1; npv = *((const f32x4*)(p + (size_t)m1 * PLE) + l); }
        unsigned mask = (unsigned)__ballot(sv >= 0);
        while (mask) {
            const int e0 = __builtin_ctz(mask); mask &= mask - 1;
            const int e1 = mask ? __builtin_ctz(mask) : e0; const float f1 = mask ? 1.f : 0.f; mask &= mask - 1;
            const int e2 = mask ? __builtin_ctz(mask) : e0; const float f2 = mask ? 1.f : 0.f; mask &= mask - 1;
            const int e3 = mask ? __builtin_ctz(mask) : e0; const float f3 = mask ? 1.f : 0.f; mask &= mask - 1;
            const v2u* r0 = (const v2u*)(yexp + ((size_t)e0 * (NB * CAP) + b * CAP + __builtin_amdgcn_readlane(sv, e0)) * DM) + l;
            const v2u* r1 = (const v2u*)(yexp + ((size_t)e1 * (NB * CAP) + b * CAP + __builtin_amdgcn_readlane(sv, e1)) * DM) + l;
            const v2u* r2 = (const v2u*)(yexp + ((size_t)e2 * (NB * CAP) + b * CAP + __builtin_amdgcn_readlane(sv, e2)) * DM) + l;
            const v2u* r3 = (const v2u*)(yexp + ((size_t)e3 * (NB * CAP) + b * CAP + __builtin_amdgcn_readlane(sv, e3)) * DM) + l;
            v2u w0[4], w1[4], w2[4], w3[4];
#pragma unroll
            for (int j = 0; j < 4; ++j) { w0[j] = r0[64 * j]; w1[j] = r1[64 * j]; w2[j] = r2[64 * j]; w3[j] = r3[64 * j]; }
#pragma unroll
            for (int j = 0; j < 4; ++j) { acc_bf16x4(v[j], w0[j], 1.f); acc_bf16x4(v[j], w1[j], f1); acc_bf16x4(v[j], w2[j], f2); acc_bf16x4(v[j], w3[j], f3); }
        }
        ln_row(v, a.in[I_LNFG], a.in[I_LNFB], l);
#pragma unroll
        for (int j = 0; j < 4; ++j) *((v2u*)(xdst + (size_t)m * DM) + l + 64 * j) = (v2u){pk2(v[j].x, v[j].y), pk2(v[j].z, v[j].w)};
        *((v2u*)(pb + (size_t)m * PLE) + l) = (v2u){pk2(pv.x, pv.y), pk2(pv.z, pv.w)};
    }
}
__device__ __forceinline__ void p13_ln3(const Frame& F, const Args& a, float* xdst) {
    const int gw = F.vcu * NWAVES + F.wave, NGW = F.G * NWAVES, l = F.lane;
    float* xo = a.out;
    f32x4 nx[4];
    if (gw < T) {
#pragma unroll
        for (int j = 0; j < 4; ++j) nx[j] = *((const f32x4*)(xo + (size_t)gw * DM) + l + 64 * j); }
    for (int m = gw; m < T; m += NGW) {
        f32x4 v[4];
#pragma unroll
        for (int j = 0; j < 4; ++j) v[j] = nx[j];
        if (m + NGW < T) {
#pragma unroll
            for (int j = 0; j < 4; ++j) nx[j] = *((const f32x4*)(xo + (size_t)(m + NGW) * DM) + l + 64 * j); }
        ln_row(v, a.in[I_LNPG], a.in[I_LNPB], l);
#pragma unroll
        for (int j = 0; j < 4; ++j) *((f32x4*)(xdst + (size_t)m * DM) + l + 64 * j) = v[j];
    }
}

__global__ void __launch_bounds__(NWAVES * 64, 2) fwd(Args args) {
    extern __shared__ __attribute__((aligned(16))) unsigned char lds[];
    Frame F;
    F.lds = (LAS unsigned char*)lds; F.wave = __builtin_amdgcn_readfirstlane(threadIdx.x >> 6); F.lane = fresh_lane(); F.tid = F.wave * 64 + F.lane;
    F.G = gridDim.x; { const int bx = blockIdx.x; F.vcu = (F.G % 8 == 0) ? (bx % 8) * (F.G / 8) + bx / 8 : bx; }
    unsigned char* ws = args.ws;
    const int lo = args.ph_lo, hi = args.ph_hi;
#define IN(k) (lo <= (k) && (k) < hi)
    volatile LAS unsigned* MISC = (volatile LAS unsigned*)(F.lds + pg8::LDS_CTL_OFF + 320);
    for (int u = F.tid; u < 256; u += NWAVES * 64) ((LAS unsigned*)(F.lds + pg8::LDS_CTL_OFF))[u] = 0u;
    for (int u = F.tid; u < 1024 + 512; u += NWAVES * 64) {
        const bool big = u < 1024; const int v = big ? u : u - 1024, pos = big ? (v >> 4) : (v >> 3), i = big ? (v & 15) : (v & 7);
        float rev = (float)pos * exp2f(-(float)i * (big ? pg8::kLog2Base / 16.0f : pg8::kLog2Base / 8.0f)) * pg8::kInv2Pi; rev = rev - floorf(rev);
        *(LAS float*)(F.lds + (big ? pg8::TAB_COS64 : pg8::TAB_COS32) + v * 4) = __builtin_amdgcn_cosf(rev);
        *(LAS float*)(F.lds + (big ? pg8::TAB_SIN64 : pg8::TAB_SIN32) + v * 4) = __builtin_amdgcn_sinf(rev); }
    __syncthreads();
    XcdBarrier bar; bar.bar = (unsigned*)(ws + WS_CTL) + 4096 + args.region * XCD_BAR_WORDS; bar.x = 0; bar.st = nullptr; bar.w = F.wave;
    if (hi - lo > 1) bar = xcd_barrier_post((unsigned*)(ws + WS_CTL) + 4096 + args.region * XCD_BAR_WORDS, MISC + 8, F.wave);
#define PHASE(k) if (IN(k) && (F.lane = fresh_lane(), F.tid = F.wave * 64 + F.lane, true))
#define XDST(k) (args.dummy ? (float*)(ws + WS_R1) : args.out)
#define XDSTB(k) (args.dummy ? (bf16*)(ws + WS_R1) : (bf16*)(ws + WS_X1B))
#define SEAM(k) do { if (IN(k) && IN((k) + 1)) xcd_barrier(bar); } while (0)
    PHASE(0) p0_convert(F, args);
    SEAM(0);
    PHASE(1) { pg8::Gemm g{(const bf16*)(ws + WS_XB), (const bf16*)(ws + WS_WIN), T, INWP, DM}; pg8::StaticOrder S; S.init(T, INWP, F.G, (int)blockIdx.x);
        pg8::EpiProj E{(bf16*)(ws + WS_QG), (bf16*)(ws + WS_KG), (bf16*)(ws + WS_VG), (bf16*)(ws + WS_CQ), (bf16*)(ws + WS_CKV), (bf16*)(ws + WS_KPE), (float*)(ws + WS_SSQ), (float*)(ws + WS_SSKV), args.in[I_QN], args.in[I_KN], F.lds};
        pg8::gemm_phase<pg8::EpiProj, pg8::StaticOrder, true>(F.lds, g, S, E, F.wave); }
    SEAM(1);
    PHASE(2) {
        { pg8::Gemm g{(const bf16*)(ws + WS_CQ), (const bf16*)(ws + WS_WUQ), T, UQW, 256}; pg8::StaticOrder S; S.init(T, UQW, F.G, (int)blockIdx.x);
          pg8::EpiMlaQ E{(bf16*)(ws + WS_QMLA), (const float*)(ws + WS_SSQ), F.lds}; pg8::gemm_phase<pg8::EpiMlaQ, pg8::StaticOrder, true>(F.lds, g, S, E, F.wave); }
        { pg8::Gemm g{(const bf16*)(ws + WS_CKV), (const bf16*)(ws + WS_WUKV), T, UKVW, 256}; pg8::StaticOrder S; S.init(T, UKVW, F.G, (int)blockIdx.x);
          pg8::EpiMlaKV E{(bf16*)(ws + WS_KN), (bf16*)(ws + WS_VMLA), (const float*)(ws + WS_SSKV)}; pg8::gemm_phase<pg8::EpiMlaKV, pg8::StaticOrder, true>(F.lds, g, S, E, F.wave); }
    }
    SEAM(2);
    PHASE(3) p_attention(F, args);
    SEAM(3);
    PHASE(4) { pg8::Gemm g{(const bf16*)(ws + WS_O), (const bf16*)(ws + WS_WOUT), T, DM, DM}; pg8::StaticOrder S; S.init(T, DM, F.G, (int)blockIdx.x);
        pg8::EpiResid E{args.out, args.in[I_X], DM}; pg8::gemm_phase<pg8::EpiResid, pg8::StaticOrder, true>(F.lds, g, S, E, F.wave); }
    SEAM(4);
    PHASE(5) p7_ln1_router(F, args, XDSTB(5));
    SEAM(5);
    PHASE(6) p8_topk(F, args);
    SEAM(6);
    PHASE(7) { pg8::Gemm g{(const bf16*)(ws + WS_X1Q), (const bf16*)(ws + WS_WGU), NE * NB * CAP, 2 * FF, DM / 2}; pg8::GatherOrder S; S.init(NE * NB * CAP, 2 * FF, F.G, (int)blockIdx.x, NB * CAP / 256); S.rowmap = (const int*)(ws + WS_ROWMAP);
        pg8::EpiSwiGLU8 E{ws + WS_H, FF}; pg8::gemm_phase<pg8::EpiSwiGLU8, pg8::GatherOrder, true, true>(F.lds, g, S, E, F.wave); }
    SEAM(7);
    PHASE(8) { pg8::Gemm g{(const bf16*)(ws + WS_H), (const bf16*)(ws + WS_WDN), NE * NB * CAP, DM, FF / 2}; pg8::StaticOrder S; S.init(NE * NB * CAP, DM, F.G, (int)blockIdx.x, NB * CAP / 256);
        pg8::EpiRowScaleBf16 E{(bf16*)(ws + WS_YEXP), DM, (const float*)(ws + WS_GVAL), 1.0f / 256.0f}; pg8::gemm_phase<pg8::EpiRowScaleBf16, pg8::StaticOrder, true, true>(F.lds, g, S, E, F.wave); }
    SEAM(8);
    PHASE(9) p11_ln2(F, args, XDSTB(9));
    SEAM(9);
    PHASE(10) {
        { pg8::Gemm g{(const bf16*)(ws + WS_PB), (const bf16*)(ws + WS_WPP), T, DM, PLE}; pg8::StaticOrder S; S.init(T, DM, F.G, (int)blockIdx.x);
          pg8::EpiF32 E{(float*)(ws + WS_E), DM}; pg8::gemm_phase<pg8::EpiF32, pg8::StaticOrder, true>(F.lds, g, S, E, F.wave); }
        { pg8::Gemm g{(const bf16*)(ws + WS_X1B), (const bf16*)(ws + WS_WPG), T, DM, DM}; pg8::StaticOrder S; S.init(T, DM, F.G, (int)blockIdx.x);
          pg8::EpiPle E{args.out, (const float*)(ws + WS_E), (const bf16*)(ws + WS_X1B), DM}; pg8::gemm_phase<pg8::EpiPle, pg8::StaticOrder, true>(F.lds, g, S, E, F.wave); }
    }
    SEAM(10);
    PHASE(11) p13_ln3(F, args, XDST(11));
#undef IN
#undef SEAM
#undef XDST
#undef XDSTB
}

constexpr int NPHASES = 12;
extern "C" void kernel_launch(void* const* d_in, const int* in_sizes, int n_in, void* d_out, int out_size, void* d_ws, size_t ws_size, hipStream_t stream) {
    static int grid = 0;
    if (grid == 0) {
        if (n_in != 22 || in_sizes[0] != T * DM || out_size != T * DM || ws_size < WS_END) { fprintf(stderr, "kernel_launch: unexpected shapes (n_in %d, in0 %d, out %d, ws %zu < %zu?)\n", n_in, n_in > 0 ? in_sizes[0] : -1, out_size, ws_size, (size_t)WS_END); grid = -1; return; }
        if (hipFuncSetAttribute((const void*)fwd, hipFuncAttributeMaxDynamicSharedMemorySize, LDS_BYTES) != hipSuccess) { fprintf(stderr, "kernel_launch: hipFuncSetAttribute failed\n"); grid = -1; return; }
        int dev = 0, cus = 0, per_cu = 0;
        if (hipGetDevice(&dev) != hipSuccess || hipDeviceGetAttribute(&cus, hipDeviceAttributeMultiprocessorCount, dev) != hipSuccess) { fprintf(stderr, "kernel_launch: device query failed\n"); grid = -1; return; }
        if (hipOccupancyMaxActiveBlocksPerMultiprocessor(&per_cu, (const void*)fwd, NWAVES * 64, LDS_BYTES) != hipSuccess || per_cu < 1) { fprintf(stderr, "kernel_launch: occupancy query says %d blocks per CU\n", per_cu); (void)hipGetLastError(); grid = -1; return; }
        grid = cus;
    }
    if (grid < 0) return;
    Args a{};
    for (int i = 0; i < 22; ++i) a.in[i] = (const float*)d_in[i];
    a.out = (float*)d_out; a.ws = (unsigned char*)d_ws;
    (void)hipMemsetAsync((char*)d_ws + WS_CTL, 0, 65536, stream);
#ifndef PROBE_PHASE
    a.ph_lo = 0; a.ph_hi = NPHASES;
    hipLaunchKernelGGL(fwd, dim3(grid), dim3(NWAVES * 64), LDS_BYTES, stream, a);
#else
    if (PROBE_PHASE > 0) { a.ph_lo = 0; a.ph_hi = PROBE_PHASE; a.region = 0; hipLaunchKernelGGL(fwd, dim3(grid), dim3(NWAVES * 64), LDS_BYTES, stream, a); }
    a.ph_lo = PROBE_PHASE; a.ph_hi = PROBE_PHASE + 1; a.dummy = 1; a.region = 1; hipLaunchKernelGGL(fwd, dim3(grid), dim3(NWAVES * 64), LDS_BYTES, stream, a);
    a.ph_lo = PROBE_PHASE; a.ph_hi = NPHASES; a.dummy = 0; a.region = 2; hipLaunchKernelGGL(fwd, dim3(grid), dim3(NWAVES * 64), LDS_BYTES, stream, a);
#endif
}
```

```cpp
#include <hip/hip_runtime.h>
#include <cstdio>
#include <cstdint>

#ifndef MK_ONE_LAUNCH
#define MK_ONE_LAUNCH 1
#endif

__device__ __forceinline__ int fresh_lane() { int l; asm volatile("v_mbcnt_lo_u32_b32 %0, -1, 0\n\tv_mbcnt_hi_u32_b32 %0, -1, %0" : "=v"(l)); return l; }
namespace pg8 {
#define PG8_LAS __attribute__((address_space(3)))
typedef unsigned short bf16_t;
typedef short bf16x8 __attribute__((ext_vector_type(8)));
typedef float f32x4 __attribute__((ext_vector_type(4)));
typedef unsigned u32x4 __attribute__((ext_vector_type(4)));
typedef unsigned u32x2 __attribute__((ext_vector_type(2)));
constexpr int BM = 256, BK = 64, HALF = 128, HTB = HALF * BK * 2  , STAGE_BYTES = 8 * HTB, NXCD = 8, WGM = 8;

__host__ __device__ __forceinline__ int lds_byte(int r, int c) { const int st = (r >> 4) * 2 + (c >> 5), rr = r & 15, cc = c & 31, ob = rr * 64 + cc * 2; return st * 1024 + (ob ^ (((ob >> 9) & 1) << 5)); }
__host__ __device__ __forceinline__ void stage_rc(int b, int& R, int& C) { const int st = b / 1024, sb = b % 1024, swz = sb ^ (((sb >> 9) & 1) << 5); R = (st >> 1) * 16 + swz / 64; C = (st & 1) * 32 + (swz % 64) / 2; }
__host__ __device__ __forceinline__ int perm32(int rho) { const int n = rho >> 4, i = rho & 15; return 8 * (i >> 2) + 4 * n + (i & 3); }

struct Unit { int pm, pn; };
struct Gemm { const bf16_t* A; const bf16_t* Bt; int M, N, K; };

struct StaticOrder {
    static constexpr bool GATHER = false;
    int nM, nN, nwg, G, c, mpe;
    __host__ __device__ void init(int M, int N, int G_, int c_, int mpe_ = 0) { nM = M / BM; nN = N / BM; nwg = nM * nN; G = G_; c = c_; mpe = mpe_; }
    __host__ __device__ bool next(int i, Unit& u) const {
        const long L = (long)i * G + c; if (L >= nwg) return false;
        int wgid = (int)L; { const int q = nwg / NXCD, r = nwg % NXCD, xcd = wgid % NXCD, off = wgid / NXCD; wgid = (xcd < r ? xcd * (q + 1) : r * (q + 1) + (xcd - r) * q) + off; }
        const int nig = WGM * nN, gid = wgid / nig, fm = gid * WGM, gsz = (nM - fm) < WGM ? (nM - fm) : WGM;
        u.pm = fm + ((wgid % nig) % gsz); u.pn = (wgid % nig) / gsz; return true;
    }
    __host__ __device__ __forceinline__ int btile(const Unit& u) const { return mpe ? (u.pm / mpe) * nN + u.pn : u.pn; }
    __device__ __forceinline__ unsigned arow(const Unit&, int) const { return 0u; }
};
struct GatherOrder : StaticOrder {
    static constexpr bool GATHER = true;
    const int* rowmap;
    __device__ __forceinline__ unsigned arow(const Unit& u, int r) const { return (unsigned)rowmap[u.pm * BM + r]; }
};

__device__ __forceinline__ unsigned cvt_pk_bf16(float lo, float hi) { unsigned r; asm volatile("v_cvt_pk_bf16_f32 %0, %1, %2" : "=v"(r) : "v"(lo), "v"(hi)); return r; }

struct EpiF32 {
    static constexpr bool PERM = false;
    float* O; int ldc;
    __device__ __forceinline__ void operator()(const f32x4 (&acc)[2][2][4][2], const Unit& u, int wr, int wc, int fr, int fq) const {
        { const int l_ = fresh_lane(); fr = l_ & 15; fq = l_ >> 4; }
        const int row0 = u.pm * BM + wr * 64 + fr, col0 = u.pn * BM + wc * 32 + 4 * fq;
#pragma unroll
        for (int ai = 0; ai < 2; ++ai)
#pragma unroll
            for (int m = 0; m < 4; ++m) { float* rowp = O + (size_t)(row0 + ai * HALF + m * 16) * ldc + col0;
#pragma unroll
                for (int bj = 0; bj < 2; ++bj)
#pragma unroll
                    for (int n = 0; n < 2; ++n) *(f32x4*)(rowp + bj * HALF + n * 16) = acc[ai][bj][m][n]; }
    }
};
struct EpiSwiGLU {
    static constexpr bool PERM = false;
    bf16_t* H; int ldh;
    __device__ __forceinline__ void operator()(const f32x4 (&acc)[2][2][4][2], const Unit& u, int wr, int wc, int fr, int fq) const {
        { const int l_ = fresh_lane(); fr = l_ & 15; fq = l_ >> 4; }
        const int row0 = u.pm * BM + wr * 64 + fr, col0 = u.pn * HALF + wc * 32 + 4 * fq;
#pragma unroll
        for (int ai = 0; ai < 2; ++ai)
#pragma unroll
            for (int m = 0; m < 4; ++m) { bf16_t* rowp = H + (size_t)(row0 + ai * HALF + m * 16) * ldh + col0;
#pragma unroll
                for (int n = 0; n < 2; ++n) { const f32x4 g = acc[ai][0][m][n], up = acc[ai][1][m][n]; float h[4];
#pragma unroll
                    for (int j = 0; j < 4; ++j) { const float s = __builtin_amdgcn_rcpf(1.0f + __builtin_amdgcn_exp2f(-1.4426950408889634f * g[j])); h[j] = g[j] * s * up[j]; }
                    u32x2 w; w.x = cvt_pk_bf16(h[0], h[1]); w.y = cvt_pk_bf16(h[2], h[3]); *(u32x2*)(rowp + n * 16) = w; } }
    }
};
__device__ __forceinline__ unsigned pk4_fp8(float a, float b, float c, float d) { int w = __builtin_amdgcn_cvt_pk_fp8_f32(a, b, 0, false); w = __builtin_amdgcn_cvt_pk_fp8_f32(c, d, w, true); return (unsigned)w; }
struct EpiSwiGLU8 {
    static constexpr bool PERM = true;
    unsigned char* H; int ldh;
    __device__ __forceinline__ void operator()(const f32x4 (&acc)[2][2][4][2], const Unit& u, int wr, int wc, int fr, int fq) const {
        { const int l_ = fresh_lane(); fr = l_ & 15; fq = l_ >> 4; }
        const int row0 = u.pm * BM + wr * 64 + fr, col0 = u.pn * HALF + wc * 32 + 8 * fq;
#pragma unroll
        for (int ai = 0; ai < 2; ++ai)
#pragma unroll
            for (int m = 0; m < 4; ++m) { unsigned char* rowp = H + (size_t)(row0 + ai * HALF + m * 16) * ldh + col0; float h[2][4];
#pragma unroll
                for (int n = 0; n < 2; ++n) { const f32x4 g = acc[ai][0][m][n], up = acc[ai][1][m][n];
#pragma unroll
                    for (int j = 0; j < 4; ++j) { const float gg = g[j] * 0.03125f; const float s = __builtin_amdgcn_rcpf(1.0f + __builtin_amdgcn_exp2f(-1.4426950408889634f * gg)); h[n][j] = gg * s * up[j] * 0.25f; } }
                u32x2 w; w.x = pk4_fp8(h[0][0], h[0][1], h[0][2], h[0][3]); w.y = pk4_fp8(h[1][0], h[1][1], h[1][2], h[1][3]); *(u32x2*)rowp = w; }
    }
};
struct EpiRowScaleBf16 {
    static constexpr bool PERM = false;
    bf16_t* O; int ldc; const float* rs; float mul;
    __device__ __forceinline__ void operator()(const f32x4 (&acc)[2][2][4][2], const Unit& u, int wr, int wc, int fr, int fq) const {
        { const int l_ = fresh_lane(); fr = l_ & 15; fq = l_ >> 4; }
        const int row0 = u.pm * BM + wr * 64 + fr, col0 = u.pn * BM + wc * 32 + 4 * fq;
#pragma unroll
        for (int ai = 0; ai < 2; ++ai)
#pragma unroll
            for (int m = 0; m < 4; ++m) { int row = row0 + ai * HALF + m * 16; asm volatile("" : "+v"(row) :: "memory"); const float s = rs[row] * mul; bf16_t* rowp = O + (size_t)row * ldc + col0;
#pragma unroll
                for (int bj = 0; bj < 2; ++bj)
#pragma unroll
                    for (int n = 0; n < 2; ++n) { const f32x4 v = acc[ai][bj][m][n] * s; u32x2 w; w.x = cvt_pk_bf16(v[0], v[1]); w.y = cvt_pk_bf16(v[2], v[3]); *(u32x2*)(rowp + bj * HALF + n * 16) = w; } }
    }
};

constexpr int LDS_CTL_OFF = 133120  , TAB_OFF = LDS_CTL_OFF + 1024, TAB_COS64 = TAB_OFF, TAB_SIN64 = TAB_OFF + 4096, TAB_COS32 = TAB_OFF + 8192, TAB_SIN32 = TAB_OFF + 10240;
constexpr float kRmsEps = 1e-6f, kAlpha = 1.189207115002721f, kInv2Pi = 0.15915494309189535f, kLog2Base = 13.287712379549449f;
__device__ __forceinline__ void sincos_rev(float pos, float ivr, float& s, float& c) { float rev = pos * ivr; rev = rev - floorf(rev); s = __builtin_amdgcn_sinf(rev); c = __builtin_amdgcn_cosf(rev); }
__device__ __forceinline__ void st_bf16x4(bf16_t* p, const f32x4 v) { u32x2 w; w.x = cvt_pk_bf16(v[0], v[1]); w.y = cvt_pk_bf16(v[2], v[3]); *(u32x2*)p = w; }
__device__ __forceinline__ float sumsq4(const f32x4 x) { return (x[0] * x[0] + x[1] * x[1]) + (x[2] * x[2] + x[3] * x[3]); }
struct EpiProj {
    static constexpr bool PERM = false;
    bf16_t *QG, *KG, *VG, *CQ, *CKV, *KPE; float *SSQ, *SSKV; const float *qn, *kn; PG8_LAS const unsigned char* lds;
    __device__ __forceinline__ void operator()(const f32x4 (&acc)[2][2][4][2], const Unit& u, int wr, int wc, int fr, int fq) const {
        { const int l_ = fresh_lane(); fr = l_ & 15; fq = l_ >> 4; }
        const int pn = u.pn, row0 = u.pm * BM + wr * 64 + fr;
        if (pn <= 2) {
            if (pn == 2 && wc >= 2) {
#pragma unroll
                for (int ai = 0; ai < 2; ++ai)
#pragma unroll
                    for (int m = 0; m < 4; ++m) { bf16_t* rowp = VG + (size_t)(row0 + ai * HALF + m * 16) * 128 + (wc - 2) * 64 + 4 * fq;
#pragma unroll
                        for (int bj = 0; bj < 2; ++bj)
#pragma unroll
                            for (int n = 0; n < 2; ++n) st_bf16x4(rowp + 32 * bj + 16 * n, acc[ai][bj][m][n]); }
            } else {
                const float* gn = (pn < 2) ? qn : kn;
                bf16_t* dst = (pn < 2) ? QG + (pn * 4 + wc) * 64 : KG + wc * 64; const int ldd = (pn < 2) ? 512 : 128;
                const int prow = 4 * (u.pm & 7) + wr;
#pragma unroll
                for (int m = 0; m < 4; ++m)
#pragma unroll
                    for (int ai = 0; ai < 2; ++ai) {
                        float ss = (sumsq4(acc[ai][0][m][0]) + sumsq4(acc[ai][0][m][1])) + (sumsq4(acc[ai][1][m][0]) + sumsq4(acc[ai][1][m][1]));
                        ss += __shfl_xor(ss, 16); ss += __shfl_xor(ss, 32);
                        const float rs = 1.0f / sqrtf(ss * (1.0f / 64.0f) + kRmsEps);
                        int row = row0 + ai * HALF + m * 16; asm volatile("" : "+v"(row) :: "memory");
                        bf16_t* rowp = dst + (size_t)row * ldd + 4 * fq;
#pragma unroll
                        for (int bj = 0; bj < 2; ++bj) { const int pos = bj ? (16 * m + fr) : (prow + 2 * ai);
                            const f32x4 c = *(const PG8_LAS f32x4*)(lds + TAB_COS64 + pos * 64 + fq * 16), s = *(const PG8_LAS f32x4*)(lds + TAB_SIN64 + pos * 64 + fq * 16);
                            const f32x4 g0 = *(const f32x4*)(gn + 32 * bj + 4 * fq), g1 = *(const f32x4*)(gn + 32 * bj + 16 + 4 * fq);
                            const f32x4 x1 = acc[ai][bj][m][0] * rs * g0, x2 = acc[ai][bj][m][1] * rs * g1;
                            st_bf16x4(rowp + 32 * bj, x1 * c - x2 * s); st_bf16x4(rowp + 32 * bj + 16, x2 * c + x1 * s); }
                        asm volatile("" ::: "memory"); }
            }
        } else if (pn <= 4) {
            bf16_t* dst = (pn == 3) ? CQ : CKV; float* sd = (pn == 3) ? SSQ : SSKV;
#pragma unroll
            for (int ai = 0; ai < 2; ++ai)
#pragma unroll
                for (int m = 0; m < 4; ++m) { int row = row0 + ai * HALF + m * 16; asm volatile("" : "+v"(row) :: "memory");
                    float ss = (sumsq4(acc[ai][0][m][0]) + sumsq4(acc[ai][0][m][1])) + (sumsq4(acc[ai][1][m][0]) + sumsq4(acc[ai][1][m][1]));
                    ss += __shfl_xor(ss, 16); ss += __shfl_xor(ss, 32);
                    if (fq == 0) sd[(size_t)row * 4 + wc] = ss;
                    bf16_t* rowp = dst + (size_t)row * 256 + wc * 32 + 4 * fq;
#pragma unroll
                    for (int bj = 0; bj < 2; ++bj)
#pragma unroll
                        for (int n = 0; n < 2; ++n) st_bf16x4(rowp + 128 * bj + 16 * n, acc[ai][bj][m][n]); }
        } else if (wc == 0) {
            const int prow = 4 * (u.pm & 7) + wr;
#pragma unroll
            for (int ai = 0; ai < 2; ++ai)
#pragma unroll
                for (int m = 0; m < 4; ++m) { const int pos = (fq >> 1) ? (16 * m + fr) : (prow + 2 * ai);
                    const f32x4 c = *(const PG8_LAS f32x4*)(lds + TAB_COS32 + pos * 32 + (fq & 1) * 16), s = *(const PG8_LAS f32x4*)(lds + TAB_SIN32 + pos * 32 + (fq & 1) * 16);
                    const f32x4 x1 = acc[ai][0][m][0], x2 = acc[ai][0][m][1];
                    bf16_t* rowp = KPE + (size_t)(row0 + ai * HALF + m * 16) * 32 + 16 * (fq >> 1) + 4 * (fq & 1);
                    st_bf16x4(rowp, x1 * c - x2 * s); st_bf16x4(rowp + 8, x2 * c + x1 * s); }
        }
    }
};
struct EpiMlaQ {
    static constexpr bool PERM = false;
    bf16_t* QM; const float* SSQ; PG8_LAS const unsigned char* lds;
    __device__ __forceinline__ void operator()(const f32x4 (&acc)[2][2][4][2], const Unit& u, int wr, int wc, int fr, int fq) const {
        { const int l_ = fresh_lane(); fr = l_ & 15; fq = l_ >> 4; }
        const int pn = u.pn, row0 = u.pm * BM + wr * 64 + fr, prow = 4 * (u.pm & 7) + wr;
#pragma unroll
        for (int ai = 0; ai < 2; ++ai)
#pragma unroll
            for (int m = 0; m < 4; ++m) { int row = row0 + ai * HALF + m * 16; asm volatile("" : "+v"(row) :: "memory"); const f32x4 p = *(const f32x4*)(SSQ + (size_t)row * 4);
                const float rs = 1.0f / sqrtf(((p[0] + p[1]) + (p[2] + p[3])) * (1.0f / 256.0f) + kRmsEps); bf16_t* rowp = QM + (size_t)row * 768;
                if (pn < 2) {
#pragma unroll
                    for (int bj = 0; bj < 2; ++bj)
#pragma unroll
                        for (int n = 0; n < 2; ++n) st_bf16x4(rowp + (4 * pn + 2 * bj + (wc >> 1)) * 96 + 32 * (wc & 1) + 16 * n + 4 * fq, acc[ai][bj][m][n] * rs);
                } else {
                    const int pos = (fq >> 1) ? (16 * m + fr) : (prow + 2 * ai);
                    const f32x4 c = *(const PG8_LAS f32x4*)(lds + TAB_COS32 + pos * 32 + (fq & 1) * 16), s = *(const PG8_LAS f32x4*)(lds + TAB_SIN32 + pos * 32 + (fq & 1) * 16);
#pragma unroll
                    for (int bj = 0; bj < 2; ++bj) { const f32x4 x1 = acc[ai][bj][m][0] * rs, x2 = acc[ai][bj][m][1] * rs;
                        bf16_t* hp = rowp + (4 * bj + wc) * 96 + 64 + 16 * (fq >> 1) + 4 * (fq & 1); st_bf16x4(hp, x1 * c - x2 * s); st_bf16x4(hp + 8, x2 * c + x1 * s); }
                }
                asm volatile("" ::: "memory"); }
    }
};
struct EpiMlaKV {
    static constexpr bool PERM = false;
    bf16_t *KN, *VM; const float* SSKV;
    __device__ __forceinline__ void operator()(const f32x4 (&acc)[2][2][4][2], const Unit& u, int wr, int wc, int fr, int fq) const {
        { const int l_ = fresh_lane(); fr = l_ & 15; fq = l_ >> 4; }
        const int row0 = u.pm * BM + wr * 64 + fr;
#pragma unroll
        for (int ai = 0; ai < 2; ++ai)
#pragma unroll
            for (int m = 0; m < 4; ++m) { int row = row0 + ai * HALF + m * 16; asm volatile("" : "+v"(row) :: "memory"); const f32x4 p = *(const f32x4*)(SSKV + (size_t)row * 4);
                const float rs = 1.0f / sqrtf(((p[0] + p[1]) + (p[2] + p[3])) * (1.0f / 256.0f) + kRmsEps);
                bf16_t* rowp = ((wc < 2) ? KN : VM) + (size_t)row * 512 + (wc & 1) * 32 + 4 * fq;
#pragma unroll
                for (int bj = 0; bj < 2; ++bj)
#pragma unroll
                    for (int n = 0; n < 2; ++n) st_bf16x4(rowp + (2 * u.pn + bj) * 64 + 16 * n, acc[ai][bj][m][n] * rs); }
    }
};
struct EpiResid {
    static constexpr bool PERM = false;
    float* O; const float* X; int ldc;
    __device__ __forceinline__ void operator()(const f32x4 (&acc)[2][2][4][2], const Unit& u, int wr, int wc, int fr, int fq) const {
        { const int l_ = fresh_lane(); fr = l_ & 15; fq = l_ >> 4; }
        const int row0 = u.pm * BM + wr * 64 + fr, col0 = u.pn * BM + wc * 32 + 4 * fq;
#pragma unroll
        for (int ai = 0; ai < 2; ++ai)
#pragma unroll
            for (int m = 0; m < 4; ++m) { int row = row0 + ai * HALF + m * 16; asm volatile("" : "+v"(row) :: "memory"); const size_t off = (size_t)row * ldc + col0;
#pragma unroll
                for (int bj = 0; bj < 2; ++bj)
#pragma unroll
                    for (int n = 0; n < 2; ++n) { const f32x4 xv = *(const f32x4*)(X + off + bj * HALF + n * 16); *(f32x4*)(O + off + bj * HALF + n * 16) = xv * kAlpha + acc[ai][bj][m][n]; } }
    }
};
struct EpiPle {
    static constexpr bool PERM = false;
    float* O; const float* E; const bf16_t* X2; int ldc;
    __device__ __forceinline__ void operator()(const f32x4 (&acc)[2][2][4][2], const Unit& u, int wr, int wc, int fr, int fq) const {
        { const int l_ = fresh_lane(); fr = l_ & 15; fq = l_ >> 4; }
        const int row0 = u.pm * BM + wr * 64 + fr, col0 = u.pn * BM + wc * 32 + 4 * fq;
#pragma unroll
        for (int ai = 0; ai < 2; ++ai)
#pragma unroll
            for (int m = 0; m < 4; ++m) { int row = row0 + ai * HALF + m * 16; asm volatile("" : "+v"(row) :: "memory"); const size_t off = (size_t)row * ldc + col0;
#pragma unroll
                for (int bj = 0; bj < 2; ++bj)
#pragma unroll
                    for (int n = 0; n < 2; ++n) { const u32x2 xw = *(const u32x2*)(X2 + off + bj * HALF + n * 16); const f32x4 ev = *(const f32x4*)(E + off + bj * HALF + n * 16), a = acc[ai][bj][m][n];
                        const f32x4 xv = {__builtin_bit_cast(float, xw.x << 16), __builtin_bit_cast(float, xw.x & 0xffff0000u), __builtin_bit_cast(float, xw.y << 16), __builtin_bit_cast(float, xw.y & 0xffff0000u)}; f32x4 o;
#pragma unroll
                        for (int j = 0; j < 4; ++j) o[j] = xv[j] * kAlpha + ev[j] * __builtin_amdgcn_rcpf(1.0f + __builtin_amdgcn_exp2f(-1.4426950408889634f * a[j]));
                        *(f32x4*)(O + off + bj * HALF + n * 16) = o; } }
    }
};

typedef int i32x8 __attribute__((ext_vector_type(8)));
typedef int i32x4 __attribute__((ext_vector_type(4)));
__device__ __forceinline__ i32x8 cat8(bf16x8 a, bf16x8 b) { return __builtin_shufflevector(__builtin_bit_cast(i32x4, a), __builtin_bit_cast(i32x4, b), 0, 1, 2, 3, 4, 5, 6, 7); }
template <class Epi, class Sched, bool ALIGN_EPI, bool FP8 = false>
__device__ __forceinline__ void gemm_phase(PG8_LAS unsigned char* lds, const Gemm g, const Sched& S, const Epi& E, int wid) {
    constexpr bool GATHER = Sched::GATHER;
    const int lane = fresh_lane(), tid = wid * 64 + lane, wr = wid >> 2, wc = wid & 3, fr = lane & 15, fq = lane >> 4;
    const int K = g.K, nt = K / BK;
    unsigned voffB[2], vC0[2], vC1[2], vN0[2], vN1[2]; int RA[2]; unsigned cofA[2];
#pragma unroll
    for (int i = 0; i < 2; ++i) { int R, C; stage_rc(tid * 16 + i * 8192, R, C); const int Rb = Epi::PERM ? ((R & ~31) + perm32(R & 31)) : R;
        vC0[i] = (unsigned)(R * K + C) * 2u; vC1[i] = vC0[i]; vN0[i] = vC0[i]; vN1[i] = vC0[i]; voffB[i] = (unsigned)(Rb * K + C) * 2u; RA[i] = R; cofA[i] = (unsigned)C * 2u; }
    const size_t kstep = (size_t)(BK * 2);
    const size_t hstep = (size_t)HALF * K * 2;
    const size_t hstepA = GATHER ? (size_t)0 : hstep;
    const size_t tstep = 2 * hstep;
    const unsigned ldsw = (unsigned)wid * 1024u;
    const unsigned ldsbase = (unsigned)(uintptr_t)lds + ldsw;
    const int aoff = lds_byte(wr * 64 + fr, fq * 8), boff = lds_byte(wc * 32 + fr, fq * 8);
#define PG8_SA(b, h) (((b) * 2 + (h)) * HTB)
#define PG8_SB(b, h) ((4 + (b) * 2 + (h)) * HTB)
#define PG8_STAGE(bufoff, gbase, voff) do { _Pragma("unroll") for (int _i = 0; _i < 2; ++_i) { unsigned _keep; \
        asm volatile("s_mov_b32 %0, m0\n\ts_mov_b32 m0, %3\n\ts_nop 0\n\tglobal_load_lds_dwordx4 %1, %2\n\ts_mov_b32 m0, %0" \
            : "=&s"(_keep) : "v"((voff)[_i]), "s"((const char*)(gbase)), "s"(ldsbase + (unsigned)((bufoff) + _i * 8192)) : "memory"); } } while (0)
#define PG8_LDA(dst, b, h) do { _Pragma("unroll") for (int m = 0; m < 4; ++m) _Pragma("unroll") for (int k = 0; k < 2; ++k) dst[m][k] = *(const PG8_LAS bf16x8*)(lds + PG8_SA(b, h) + aoff + m * 2048 + k * 1024); } while (0)
#define PG8_LDB(dst, b, h) do { _Pragma("unroll") for (int n = 0; n < 2; ++n) _Pragma("unroll") for (int k = 0; k < 2; ++k) dst[n][k] = *(const PG8_LAS bf16x8*)(lds + PG8_SB(b, h) + boff + n * 2048 + k * 1024); } while (0)
#define PG8_MMA(ai, bj, At, Bt) do { __builtin_amdgcn_s_setprio(1); _Pragma("unroll") for (int m = 0; m < 4; ++m) _Pragma("unroll") for (int n = 0; n < 2; ++n) { \
        if constexpr (FP8) acc[ai][bj][m][n] = __builtin_amdgcn_mfma_scale_f32_16x16x128_f8f6f4(cat8(Bt[n][0], Bt[n][1]), cat8(At[m][0], At[m][1]), acc[ai][bj][m][n], 0, 0, 0, 0x7f7f7f7f, 0, 0x7f7f7f7f); \
        else { _Pragma("unroll") for (int k = 0; k < 2; ++k) acc[ai][bj][m][n] = __builtin_amdgcn_mfma_f32_16x16x32_bf16(Bt[n][k], At[m][k], acc[ai][bj][m][n], 0, 0, 0); } } __builtin_amdgcn_s_setprio(0); } while (0)
#define PG8_WAIT_V(n) asm volatile("s_waitcnt vmcnt(" #n ")" ::: "memory")
#define PG8_WAIT_L(n) asm volatile("s_waitcnt lgkmcnt(" #n ")" ::: "memory")
#define PG8_BAR __builtin_amdgcn_s_barrier()
#define PG8_SCHED __builtin_amdgcn_sched_barrier(0)
#define PG8_AROWS(u, d0, d1) do { if constexpr (GATHER) { _Pragma("unroll") for (int _i = 0; _i < 2; ++_i) { \
        d0[_i] = S.arow(u, RA[_i]) * (unsigned)(K * 2) + cofA[_i]; d1[_i] = S.arow(u, HALF + RA[_i]) * (unsigned)(K * 2) + cofA[_i]; } } } while (0)
    Unit cur, nxt; int ui = 0;
    if (!S.next(0, cur)) return;
    f32x4 acc[2][2][4][2];
#pragma unroll
    for (int a = 0; a < 2; ++a)
#pragma unroll
        for (int b = 0; b < 2; ++b)
#pragma unroll
            for (int m = 0; m < 4; ++m)
#pragma unroll
                for (int n = 0; n < 2; ++n) acc[a][b][m][n] = (f32x4){0.f, 0.f, 0.f, 0.f};
    bf16x8 At[4][2], B0[2][2], B1[2][2];
    const char* cA = GATHER ? (const char*)g.A : (const char*)g.A + (size_t)cur.pm * tstep; const char* cB = (const char*)g.Bt + (size_t)S.btile(cur) * tstep;
    PG8_AROWS(cur, vC0, vC1);
    PG8_STAGE(PG8_SB(0, 0), cB, voffB); PG8_STAGE(PG8_SB(0, 1), cB + hstep, voffB); PG8_STAGE(PG8_SA(0, 0), cA, vC0); PG8_STAGE(PG8_SA(0, 1), cA + hstepA, vC1);
    if (wr == 1) PG8_BAR;
    PG8_WAIT_V(2); PG8_BAR;
    PG8_STAGE(PG8_SB(1, 0), cB + kstep, voffB); PG8_STAGE(PG8_SA(1, 0), cA + kstep, vC0); PG8_STAGE(PG8_SB(1, 1), cB + hstep + kstep, voffB);
    PG8_WAIT_V(6); PG8_BAR;
    for (;;) {
        const bool has_next = S.next(ui + 1, nxt);
        const char* nA = GATHER ? (const char*)g.A : (has_next ? (const char*)g.A + (size_t)nxt.pm * tstep : cA); const char* nB = has_next ? (const char*)g.Bt + (size_t)S.btile(nxt) * tstep : cB;
        if constexpr (GATHER) { if (has_next) { PG8_AROWS(nxt, vN0, vN1); } else { vN0[0] = vC0[0]; vN0[1] = vC0[1]; vN1[0] = vC1[0]; vN1[1] = vC1[1]; } }
#pragma unroll 1
        for (int t = 0; t < nt; t += 2) {
            const bool last = (t == nt - 2);
            const char* a1 = cA + (size_t)(t + 1) * kstep;
            const char* a2 = last ? nA : cA + (size_t)(t + 2) * kstep; const char* b2 = last ? nB : cB + (size_t)(t + 2) * kstep;
            const char* a3 = a2 + kstep; const char* b3 = b2 + kstep;
            PG8_LDB(B0, 0, 0); PG8_LDB(B1, 0, 1); PG8_SCHED; PG8_LDA(At, 0, 0); PG8_STAGE(PG8_SA(1, 1), a1 + hstepA, vC1);
            if constexpr (GATHER) { if (last) { vC0[0] = vN0[0]; vC0[1] = vN0[1]; vC1[0] = vN1[0]; vC1[1] = vN1[1]; } }
            PG8_WAIT_V(8); PG8_WAIT_L(0); PG8_BAR; PG8_MMA(0, 0, At, B0); PG8_MMA(0, 1, At, B1); PG8_BAR; PG8_SCHED;
            PG8_LDA(At, 0, 1); PG8_STAGE(PG8_SB(0, 0), b2, voffB); PG8_STAGE(PG8_SB(0, 1), b2 + hstep, voffB); PG8_STAGE(PG8_SA(0, 0), a2, vC0);
            PG8_WAIT_V(8); PG8_WAIT_L(0); PG8_BAR; PG8_MMA(1, 0, At, B0); PG8_MMA(1, 1, At, B1); PG8_BAR; PG8_SCHED;
            PG8_LDB(B0, 1, 0); PG8_LDB(B1, 1, 1); PG8_SCHED; PG8_LDA(At, 1, 0); PG8_STAGE(PG8_SA(0, 1), a2 + hstepA, vC1);
            PG8_WAIT_V(8); PG8_WAIT_L(0); PG8_BAR; PG8_MMA(0, 0, At, B0); PG8_MMA(0, 1, At, B1); PG8_BAR; PG8_SCHED;
            PG8_LDA(At, 1, 1); PG8_STAGE(PG8_SB(1, 0), b3, voffB); PG8_STAGE(PG8_SB(1, 1), b3 + hstep, voffB); PG8_STAGE(PG8_SA(1, 0), a3, vC0);
            PG8_WAIT_V(8); PG8_WAIT_L(0); PG8_BAR; PG8_MMA(1, 0, At, B0); PG8_MMA(1, 1, At, B1); PG8_BAR; PG8_SCHED;
        }
        if constexpr (ALIGN_EPI) { if (wr == 0) PG8_BAR; }
        E(acc, cur, wr, wc, fr, fq);
        if (!has_next) break;
#pragma unroll
        for (int a = 0; a < 2; ++a)
#pragma unroll
            for (int b = 0; b < 2; ++b)
#pragma unroll
                for (int m = 0; m < 4; ++m)
#pragma unroll
                    for (int n = 0; n < 2; ++n) acc[a][b][m][n] = (f32x4){0.f, 0.f, 0.f, 0.f};
        cur = nxt; cA = nA; cB = nB; ++ui;
        if constexpr (ALIGN_EPI) { if (wr == 1) PG8_BAR; }
    }
    PG8_WAIT_V(0);
    if constexpr (!ALIGN_EPI) { if (wr == 0) PG8_BAR; }
    PG8_BAR;
#undef PG8_SA
#undef PG8_SB
#undef PG8_STAGE
#undef PG8_LDA
#undef PG8_LDB
#undef PG8_MMA
#undef PG8_WAIT_V
#undef PG8_WAIT_L
#undef PG8_BAR
#undef PG8_SCHED
#undef PG8_AROWS
}
}

namespace att {
using bf16_t = unsigned short;
using bf16x8 = __attribute__((ext_vector_type(8))) short;
using s16x4  = __attribute__((ext_vector_type(4))) short;
using f32x16 = __attribute__((ext_vector_type(16))) float;
using u32x4  = __attribute__((ext_vector_type(4))) unsigned;
#define SBAR() __builtin_amdgcn_sched_barrier(0)
constexpr float THR = 8.f;
__device__ __forceinline__ int crow(int r, int hi) { return (r & 3) + 8 * (r >> 2) + 4 * hi; }
__device__ __forceinline__ unsigned cvtpk(float lo, float hi) { unsigned r; asm volatile("v_cvt_pk_bf16_f32 %0, %1, %2" : "=v"(r) : "v"(lo), "v"(hi)); return r; }
template <int DK> struct KCfg;
template <> struct KCfg<64> { static constexpr float SCALE = 0.125f;
    static __device__ __forceinline__ int swz(int row, int cb) { return row * 128 + (cb ^ (((row >> 1) & 7) << 4)); } };
template <> struct KCfg<96> { static constexpr float SCALE = 0.10206207261596577f;
    static __device__ __forceinline__ int swz(int row, int cb) { return row * 192 + (cb ^ (((row >> 2) & 3) << 4)); } };

template <int DK> __device__ __forceinline__ void partialSM(f32x16& p0, f32x16& p1, float& m_reg, float& mn, float& alpha) {
  constexpr float SCALE = KCfg<DK>::SCALE, C = SCALE * 1.4426950408889634f;
  float pmax = p0[0];
#pragma unroll
  for (int r = 1; r < 16; ++r) pmax = fmaxf(pmax, p0[r]);
#pragma unroll
  for (int r = 0; r < 16; ++r) pmax = fmaxf(pmax, p1[r]);
  { auto rr = __builtin_amdgcn_permlane32_swap(__float_as_uint(pmax), __float_as_uint(pmax), false, false);
    pmax = fmaxf(__uint_as_float(rr[0]), __uint_as_float(rr[1])); }
  if (__builtin_expect(__all(pmax - m_reg <= THR / SCALE), 1)) { mn = m_reg; alpha = 1.f; }
  else { mn = fmaxf(m_reg, pmax); alpha = __builtin_amdgcn_exp2f((m_reg - mn) * C); m_reg = mn; }
  float mnC = -mn * C;
#pragma unroll
  for (int r = 0; r < 16; ++r) p0[r] = fmaf(p0[r], C, mnC);
#pragma unroll
  for (int r = 0; r < 16; ++r) p1[r] = fmaf(p1[r], C, mnC);
#pragma unroll
  for (int r = 0; r < 16; ++r) p0[r] = __builtin_amdgcn_exp2f(p0[r]);
}
__device__ __forceinline__ void finishSM(f32x16& p0, f32x16& p1, float alpha, float& l_reg, bf16x8& pa0, bf16x8& pa1, bf16x8& pa2, bf16x8& pa3) {
#pragma unroll
  for (int r = 0; r < 16; ++r) p1[r] = __builtin_amdgcn_exp2f(p1[r]);
  float ps = 0;
#pragma unroll
  for (int r = 0; r < 16; ++r) ps += p0[r];
#pragma unroll
  for (int r = 0; r < 16; ++r) ps += p1[r];
  { auto rr = __builtin_amdgcn_permlane32_swap(__float_as_uint(ps), __float_as_uint(ps), false, false);
    ps = __uint_as_float(rr[0]) + __uint_as_float(rr[1]); }
  l_reg = l_reg * alpha + ps;
#define PK4(P, BASE, OUT) do { unsigned a0 = cvtpk(P[BASE + 0], P[BASE + 1]), a1 = cvtpk(P[BASE + 2], P[BASE + 3]);   \
    unsigned b0 = cvtpk(P[BASE + 4], P[BASE + 5]), b1 = cvtpk(P[BASE + 6], P[BASE + 7]);                              \
    auto r0 = __builtin_amdgcn_permlane32_swap(a0, b0, false, false); auto r1 = __builtin_amdgcn_permlane32_swap(a1, b1, false, false); \
    u32x4 w = {r0[0], r1[0], r0[1], r1[1]}; OUT = *reinterpret_cast<bf16x8*>(&w); } while (0)
  PK4(p0, 0, pa0); PK4(p0, 8, pa1); PK4(p1, 0, pa2); PK4(p1, 8, pa3);
#undef PK4
}
template <int DK> __device__ __forceinline__ void qkt(f32x16& p0, f32x16& p1, const char* Ks, const bf16x8* qr, int r32, int hi) {
  p0 = f32x16{}; p1 = f32x16{};
#pragma unroll
  for (int d0 = 0; d0 < DK / 16; ++d0) { const int cb = (d0 * 16 + hi * 8) * 2;
    bf16x8 b0 = *reinterpret_cast<const bf16x8*>(Ks + KCfg<DK>::swz(r32, cb));
    bf16x8 b1 = *reinterpret_cast<const bf16x8*>(Ks + KCfg<DK>::swz(32 + r32, cb));
    p0 = __builtin_amdgcn_mfma_f32_32x32x16_bf16(b0, qr[d0], p0, 0, 0, 0);
    p1 = __builtin_amdgcn_mfma_f32_32x32x16_bf16(b1, qr[d0], p1, 0, 0, 0); }
}
__device__ __forceinline__ int v_st(int k, int c) { const int kk = (k & ~0xC) | ((k & 4) << 1) | ((k & 8) >> 1); return ((kk >> 3) * 2 + (c >> 5)) * 512 + ((kk & 7) * 32 + (c & 31)) * 2; }
__device__ __forceinline__ int v_rd_base(int lane) { return ((lane & 3) << 3) | (((lane >> 2) & 3) << 6) | (((lane >> 4) & 1) << 5) | (((lane >> 5) & 1) << 8); }
constexpr int v_rd_off(int d0, int ks, int half) { return d0 * 512 + ks * 2048 + half * 1024; }
template <int OFF> __device__ __forceinline__ s16x4 tr_read(int vb) {
  s16x4 r; asm volatile("ds_read_b64_tr_b16 %0, %1 offset:%2" : "=&v"(r) : "v"(vb), "i"(OFF) : "memory"); return r;
}
template <int D0> __device__ __forceinline__ void pv_one(f32x16& od, int vb, bf16x8 pa0, bf16x8 pa1, bf16x8 pa2, bf16x8 pa3) {
  const s16x4 l0 = tr_read<v_rd_off(D0, 0, 0)>(vb), h0 = tr_read<v_rd_off(D0, 0, 1)>(vb), l1 = tr_read<v_rd_off(D0, 1, 0)>(vb), h1 = tr_read<v_rd_off(D0, 1, 1)>(vb);
  const s16x4 l2 = tr_read<v_rd_off(D0, 2, 0)>(vb), h2 = tr_read<v_rd_off(D0, 2, 1)>(vb), l3 = tr_read<v_rd_off(D0, 3, 0)>(vb), h3 = tr_read<v_rd_off(D0, 3, 1)>(vb);
  asm volatile("s_waitcnt lgkmcnt(0)" ::: "memory"); SBAR();
#define PK(L, H) (bf16x8){L[0], L[1], L[2], L[3], H[0], H[1], H[2], H[3]}
  od = __builtin_amdgcn_mfma_f32_32x32x16_bf16(pa0, PK(l0, h0), od, 0, 0, 0);
  od = __builtin_amdgcn_mfma_f32_32x32x16_bf16(pa1, PK(l1, h1), od, 0, 0, 0);
  od = __builtin_amdgcn_mfma_f32_32x32x16_bf16(pa2, PK(l2, h2), od, 0, 0, 0);
  od = __builtin_amdgcn_mfma_f32_32x32x16_bf16(pa3, PK(l3, h3), od, 0, 0, 0);
#undef PK
}
__device__ __forceinline__ void pv_d0(f32x16* o, int vb, bf16x8 pa0, bf16x8 pa1, bf16x8 pa2, bf16x8 pa3) {
  pv_one<0>(o[0], vb, pa0, pa1, pa2, pa3); pv_one<1>(o[1], vb, pa0, pa1, pa2, pa3);
}
constexpr int SEQK = 2048, KVBLK = 64, NT = SEQK / KVBLK, SHM_V = 64 * 64 * 2;
constexpr int LDS_BYTES = 2 * SHM_V + 2 * (64 * 96 * 2) + 2048 + 8 * 4096;
template <int DK>
__device__ __forceinline__ void attn_unit(const bf16_t* __restrict__ Qb, int ldq, const bf16_t* __restrict__ Kh, int ldk, const bf16_t* __restrict__ Kp, int ldp, const bf16_t* __restrict__ Vh, int ldv, bf16_t* __restrict__ Ob, int ldo, char* lds, int wid) {
  constexpr int KCH = DK / 8, SHM_K = 64 * DK * 2; constexpr bool K2 = (64 * KCH > 512);
  const int lane = fresh_lane(), tid = wid * 64 + lane, r32 = lane & 31, hi = lane >> 5;
  char* V_lds = lds; char* K_lds = lds + 2 * SHM_V;
  float* ws = (float*)(lds + 2 * SHM_V + 2 * SHM_K) + wid * 64; float* li_l = ws; float* al_l = ws + 32;
  bf16_t* stg = (bf16_t*)(lds + 2 * SHM_V + 2 * SHM_K + 2048) + wid * 2048;
  float m_reg = -1e30f, l_reg = 0; f32x16 o[2] = {}; bf16x8 qr[DK / 16];
  const bf16_t* Qw = Qb + (long)(wid * 32 + r32) * ldq + hi * 8;
#pragma unroll
  for (int d0 = 0; d0 < DK / 16; ++d0) qr[d0] = *reinterpret_cast<const bf16x8*>(Qw + d0 * 16);
  const int kr0 = tid / KCH, kc0 = (tid % KCH) * 8, kr1 = (tid + 512) / KCH, kc1 = ((tid + 512) % KCH) * 8; const bool has2 = K2 && (tid < 64 * KCH - 512);
  const bf16_t* kp0 = (kc0 < 64) ? Kh + (long)kr0 * ldk + kc0 : Kp + (long)kr0 * ldp + (kc0 - 64); const long ks0 = (kc0 < 64) ? ldk : ldp;
  const bf16_t* kp1 = (kc1 < 64) ? Kh + (long)kr1 * ldk + kc1 : Kp + (long)kr1 * ldp + (kc1 - 64); const long ks1 = (kc1 < 64) ? ldk : ldp;
  const int vr = tid >> 3, vc = (tid & 7) * 8, vst0 = v_st(vr, vc);
  const int vb0 = (int)(uintptr_t)V_lds + v_rd_base(lane);
  bf16x8 skE0, skE1, svE, skO0, skO1, svO;
#define SLOAD(S, k0) do { sk##S##0 = *reinterpret_cast<const bf16x8*>(kp0 + (long)(k0) * ks0); if (has2) sk##S##1 = *reinterpret_cast<const bf16x8*>(kp1 + (long)(k0) * ks1); \
    sv##S = *reinterpret_cast<const bf16x8*>(&Vh[(long)((k0) + vr) * ldv + vc]); } while (0)
#define SWRITE(b, S) do { *(bf16x8*)(K_lds + (b) * SHM_K + KCfg<DK>::swz(kr0, kc0 * 2)) = sk##S##0; if (has2) *(bf16x8*)(K_lds + (b) * SHM_K + KCfg<DK>::swz(kr1, kc1 * 2)) = sk##S##1; \
    *(bf16x8*)(V_lds + (b) * SHM_V + vst0) = sv##S; } while (0)
#define RESC(a) do { if (__any((a) < 1.f)) { if (hi == 0) al_l[r32] = (a); asm volatile("s_waitcnt lgkmcnt(0)" ::: "memory"); \
    _Pragma("unroll") for (int d = 0; d < 2; ++d) _Pragma("unroll") for (int r = 0; r < 16; ++r) o[d][r] *= al_l[crow(r, hi)]; } } while (0)
  f32x16 pA0, pA1, pB0, pB1; float mnA, mnB, alA, alB; bf16x8 pa0, pa1, pa2, pa3;
  SLOAD(E, 0); SWRITE(0, E); __syncthreads();
  qkt<DK>(pA0, pA1, K_lds, qr, r32, hi); partialSM<DK>(pA0, pA1, m_reg, mnA, alA);
  SLOAD(O, KVBLK); SLOAD(E, 2 * KVBLK);
  SWRITE(1, O); __syncthreads();
  for (int j = 1; j + 1 < NT; j += 2) {
    SBAR(); qkt<DK>(pB0, pB1, K_lds + SHM_K, qr, r32, hi);
    finishSM(pA0, pA1, alA, l_reg, pa0, pa1, pa2, pa3); SBAR();
    SLOAD(O, (j + 2) * KVBLK); SBAR();
    pv_d0(o, vb0, pa0, pa1, pa2, pa3); partialSM<DK>(pB0, pB1, m_reg, mnB, alB);
    __syncthreads(); SWRITE(0, E);
    RESC(alB); __syncthreads();
    SBAR(); qkt<DK>(pA0, pA1, K_lds, qr, r32, hi);
    finishSM(pB0, pB1, alB, l_reg, pa0, pa1, pa2, pa3); SBAR();
    if (j + 3 < NT) SLOAD(E, (j + 3) * KVBLK); SBAR();
    pv_d0(o, vb0 + SHM_V, pa0, pa1, pa2, pa3); partialSM<DK>(pA0, pA1, m_reg, mnA, alA);
    __syncthreads(); SWRITE(1, O);
    RESC(alA); __syncthreads();
  }
  SBAR(); qkt<DK>(pB0, pB1, K_lds + SHM_K, qr, r32, hi);
  finishSM(pA0, pA1, alA, l_reg, pa0, pa1, pa2, pa3); SBAR();
  pv_d0(o, vb0, pa0, pa1, pa2, pa3); partialSM<DK>(pB0, pB1, m_reg, mnB, alB);
  __syncthreads(); RESC(alB);
  finishSM(pB0, pB1, alB, l_reg, pa0, pa1, pa2, pa3); SBAR();
  pv_d0(o, vb0 + SHM_V, pa0, pa1, pa2, pa3);
  if (hi == 0) li_l[r32] = l_reg; asm volatile("s_waitcnt lgkmcnt(0)" ::: "memory");
  float rli[16];
#pragma unroll
  for (int r = 0; r < 16; ++r) rli[r] = __builtin_amdgcn_rcpf(li_l[crow(r, hi)]);
#pragma unroll
  for (int r = 0; r < 16; ++r) { const int orow = crow(r, hi);
#pragma unroll
    for (int d0 = 0; d0 < 2; ++d0) { const unsigned w = cvtpk(o[d0][r] * rli[r], 0.f); stg[orow * 64 + d0 * 32 + r32] = (bf16_t)(w & 0xffffu); } }
  asm volatile("s_waitcnt lgkmcnt(0)" ::: "memory");
  bf16_t* Ow = Ob + (long)(wid * 32) * ldo;
#pragma unroll
  for (int i = 0; i < 4; ++i) { const int row = i * 8 + (lane >> 3), ch = lane & 7; const u32x4 v = *(const u32x4*)(stg + row * 64 + ch * 8); *(u32x4*)(Ow + (long)row * ldo + ch * 8) = v; }
  __syncthreads();
#undef SLOAD
#undef SWRITE
#undef RESC
}
#undef SBAR
}

constexpr int NWAVES = 8;
constexpr int NB = 16, SEQ = 2048, DM = 1024, T = NB * SEQ;
constexpr int INW = 1312, INWP = 1536;
constexpr int NE = 16, CAP = 256, FF = 2816, PLE = 256;
constexpr int UQW = 768, UKVW = 1024;
constexpr float ALPHA = 1.189207115002721f;
constexpr float LN_EPS = 1e-5f, RMS_EPS = 1e-6f;

constexpr size_t MiB = 1u << 20;
constexpr size_t WS_CTL = 0;
constexpr size_t WS_WIN = 1 * MiB;
constexpr size_t WS_WUQ = 4 * MiB;
constexpr size_t WS_WUKV = 4 * MiB + 512 * 1024;
constexpr size_t WS_WOUT = 5 * MiB;
constexpr size_t WS_WPG = 7 * MiB;
constexpr size_t WS_WPP = 9 * MiB;
constexpr size_t WS_WRT = 9 * MiB + 512 * 1024;
constexpr size_t WS_AFF = 10 * MiB;
constexpr size_t WS_ROWMAP = 12 * MiB;
constexpr size_t WS_GVAL = 12 * MiB + 256 * 1024;
constexpr size_t WS_SEL = 12 * MiB + 512 * 1024;
constexpr size_t WS_SSQ = 14 * MiB + 512 * 1024, WS_SSKV = 15 * MiB;
constexpr size_t WS_WGU = 16 * MiB;
constexpr size_t WS_YEXP = 16 * MiB, WS_PB = 144 * MiB;
constexpr size_t WS_X1Q = 104 * MiB;
constexpr size_t WS_WDN = 192 * MiB;
constexpr size_t WS_X1B = 280 * MiB;
constexpr size_t WS_QMLA = 280 * MiB;
constexpr size_t WS_R1 = 344 * MiB;
constexpr size_t WS_XB = WS_R1;
constexpr size_t WS_PROJ = WS_R1 + 64 * MiB;
constexpr size_t WS_QG = WS_R1 + 256 * MiB, WS_KG = WS_QG + 32 * MiB, WS_VG = WS_KG + 8 * MiB, WS_CQ = WS_VG + 8 * MiB, WS_CKV = WS_CQ + 16 * MiB, WS_KPE = WS_CKV + 16 * MiB;
constexpr size_t WS_QM = WS_R1;
constexpr size_t WS_KV = WS_R1 + 96 * MiB;
constexpr size_t WS_VMLA = WS_R1 + 224 * MiB;
constexpr size_t WS_KN = WS_R1 + 96 * MiB;
constexpr size_t WS_O = WS_R1;
constexpr size_t WS_H = WS_R1;
constexpr size_t WS_E = WS_R1, WS_G = WS_R1 + 128 * MiB;
constexpr size_t WS_END = 704 * MiB;
static_assert(WS_KPE + 2 * MiB <= WS_END && WS_H + (size_t)65536 * FF * 2 <= WS_END && WS_VMLA + 32 * MiB <= WS_QG, "d_ws map");

constexpr int LDS_BYTES = 147456;
static_assert(att::LDS_BYTES <= 131072 && pg8::TAB_OFF + 12288 <= LDS_BYTES, "LDS map");

#define LAS __attribute__((address_space(3)))
typedef unsigned short bf16;
typedef unsigned v4u __attribute__((ext_vector_type(4)));
typedef unsigned v2u __attribute__((ext_vector_type(2)));
typedef float f32x4 __attribute__((ext_vector_type(4)));
__device__ __forceinline__ unsigned f2bf(float f) { unsigned u = __builtin_bit_cast(unsigned, f); return (u + 0x7fffu + ((u >> 16) & 1u)) >> 16; }
__device__ __forceinline__ unsigned pk2(float lo, float hi) { return f2bf(lo) | (f2bf(hi) << 16); }
__device__ __forceinline__ float bf2f(unsigned h) { return __builtin_bit_cast(float, h << 16); }
__device__ __forceinline__ float wave_sum(float v) {
#pragma unroll
    for (int o = 1; o < 64; o <<= 1) v += __shfl_xor(v, o);
    return v;
}
__device__ __forceinline__ float wave_max(float v) {
#pragma unroll
    for (int o = 1; o < 64; o <<= 1) v = fmaxf(v, __shfl_xor(v, o));
    return v;
}


#define GAS __attribute__((address_space(1)))
typedef GAS unsigned gu32;
#define RLX_AGENT __ATOMIC_RELAXED, __HIP_MEMORY_SCOPE_AGENT
#define XB_TMO      128
#define XB_XCNT(j)  (256  + 64 * (j))
#define XB_XSUB(j)  (1280 + 64 * (j))
#define XB_XGEN(j)  (2304 + 64 * (j))
#define XB_TOP      3328
#define XB_TOPGEN   3392
#define XCD_BAR_WORDS 3456
#define XB_SPIN_CAP (1u << 18)

__device__ __forceinline__ unsigned xb_ld(unsigned* p)              { return __hip_atomic_load(p, __ATOMIC_RELAXED, __HIP_MEMORY_SCOPE_AGENT); }
__device__ __forceinline__ unsigned xb_add(unsigned* p, unsigned v) { return __hip_atomic_fetch_add(p, v, __ATOMIC_RELAXED, __HIP_MEMORY_SCOPE_AGENT); }
__device__ __forceinline__ unsigned xb_xcc_id() { return (unsigned)__builtin_amdgcn_s_getreg((3 << 11) | 20) & 0xFu; }
#define XB_SPIN(cond, bar) do { unsigned _sp = 0; while (cond) { __builtin_amdgcn_s_sleep(1); \
    if ((++_sp & 255u) == 0u) { if (xb_ld(&(bar)[XB_TMO])) break; if (_sp > XB_SPIN_CAP) { atomicAdd(&(bar)[XB_TMO], 1u); break; } } } } while (0)

struct XcdBarrier {
    unsigned* bar; unsigned x; int w;
    volatile LAS unsigned* st;
};

__device__ __forceinline__ XcdBarrier xcd_barrier_post(unsigned* bar, volatile LAS unsigned* st, int w) {
    XcdBarrier b; b.bar = bar; b.x = xb_xcc_id(); b.st = st; b.w = w;
    if (w == 0 && fresh_lane() == 0) (void)xb_add(&bar[XB_XCNT(b.x)], 1u);
    return b;
}
__device__ __forceinline__ void xcd_barrier_complete(unsigned* bar, unsigned x, unsigned& nloc, unsigned& nx) {
    const unsigned G = gridDim.x * gridDim.y * gridDim.z;
    unsigned sum, cnt, mine, sp = 0u;
    for (;;) {
        sum = 0u; cnt = 0u; mine = 0u;
#pragma unroll
        for (unsigned j = 0; j < 16; ++j) { const unsigned c = xb_ld(&bar[XB_XCNT(j)]); sum += c; cnt += (c > 0u) ? 1u : 0u; mine = (j == x) ? c : mine; }
        if (sum == G) break;
        __builtin_amdgcn_s_sleep(1);
        if ((++sp & 255u) == 0u) { if (xb_ld(&bar[XB_TMO])) break; if (sp > XB_SPIN_CAP) { atomicAdd(&bar[XB_TMO], 1u); break; } }
    }
    nloc = mine > 0u ? mine : 1u; nx = cnt > 0u ? cnt : 1u;
}

__device__ __forceinline__ void xcd_barrier(const XcdBarrier& b) {
    asm volatile("s_waitcnt vmcnt(0)" ::: "memory");
    __syncthreads();
    if (b.w == 0 && fresh_lane() == 0) {
        unsigned* bar = b.bar;
        __builtin_amdgcn_s_waitcnt(0);
        unsigned nloc = b.st[0], nx = b.st[1];
        if (nloc == 0u) { xcd_barrier_complete(bar, b.x, nloc, nx); b.st[0] = nloc; b.st[1] = nx; }
        const unsigned old = xb_add(&bar[XB_XSUB(b.x)], 1u);
        const unsigned gen = old / nloc;
        if (old + 1u == (gen + 1u) * nloc) {
            __builtin_amdgcn_fence(__ATOMIC_RELEASE, "agent");
            asm volatile("s_waitcnt vmcnt(0)" ::: "memory");
            const unsigned og = xb_add(&bar[XB_TOP], 1u);
            const unsigned tg = og / nx;
            if (og + 1u == (tg + 1u) * nx) xb_add(&bar[XB_TOPGEN], 1u);
            else XB_SPIN(xb_ld(&bar[XB_TOPGEN]) == tg, bar);
            __builtin_amdgcn_fence(__ATOMIC_ACQUIRE, "agent");
            xb_add(&bar[XB_XGEN(b.x)], 1u);
            asm volatile("s_waitcnt vmcnt(0)" ::: "memory");
        } else {
            XB_SPIN(xb_ld(&bar[XB_XGEN(b.x)]) == gen, bar);
            __builtin_amdgcn_fence(__ATOMIC_ACQUIRE, "agent");
            asm volatile("s_waitcnt vmcnt(0)" ::: "memory");
        }
    }
    __syncthreads();
}
struct Args { const float* in[22]; float* out; unsigned char* ws; int ph_lo, ph_hi, dummy, region; };
enum { I_X = 0, I_P, I_WIN, I_QN, I_KN, I_CQN, I_CKVN, I_WUQ, I_WUKV, I_WOUT, I_LNAG, I_LNAB, I_WR, I_WG, I_WU, I_WD, I_LNFG, I_LNFB, I_WPP, I_WPG, I_LNPG, I_LNPB };

struct Frame { LAS unsigned char* lds; int tid, lane, wave, vcu, G; };

__device__ __forceinline__ void tr_item(const float* W, int N, int k0, int n0, bf16* WT, int K, long dst_row0, LAS float* scr, int lane, const float* kscale = nullptr, int nmode = 0) {
#pragma unroll 8
    for (int i = 0; i < 32; ++i) { const int kk = 2 * i + (lane >> 5); float v = W[(size_t)(k0 + kk) * N + n0 + (lane & 31)]; if (kscale) v *= kscale[k0 + kk]; scr[kk * 33 + (lane & 31)] = v; }
    asm volatile("s_waitcnt lgkmcnt(0)" ::: "memory");
    const int c = lane & 7;
#pragma unroll
    for (int j = 0; j < 4; ++j) { const int n = (lane >> 3) + 8 * j; const LAS float* s = scr + (8 * c) * 33 + n;
        v4u o; o.x = pk2(s[0 * 33], s[1 * 33]); o.y = pk2(s[2 * 33], s[3 * 33]); o.z = pk2(s[4 * 33], s[5 * 33]); o.w = pk2(s[6 * 33], s[7 * 33]);
        const int nd = nmode ? (16 * ((n >> 3) & 1) + 8 * (n >> 4) + (n & 7)) : n;
        *(v4u*)(WT + (size_t)(dst_row0 + nd) * K + k0 + 8 * c) = o; }
    asm volatile("s_waitcnt lgkmcnt(0)" ::: "memory");
}
__device__ __forceinline__ unsigned q4(float a, float b, float c, float d) { int w = __builtin_amdgcn_cvt_pk_fp8_f32(a * 32.0f, b * 32.0f, 0, false); w = __builtin_amdgcn_cvt_pk_fp8_f32(c * 32.0f, d * 32.0f, w, true); return (unsigned)w; }
__device__ __forceinline__ void tr_item8(const float* W, int N, int k0, int n0, unsigned char* WT, int K, long dst_row0, LAS float* scr, int lane) {
#pragma unroll 8
    for (int i = 0; i < 32; ++i) { const int kk = 2 * i + (lane >> 5); scr[kk * 33 + (lane & 31)] = W[(size_t)(k0 + kk) * N + n0 + (lane & 31)]; }
    asm volatile("s_waitcnt lgkmcnt(0)" ::: "memory");
    const int c = lane & 7;
#pragma unroll
    for (int j = 0; j < 4; ++j) { const int n = (lane >> 3) + 8 * j; const LAS float* s = scr + (8 * c) * 33 + n;
        v2u o; o.x = q4(s[0 * 33], s[1 * 33], s[2 * 33], s[3 * 33]); o.y = q4(s[4 * 33], s[5 * 33], s[6 * 33], s[7 * 33]);
        *(v2u*)(WT + (size_t)(dst_row0 + n) * K + k0 + 8 * c) = o; }
    asm volatile("s_waitcnt lgkmcnt(0)" ::: "memory");
}
__device__ __forceinline__ void tr_dense(const float* W, int K, int N, bf16* WT, int r, LAS float* scr, int lane, const float* kscale = nullptr) {
    const int nblk = N / 32, kb = r / nblk, nb = r % nblk; tr_item(W, N, 64 * kb, 32 * nb, WT, K, 32 * nb, scr, lane, kscale);
}
constexpr int MOE_I_E = 16 * 44, MOE_ITEMS = 3 * NE * MOE_I_E;
__device__ __forceinline__ void moe_convert_range(const Frame& F, const Args& a, int lo, int hi) {
    LAS float* scr = (LAS float*)(F.lds + F.wave * 16640);
    const int gw = F.vcu * NWAVES + F.wave, NGW = F.G * NWAVES;
    unsigned char* ws = a.ws;
    {
        constexpr int I_E = MOE_I_E;
        const int l = fresh_lane(), kr = l >> 4, nq = l & 15, nl = l & 7, c = l >> 3;
#define MOE_DESC(it, src, N_, dst, K_) do { const int mat_ = (it) / (NE * I_E); int r_ = (it) % (NE * I_E); const int e_ = r_ / I_E; r_ %= I_E; \
        if (mat_ < 2) { const int kb_ = r_ / 44, nb_ = r_ % 44, n0_ = 64 * nb_; src = a.in[mat_ ? I_WU : I_WG] + (size_t)e_ * DM * FF + (size_t)(64 * kb_) * FF + n0_; N_ = FF; K_ = DM; \
            dst = ws + WS_WGU + ((size_t)e_ * (2 * FF) + (n0_ / 128) * 256 + (n0_ % 128) + (mat_ ? 128 : 0)) * DM + 64 * kb_; } \
        else { const int kb_ = r_ / 16, nb_ = r_ % 16; src = a.in[I_WD] + (size_t)e_ * FF * DM + (size_t)(64 * kb_) * DM + 64 * nb_; N_ = DM; K_ = FF; \
            dst = ws + WS_WDN + ((size_t)e_ * DM + 64 * nb_) * FF + 64 * kb_; } } while (0)
#define MOE_LOAD(v, src, N_) do { _Pragma("unroll") for (int i = 0; i < 16; ++i) v[i] = __builtin_nontemporal_load((const f32x4*)(src + (size_t)(4 * i + kr) * N_ + 4 * nq)); } while (0)
#define MOE_PROC(v, dst, K_) do { _Pragma("unroll") for (int i = 0; i < 16; ++i) { LAS float* s_ = scr + (4 * i + kr) * 65 + 4 * nq; s_[0] = v[i].x; s_[1] = v[i].y; s_[2] = v[i].z; s_[3] = v[i].w; } \
        asm volatile("s_waitcnt lgkmcnt(0)" ::: "memory"); \
        _Pragma("unroll") for (int j = 0; j < 8; ++j) { const int n_ = nl + 8 * j; const LAS float* s_ = scr + (8 * c) * 65 + n_; \
            v2u o_; o_.x = q4(s_[0], s_[65], s_[130], s_[195]); o_.y = q4(s_[260], s_[325], s_[390], s_[455]); __builtin_nontemporal_store(o_, (v2u*)(dst + (size_t)n_ * K_ + 8 * c)); } \
        asm volatile("s_waitcnt lgkmcnt(0)" ::: "memory"); } while (0)
        if (NGW == 2048 && lo == 0 && hi == MOE_ITEMS) {
            constexpr int NI = (MOE_ITEMS + 2047) / 2048;
            f32x4 v[2][16]; const float* sp[2]; unsigned char* dp[2]; int Nn[2], Kk[2];
#define MOE_ITEM(k) ((gw + (k) * 2048 < MOE_ITEMS) ? gw + (k) * 2048 : gw + ((k) - 1) * 2048)
            { MOE_DESC(MOE_ITEM(0), sp[0], Nn[0], dp[0], Kk[0]); MOE_LOAD(v[0], sp[0], Nn[0]); }
            { MOE_DESC(MOE_ITEM(1), sp[1], Nn[1], dp[1], Kk[1]); MOE_LOAD(v[1], sp[1], Nn[1]); }
#pragma unroll
            for (int k = 0; k < NI; ++k) {
                MOE_PROC(v[k & 1], dp[k & 1], Kk[k & 1]);
                if (k + 2 < NI) { MOE_DESC(MOE_ITEM(k + 2), sp[k & 1], Nn[k & 1], dp[k & 1], Kk[k & 1]); MOE_LOAD(v[k & 1], sp[k & 1], Nn[k & 1]); }
            }
#undef MOE_ITEM
        } else {
        f32x4 va[16], vb[16]; const float *sa = nullptr, *sb = nullptr; unsigned char *da = nullptr, *db = nullptr; int Na = 0, Nb = 0, Ka = 0, Kb = 0;
        int it = lo + gw;
        if (it < hi) { MOE_DESC(it, sa, Na, da, Ka); MOE_LOAD(va, sa, Na); }
        while (it < hi) {
            const int itb = it + NGW;
            if (itb < hi) { MOE_DESC(itb, sb, Nb, db, Kb); MOE_LOAD(vb, sb, Nb); }
            MOE_PROC(va, da, Ka);
            it = itb + NGW;
            if (itb >= hi) break;
            if (it < hi) { MOE_DESC(it, sa, Na, da, Ka); MOE_LOAD(va, sa, Na); }
            MOE_PROC(vb, db, Kb);
        }
        }
#undef MOE_DESC
#undef MOE_LOAD
#undef MOE_PROC
    }
}
__device__ __forceinline__ void p0_convert(const Frame& F, const Args& a) {
    LAS float* scr = (LAS float*)(F.lds + F.wave * 16640);
    const int gw = F.vcu * NWAVES + F.wave, NGW = F.G * NWAVES;
    unsigned char* ws = a.ws;
    constexpr int I_IN = (DM / 64) * (INW / 32), I_UQ = (256 / 64) * (UQW / 32), I_UKV = (256 / 64) * (UKVW / 32), I_OUT = (DM / 64) * (DM / 32), I_PG = I_OUT, I_PP = (PLE / 64) * (DM / 32);
    constexpr int NITEMS = I_IN + I_UQ + I_UKV + I_OUT + I_PG + I_PP;
    for (int it = gw; it < NITEMS; it += NGW) {
        int r = it;
        if (r < I_IN) {
            const int nblk = INW / 32, kb = r / nblk, nb = r % nblk, n0 = 32 * nb, pn = n0 >> 8, cw = n0 & 255;
            const int d0 = (pn <= 2) ? 256 * pn + ((cw >> 5) & 1) * 128 + (cw >> 6) * 32 : n0;
            tr_item(a.in[I_WIN], INW, 64 * kb, n0, (bf16*)(ws + WS_WIN), DM, d0, scr, F.lane, nullptr, pn == 5 ? 1 : 0); continue; } r -= I_IN;
        if (r < I_UQ) {
            const int nblk = UQW / 32, kb = r / nblk, nb = r % nblk, n0 = 32 * nb, head = n0 / 96, off = n0 % 96;
            const int d0 = (off < 64) ? (head >> 2) * 256 + (head & 3) * 64 + off : 512 + head * 32;
            tr_item(a.in[I_WUQ], UQW, 64 * kb, n0, (bf16*)(ws + WS_WUQ), 256, d0, scr, F.lane, a.in[I_CQN], off < 64 ? 0 : 1); continue; } r -= I_UQ;
        if (r < I_UKV) { tr_dense(a.in[I_WUKV], 256, UKVW, (bf16*)(ws + WS_WUKV), r, scr, F.lane, a.in[I_CKVN]); continue; } r -= I_UKV;
        if (r < I_OUT) { tr_dense(a.in[I_WOUT], DM, DM, (bf16*)(ws + WS_WOUT), r, scr, F.lane); continue; } r -= I_OUT;
        if (r < I_PG) { tr_dense(a.in[I_WPG], DM, DM, (bf16*)(ws + WS_WPG), r, scr, F.lane); continue; } r -= I_PG;
        tr_dense(a.in[I_WPP], PLE, DM, (bf16*)(ws + WS_WPP), r, scr, F.lane);
    }
    { v4u* z = (v4u*)(ws + WS_WIN + (size_t)INW * DM * 2); const int n16 = (INWP - INW) * DM * 2 / 16;
      for (int i = (F.vcu * NWAVES + F.wave) * 64 + F.lane; i < n16; i += NGW * 64) z[i] = (v4u){0u, 0u, 0u, 0u}; }
    { float* wrt = (float*)(ws + WS_WRT); const float* wr = a.in[I_WR];
      for (int i = (F.vcu * NWAVES + F.wave) * 64 + F.lane; i < NE * DM; i += NGW * 64) { const int e = i / DM, k = i % DM; wrt[i] = wr[k * NE + e]; } }
    { const float* x = a.in[I_X]; bf16* xb = (bf16*)(ws + WS_XB);
      for (int m = gw; m < T; m += NGW) { const f32x4* xr = (const f32x4*)(x + (size_t)m * DM) + F.lane; v2u* o = (v2u*)(xb + (size_t)m * DM) + F.lane;
#pragma unroll
          for (int j = 0; j < 4; ++j) { const f32x4 v = xr[64 * j]; o[64 * j] = (v2u){pk2(v.x, v.y), pk2(v.z, v.w)}; } } }
}

__device__ __forceinline__ void p_attention(const Frame& F, const Args& a) {
    unsigned char* ws = a.ws; char* lds = (char*)F.lds;
    const bf16* QG = (const bf16*)(ws + WS_QG); const bf16* KG = (const bf16*)(ws + WS_KG); const bf16* VG = (const bf16*)(ws + WS_VG);
    const bf16* QMLA = (const bf16*)(ws + WS_QMLA); const bf16* KN = (const bf16*)(ws + WS_KN); const bf16* KPE = (const bf16*)(ws + WS_KPE); const bf16* VMLA = (const bf16*)(ws + WS_VMLA);
    bf16* O = (bf16*)(ws + WS_O);
    const int nslots = (2048 + F.G - 1) / F.G, myslot = F.vcu % nslots; int slot = 0;
    for (int U = F.vcu; U < 2048; U += F.G, ++slot) {
        if (U < 1024) { const int qb = U & 7, hq = (U >> 3) & 7, kvh = hq >> 2, b = U >> 6; const size_t r0 = (size_t)b * SEQ + qb * 256;
            att::attn_unit<64>(QG + r0 * 512 + hq * 64, 512, KG + (size_t)b * SEQ * 128 + kvh * 64, 128, KG, 128, VG + (size_t)b * SEQ * 128 + kvh * 64, 128, O + r0 * 1024 + hq * 64, 1024, lds, F.wave); }
        else { const int V = U - 1024, qb = V & 7, h = (V >> 3) & 7, b = V >> 6; const size_t r0 = (size_t)b * SEQ + qb * 256;
            att::attn_unit<96>(QMLA + r0 * 768 + h * 96, 768, KN + (size_t)b * SEQ * 512 + h * 64, 512, KPE + (size_t)b * SEQ * 32, 32, VMLA + (size_t)b * SEQ * 512 + h * 64, 512, O + r0 * 1024 + 512 + h * 64, 1024, lds, F.wave); }
        if (slot == myslot) { moe_convert_range(F, a, 0, MOE_ITEMS); __syncthreads(); }
    }
    if (slot <= myslot) moe_convert_range(F, a, 0, MOE_ITEMS);
}
__device__ __forceinline__ void ln_row(f32x4 (&v)[4], const float* g, const float* bta, int lane) {
    float s = 0.f;
#pragma unroll
    for (int j = 0; j < 4; ++j) s += (v[j].x + v[j].y) + (v[j].z + v[j].w);
    const float mean = wave_sum(s) * (1.f / DM); float s2 = 0.f;
#pragma unroll
    for (int j = 0; j < 4; ++j) { v[j] = v[j] - mean; s2 += (v[j].x * v[j].x + v[j].y * v[j].y) + (v[j].z * v[j].z + v[j].w * v[j].w); }
    const float rstd = 1.f / sqrtf(wave_sum(s2) * (1.f / DM) + LN_EPS);
#pragma unroll
    for (int j = 0; j < 4; ++j) { const f32x4 gg = *((const f32x4*)g + lane + 64 * j), bb = *((const f32x4*)bta + lane + 64 * j); v[j] = v[j] * rstd * gg + bb; }
}
__device__ __forceinline__ void p7_ln1_router(const Frame& F, const Args& a, bf16* xdst) {
    const int gw = F.vcu * NWAVES + F.wave, NGW = F.G * NWAVES, l = F.lane;
    unsigned char* ws = a.ws; const float* xo = a.out; unsigned char* x1q = ws + WS_X1Q; float* aff = (float*)(ws + WS_AFF);
    { const f32x4* wg = (const f32x4*)(ws + WS_WRT); LAS f32x4* wl = (LAS f32x4*)F.lds;
      for (int i = F.tid; i < NE * DM / 4; i += NWAVES * 64) wl[i] = wg[i];
      __syncthreads(); }
    const LAS f32x4* wrt = (const LAS f32x4*)F.lds;
    const bool h5 = (l & 32) != 0, h4 = (l & 16) != 0, h3 = (l & 8) != 0, h2 = (l & 4) != 0;
    f32x4 nx[4];
    if (gw < T) {
#pragma unroll
        for (int j = 0; j < 4; ++j) nx[j] = *((const f32x4*)(xo + (size_t)gw * DM) + l + 64 * j); }
    for (int m = gw; m < T; m += NGW) {
        f32x4 v[4];
#pragma unroll
        for (int j = 0; j < 4; ++j) v[j] = nx[j];
        if (m + NGW < T) {
#pragma unroll
            for (int j = 0; j < 4; ++j) nx[j] = *((const f32x4*)(xo + (size_t)(m + NGW) * DM) + l + 64 * j); }
        ln_row(v, a.in[I_LNAG], a.in[I_LNAB], l);
#pragma unroll
        for (int j = 0; j < 4; ++j) { *((v2u*)(xdst + (size_t)m * DM) + l + 64 * j) = (v2u){pk2(v[j].x, v[j].y), pk2(v[j].z, v[j].w)}; *((unsigned*)(x1q + (size_t)m * DM) + l + 64 * j) = pg8::pk4_fp8(v[j].x, v[j].y, v[j].z, v[j].w); }
        float s16[NE];
#pragma unroll
        for (int e = 0; e < NE; ++e) { float s = 0.f;
#pragma unroll
            for (int j = 0; j < 4; ++j) { const f32x4 w = wrt[e * (DM / 4) + l + 64 * j]; s += (v[j].x * w.x + v[j].y * w.y) + (v[j].z * w.z + v[j].w * w.w); }
            s16[e] = s; if ((e & 3) == 3) asm volatile("" ::: "memory"); }
        float t8[8], t4[4], t2[2];
#pragma unroll
        for (int i = 0; i < 8; ++i) { const float mine = h5 ? s16[i + 8] : s16[i], oth = h5 ? s16[i] : s16[i + 8]; t8[i] = mine + __shfl_xor(oth, 32); }
#pragma unroll
        for (int i = 0; i < 4; ++i) { const float mine = h4 ? t8[i + 4] : t8[i], oth = h4 ? t8[i] : t8[i + 4]; t4[i] = mine + __shfl_xor(oth, 16); }
#pragma unroll
        for (int i = 0; i < 2; ++i) { const float mine = h3 ? t4[i + 2] : t4[i], oth = h3 ? t4[i] : t4[i + 2]; t2[i] = mine + __shfl_xor(oth, 8); }
        float lg = (h2 ? t2[1] : t2[0]) + __shfl_xor(h2 ? t2[0] : t2[1], 4);
        lg += __shfl_xor(lg, 2); lg += __shfl_xor(lg, 1);
        float mx = lg;
#pragma unroll
        for (int o = 4; o < 64; o <<= 1) mx = fmaxf(mx, __shfl_xor(mx, o));
        const float ex = expf(lg - mx); float den = ex;
#pragma unroll
        for (int o = 4; o < 64; o <<= 1) den += __shfl_xor(den, o);
        const int b = m >> 11, s_ = m & (SEQ - 1);
        if ((l & 3) == 0) aff[((size_t)b * NE + (l >> 2)) * SEQ + s_] = ex / den;
    }
}
__device__ __forceinline__ unsigned block_excl_scan(const Frame& F, unsigned cnt, LAS unsigned* wsum, unsigned& total) {
    unsigned inc = cnt;
#pragma unroll
    for (int o = 1; o < 64; o <<= 1) { const unsigned t = __shfl_up(inc, o); if (F.lane >= o) inc += t; }
    __syncthreads();
    if (F.lane == 63) wsum[F.wave] = inc;
    __syncthreads();
    unsigned base = 0, tot = 0;
#pragma unroll
    for (int w = 0; w < NWAVES; ++w) { const unsigned s = wsum[w]; if (w < F.wave) base += s; tot += s; }
    total = tot; return base + inc - cnt;
}
__device__ __forceinline__ void p8_topk(const Frame& F, const Args& a) {
    unsigned char* ws = a.ws; const float* aff = (const float*)(ws + WS_AFF);
    int* rowmap = (int*)(ws + WS_ROWMAP); float* gval = (float*)(ws + WS_GVAL); int* sel = (int*)(ws + WS_SEL);
    LAS unsigned* hist = (LAS unsigned*)F.lds; LAS unsigned* wsum = hist + 256; LAS unsigned* bc = hist + 272;
    for (int task = F.vcu; task < NB * NE; task += F.G) {
        const int b = task / NE, e = task % NE;
        const f32x4 vv = *((const f32x4*)(aff + (size_t)task * SEQ) + F.tid);
        const float vf[4] = {vv.x, vv.y, vv.z, vv.w}; unsigned u[4];
#pragma unroll
        for (int i = 0; i < 4; ++i) u[i] = __builtin_bit_cast(unsigned, vf[i]);
        unsigned prefix = 0, kneed = CAP;
#pragma unroll 1
        for (int pass = 0; pass < 4; ++pass) {
            const int shift = 24 - 8 * pass;
            __syncthreads();
            if (F.tid < 256) hist[F.tid] = 0u;
            __syncthreads();
#pragma unroll
            for (int i = 0; i < 4; ++i) { const bool in = (pass == 0) || ((u[i] >> (shift + 8)) == prefix); if (in) atomicAdd((unsigned*)&hist[(u[i] >> shift) & 255u], 1u); }
            __syncthreads();
            if (F.wave == 0) {
                unsigned h0 = hist[4 * F.lane], h1 = hist[4 * F.lane + 1], h2 = hist[4 * F.lane + 2], h3 = hist[4 * F.lane + 3];
                const unsigned tl = h0 + h1 + h2 + h3; unsigned suf = tl;
#pragma unroll
                for (int o = 1; o < 64; o <<= 1) { const unsigned t = __shfl_down(suf, o); if (F.lane + o < 64) suf += t; }
                const unsigned above = suf - tl;
                const unsigned a3 = above, a2 = above + h3, a1 = a2 + h2, a0 = a1 + h1;
                int found = -1; unsigned nk = 0;
                if (a3 < kneed && kneed <= a3 + h3) { found = 4 * F.lane + 3; nk = kneed - a3; }
                else if (a2 < kneed && kneed <= a2 + h2) { found = 4 * F.lane + 2; nk = kneed - a2; }
                else if (a1 < kneed && kneed <= a1 + h1) { found = 4 * F.lane + 1; nk = kneed - a1; }
                else if (a0 < kneed && kneed <= a0 + h0) { found = 4 * F.lane; nk = kneed - a0; }
                if (found >= 0) { bc[0] = (unsigned)found; bc[1] = nk; }
            }
            __syncthreads();
            prefix = (prefix << 8) | bc[0]; kneed = bc[1];
        }
        unsigned ceq = 0;
#pragma unroll
        for (int i = 0; i < 4; ++i) ceq += (u[i] == prefix) ? 1u : 0u;
        unsigned tot; unsigned eqbase = block_excl_scan(F, ceq, wsum, tot);
        bool take[4]; unsigned csel = 0;
#pragma unroll
        for (int i = 0; i < 4; ++i) { const bool eq = (u[i] == prefix); take[i] = (u[i] > prefix) || (eq && eqbase < kneed); if (eq) ++eqbase; csel += take[i] ? 1u : 0u; }
        unsigned slot = block_excl_scan(F, csel, wsum, tot);
#pragma unroll
        for (int i = 0; i < 4; ++i) { const int tkn = F.tid * 4 + i; int sv = -1;
            if (take[i]) { sv = (int)slot; const size_t r = (size_t)e * (NB * CAP) + b * CAP + slot; rowmap[r] = b * SEQ + tkn; gval[r] = vf[i]; ++slot; }
            sel[((size_t)b * SEQ + tkn) * NE + e] = sv; }
    }
}
__device__ __forceinline__ void acc_bf16x4(f32x4& v, const v2u w, const float f) {
    v.x += f * bf2f(w.x & 0xffffu); v.y += f * bf2f(w.x >> 16); v.z += f * bf2f(w.y & 0xffffu); v.w += f * bf2f(w.y >> 16);
}
__device__ __forceinline__ void p11_ln2(const Frame& F, const Args& a, bf16* xdst) {
    const int gw = F.vcu * NWAVES + F.wave, NGW = F.G * NWAVES, l = F.lane;
    unsigned char* ws = a.ws; const bf16* x1b = (const bf16*)(ws + WS_X1B); const bf16* yexp = (const bf16*)(ws + WS_YEXP); const int* sel = (const int*)(ws + WS_SEL);
    const float* p = a.in[I_P]; bf16* pb = (bf16*)(ws + WS_PB);
    v2u nx[4]; f32x4 npv; int nsv = -1;
    if (gw < T) {
#pragma unroll
        for (int j = 0; j < 4; ++j) nx[j] = *((const v2u*)(x1b + (size_t)gw * DM) + l + 64 * j);
        nsv = (l < NE) ? sel[(size_t)gw * NE + l] : -1; npv = *((const f32x4*)(p + (size_t)gw * PLE) + l); }
    for (int m = gw; m < T; m += NGW) {
        const int b = m >> 11;
        f32x4 v[4]; const int sv = nsv; const f32x4 pv = npv;
#pragma unroll
        for (int j = 0; j < 4; ++j) { v[j] = (f32x4){0.f, 0.f, 0.f, 0.f}; acc_bf16x4(v[j], nx[j], ALPHA); }
        if (m + NGW < T) { const int m1 = m + NGW;
#pragma unroll
            for (int j = 0; j < 4; ++j) nx[j] = *((const v2u*)(x1b + (size_t)m1 * DM) + l + 64 * j);
            nsv = (l < NE) ? sel[(size_t)m1 * NE + l] : -1; npv = *((const f32x4*)(p + (size_t)m1 * PLE) + l); }
        unsigned mask = (unsigned)__ballot(sv >= 0);
        while (mask) {
            const int e0 = __builtin_ctz(mask); mask &= mask - 1;
            const int e1 = mask ? __builtin_ctz(mask) : e0; const float f1 = mask ? 1.f : 0.f; mask &= mask - 1;
            const int e2 = mask ? __builtin_ctz(mask) : e0; const float f2 = mask ? 1.f : 0.f; mask &= mask - 1;
            const int e3 = mask ? __builtin_ctz(mask) : e0; const float f3 = mask ? 1.f : 0.f; mask &= mask - 1;
            const v2u* r0 = (const v2u*)(yexp + ((size_t)e0 * (NB * CAP) + b * CAP + __builtin_amdgcn_readlane(sv, e0)) * DM) + l;
            const v2u* r1 = (const v2u*)(yexp + ((size_t)e1 * (NB * CAP) + b * CAP + __builtin_amdgcn_readlane(sv, e1)) * DM) + l;
            const v2u* r2 = (const v2u*)(yexp + ((size_t)e2 * (NB * CAP) + b * CAP + __builtin_amdgcn_readlane(sv, e2)) * DM) + l;
            const v2u* r3 = (const v2u*)(yexp + ((size_t)e3 * (NB * CAP) + b * CAP + __builtin_amdgcn_readlane(sv, e3)) * DM) + l;
            v2u w0[4], w1[4], w2[4], w3[4];
#pragma unroll
            for (int j = 0; j < 4; ++j) { w0[j] = r0[64 * j]; w1[j] = r1[64 * j]; w2[j] = r2[64 * j]; w3[j] = r3[64 * j]; }
#pragma unroll
            for (int j = 0; j < 4; ++j) { acc_bf16x4(v[j], w0[j], 1.f); acc_bf16x4(v[j], w1[j], f1); acc_bf16x4(v[j], w2[j], f2); acc_bf16x4(v[j], w3[j], f3); }
        }
        ln_row(v, a.in[I_LNFG], a.in[I_LNFB], l);
#pragma unroll
        for (int j = 0; j < 4; ++j) *((v2u*)(xdst + (size_t)m * DM) + l + 64 * j) = (v2u){pk2(v[j].x, v[j].y), pk2(v[j].z, v[j].w)};
        *((v2u*)(pb + (size_t)m * PLE) + l) = (v2u){pk2(pv.x, pv.y), pk2(pv.z, pv.w)};
    }
}
__device__ __forceinline__ void p13_ln3(const Frame& F, const Args& a, float* xdst) {
    const int gw = F.vcu * NWAVES + F.wave, NGW = F.G * NWAVES, l = F.lane;
    float* xo = a.out;
    f32x4 nx[4];
    if (gw < T) {
#pragma unroll
        for (int j = 0; j < 4; ++j) nx[j] = *((const f32x4*)(xo + (size_t)gw * DM) + l + 64 * j); }
    for (int m = gw; m < T; m += NGW) {
        f32x4 v[4];
#pragma unroll
        for (int j = 0; j < 4; ++j) v[j] = nx[j];
        if (m + NGW < T) {
#pragma unroll
            for (int j = 0; j < 4; ++j) nx[j] = *((const f32x4*)(xo + (size_t)(m + NGW) * DM) + l + 64 * j); }
        ln_row(v, a.in[I_LNPG], a.in[I_LNPB], l);
#pragma unroll
        for (int j = 0; j < 4; ++j) *((f32x4*)(xdst + (size_t)m * DM) + l + 64 * j) = v[j];
    }
}

__global__ void __launch_bounds__(NWAVES * 64, 2) fwd(Args args) {
    extern __shared__ __attribute__((aligned(16))) unsigned char lds[];
    Frame F;
    F.lds = (LAS unsigned char*)lds; F.wave = __builtin_amdgcn_readfirstlane(threadIdx.x >> 6); F.lane = fresh_lane(); F.tid = F.wave * 64 + F.lane;
    F.G = gridDim.x; { const int bx = blockIdx.x; F.vcu = (F.G % 8 == 0) ? (bx % 8) * (F.G / 8) + bx / 8 : bx; }
    unsigned char* ws = args.ws;
    const int lo = args.ph_lo, hi = args.ph_hi;
#define IN(k) (lo <= (k) && (k) < hi)
    volatile LAS unsigned* MISC = (volatile LAS unsigned*)(F.lds + pg8::LDS_CTL_OFF + 320);
    for (int u = F.tid; u < 256; u += NWAVES * 64) ((LAS unsigned*)(F.lds + pg8::LDS_CTL_OFF))[u] = 0u;
    for (int u = F.tid; u < 1024 + 512; u += NWAVES * 64) {
        const bool big = u < 1024; const int v = big ? u : u - 1024, pos = big ? (v >> 4) : (v >> 3), i = big ? (v & 15) : (v & 7);
        float rev = (float)pos * exp2f(-(float)i * (big ? pg8::kLog2Base / 16.0f : pg8::kLog2Base / 8.0f)) * pg8::kInv2Pi; rev = rev - floorf(rev);
        *(LAS float*)(F.lds + (big ? pg8::TAB_COS64 : pg8::TAB_COS32) + v * 4) = __builtin_amdgcn_cosf(rev);
        *(LAS float*)(F.lds + (big ? pg8::TAB_SIN64 : pg8::TAB_SIN32) + v * 4) = __builtin_amdgcn_sinf(rev); }
    __syncthreads();
    XcdBarrier bar; bar.bar = (unsigned*)(ws + WS_CTL) + 4096 + args.region * XCD_BAR_WORDS; bar.x = 0; bar.st = nullptr; bar.w = F.wave;
    if (hi - lo > 1) bar = xcd_barrier_post((unsigned*)(ws + WS_CTL) + 4096 + args.region * XCD_BAR_WORDS, MISC + 8, F.wave);
#define PHASE(k) if (IN(k) && (F.lane = fresh_lane(), F.tid = F.wave * 64 + F.lane, true))
#define XDST(k) (args.dummy ? (float*)(ws + WS_R1) : args.out)
#define XDSTB(k) (args.dummy ? (bf16*)(ws + WS_R1) : (bf16*)(ws + WS_X1B))
#define SEAM(k) do { if (IN(k) && IN((k) + 1)) xcd_barrier(bar); } while (0)
    PHASE(0) p0_convert(F, args);
    SEAM(0);
    PHASE(1) { pg8::Gemm g{(const bf16*)(ws + WS_XB), (const bf16*)(ws + WS_WIN), T, INWP, DM}; pg8::StaticOrder S; S.init(T, INWP, F.G, (int)blockIdx.x);
        pg8::EpiProj E{(bf16*)(ws + WS_QG), (bf16*)(ws + WS_KG), (bf16*)(ws + WS_VG), (bf16*)(ws + WS_CQ), (bf16*)(ws + WS_CKV), (bf16*)(ws + WS_KPE), (float*)(ws + WS_SSQ), (float*)(ws + WS_SSKV), args.in[I_QN], args.in[I_KN], F.lds};
        pg8::gemm_phase<pg8::EpiProj, pg8::StaticOrder, true>(F.lds, g, S, E, F.wave); }
    SEAM(1);
    PHASE(2) {
        { pg8::Gemm g{(const bf16*)(ws + WS_CQ), (const bf16*)(ws + WS_WUQ), T, UQW, 256}; pg8::StaticOrder S; S.init(T, UQW, F.G, (int)blockIdx.x);
          pg8::EpiMlaQ E{(bf16*)(ws + WS_QMLA), (const float*)(ws + WS_SSQ), F.lds}; pg8::gemm_phase<pg8::EpiMlaQ, pg8::StaticOrder, true>(F.lds, g, S, E, F.wave); }
        { pg8::Gemm g{(const bf16*)(ws + WS_CKV), (const bf16*)(ws + WS_WUKV), T, UKVW, 256}; pg8::StaticOrder S; S.init(T, UKVW, F.G, (int)blockIdx.x);
          pg8::EpiMlaKV E{(bf16*)(ws + WS_KN), (bf16*)(ws + WS_VMLA), (const float*)(ws + WS_SSKV)}; pg8::gemm_phase<pg8::EpiMlaKV, pg8::StaticOrder, true>(F.lds, g, S, E, F.wave); }
    }
    SEAM(2);
    PHASE(3) p_attention(F, args);
    SEAM(3);
    PHASE(4) { pg8::Gemm g{(const bf16*)(ws + WS_O), (const bf16*)(ws + WS_WOUT), T, DM, DM}; pg8::StaticOrder S; S.init(T, DM, F.G, (int)blockIdx.x);
        pg8::EpiResid E{args.out, args.in[I_X], DM}; pg8::gemm_phase<pg8::EpiResid, pg8::StaticOrder, true>(F.lds, g, S, E, F.wave); }
    SEAM(4);
    PHASE(5) p7_ln1_router(F, args, XDSTB(5));
    SEAM(5);
    PHASE(6) p8_topk(F, args);
    SEAM(6);
    PHASE(7) { pg8::Gemm g{(const bf16*)(ws + WS_X1Q), (const bf16*)(ws + WS_WGU), NE * NB * CAP, 2 * FF, DM / 2}; pg8::GatherOrder S; S.init(NE * NB * CAP, 2 * FF, F.G, (int)blockIdx.x, NB * CAP / 256); S.rowmap = (const int*)(ws + WS_ROWMAP);
        pg8::EpiSwiGLU8 E{ws + WS_H, FF}; pg8::gemm_phase<pg8::EpiSwiGLU8, pg8::GatherOrder, true, true>(F.lds, g, S, E, F.wave); }
    SEAM(7);
    PHASE(8) { pg8::Gemm g{(const bf16*)(ws + WS_H), (const bf16*)(ws + WS_WDN), NE * NB * CAP, DM, FF / 2}; pg8::StaticOrder S; S.init(NE * NB * CAP, DM, F.G, (int)blockIdx.x, NB * CAP / 256);
        pg8::EpiRowScaleBf16 E{(bf16*)(ws + WS_YEXP), DM, (const float*)(ws + WS_GVAL), 1.0f / 256.0f}; pg8::gemm_phase<pg8::EpiRowScaleBf16, pg8::StaticOrder, true, true>(F.lds, g, S, E, F.wave); }
    SEAM(8);
    PHASE(9) p11_ln2(F, args, XDSTB(9));
    SEAM(9);
    PHASE(10) {
        { pg8::Gemm g{(const bf16*)(ws + WS_PB), (const bf16*)(ws + WS_WPP), T, DM, PLE}; pg8::StaticOrder S; S.init(T, DM, F.G, (int)blockIdx.x);
          pg8::EpiF32 E{(float*)(ws + WS_E), DM}; pg8::gemm_phase<pg8::EpiF32, pg8::StaticOrder, true>(F.lds, g, S, E, F.wave); }
        { pg8::Gemm g{(const bf16*)(ws + WS_X1B), (const bf16*)(ws + WS_WPG), T, DM, DM}; pg8::StaticOrder S; S.init(T, DM, F.G, (int)blockIdx.x);
          pg8::EpiPle E{args.out, (const float*)(ws + WS_E), (const bf16*)(ws + WS_X1B), DM}; pg8::gemm_phase<pg8::EpiPle, pg8::StaticOrder, true>(F.lds, g, S, E, F.wave); }
    }
    SEAM(10);
    PHASE(11) p13_ln3(F, args, XDST(11));
#undef IN
#undef SEAM
#undef XDST
#undef XDSTB
}

constexpr int NPHASES = 12;
extern "C" void kernel_launch(void* const* d_in, const int* in_sizes, int n_in, void* d_out, int out_size, void* d_ws, size_t ws_size, hipStream_t stream) {
    static int grid = 0;
    if (grid == 0) {
        if (n_in != 22 || in_sizes[0] != T * DM || out_size != T * DM || ws_size < WS_END) { fprintf(stderr, "kernel_launch: unexpected shapes (n_in %d, in0 %d, out %d, ws %zu < %zu?)\n", n_in, n_in > 0 ? in_sizes[0] : -1, out_size, ws_size, (size_t)WS_END); grid = -1; return; }
        if (hipFuncSetAttribute((const void*)fwd, hipFuncAttributeMaxDynamicSharedMemorySize, LDS_BYTES) != hipSuccess) { fprintf(stderr, "kernel_launch: hipFuncSetAttribute failed\n"); grid = -1; return; }
        int dev = 0, cus = 0, per_cu = 0;
        if (hipGetDevice(&dev) != hipSuccess || hipDeviceGetAttribute(&cus, hipDeviceAttributeMultiprocessorCount, dev) != hipSuccess) { fprintf(stderr, "kernel_launch: device query failed\n"); grid = -1; return; }
        if (hipOccupancyMaxActiveBlocksPerMultiprocessor(&per_cu, (const void*)fwd, NWAVES * 64, LDS_BYTES) != hipSuccess || per_cu < 1) { fprintf(stderr, "kernel_launch: occupancy query says %d blocks per CU\n", per_cu); (void)hipGetLastError(); grid = -1; return; }
        grid = cus;
    }
    if (grid < 0) return;
    Args a{};
    for (int i = 0; i < 22; ++i) a.in[i] = (const float*)d_in[i];
    a.out = (float*)d_out; a.ws = (unsigned char*)d_ws;
    (void)hipMemsetAsync((char*)d_ws + WS_CTL, 0, 65536, stream);
#ifndef PROBE_PHASE
    a.ph_lo = 0; a.ph_hi = NPHASES;
    hipLaunchKernelGGL(fwd, dim3(grid), dim3(NWAVES * 64), LDS_BYTES, stream, a);
#else
    if (PROBE_PHASE > 0) { a.ph_lo = 0; a.ph_hi = PROBE_PHASE; a.region = 0; hipLaunchKernelGGL(fwd, dim3(grid), dim3(NWAVES * 64), LDS_BYTES, stream, a); }
    a.ph_lo = PROBE_PHASE; a.ph_hi = PROBE_PHASE + 1; a.dummy = 1; a.region = 1; hipLaunchKernelGGL(fwd, dim3(grid), dim3(NWAVES * 64), LDS_BYTES, stream, a);
    a.ph_lo = PROBE_PHASE; a.ph_hi = NPHASES; a.dummy = 0; a.region = 2; hipLaunchKernelGGL(fwd, dim3(grid), dim3(NWAVES * 64), LDS_BYTES, stream, a);
#endif
}
```
